# Optimizing an MI355X kernel written in HIP

```python
import math
import jax
import jax.numpy as jnp
from jax import lax
import numpy as np

D_MODEL = 2048
BATCH = 8
SEQ = 2048
DEPTH = 1

HG_WIDTH = D_MODEL // 2
HG_HEAD_DIM = 128
HG_HEADS = HG_WIDTH // HG_HEAD_DIM
HG_CHUNK = 64
DA_WIDTH = D_MODEL - HG_WIDTH
DA_HEAD_DIM = 64
DA_HEADS = DA_WIDTH // (2 * DA_HEAD_DIM)
DA_Q_BLOCK = 128
N_BUCKETS = 32
MAX_DISTANCE = 128
D_FF = -(-(8 * D_MODEL) // (3 * 256)) * 256
IN_COLS = 5 * HG_WIDTH + 3 * DA_WIDTH
EPS = 1e-6

kernel_name = 'hybrid_hgrn2_diffattn_block'


def rms_norm(x, w):
    xf = x.astype(jnp.float32)
    y = xf * lax.rsqrt(jnp.mean(xf * xf, axis=-1, keepdims=True) + EPS)
    return (y * w.astype(jnp.float32)).astype(x.dtype)


def rel_bucket(rel):
    nb = N_BUCKETS // 2
    max_exact = nb // 2
    ret = jnp.where(rel > 0, nb, 0)
    n = jnp.abs(rel)
    nf = jnp.maximum(n, 1).astype(jnp.float32)
    large = max_exact + (jnp.log(nf / max_exact) / math.log(MAX_DISTANCE / max_exact)
                         * (nb - max_exact)).astype(jnp.int32)
    large = jnp.minimum(large, nb - 1)
    return ret + jnp.where(n < max_exact, n, large)


def hgrn2_scan(q, k, v, logf):
    B, H, S, dk = q.shape
    dv = v.shape[-1]
    C = HG_CHUNK
    N = S // C

    def to_chunks(t):
        return jnp.moveaxis(t.astype(jnp.float32).reshape(B, H, N, C, t.shape[-1]), 2, 0)

    qc, kc, vc, gc = to_chunks(q), to_chunks(k), to_chunks(v), to_chunks(logf)
    mask = jnp.tril(jnp.ones((C, C), dtype=bool))[:, :, None]

    def step(s_prev, inp):
        qi, ki, vi, gi = inp
        b = jnp.cumsum(gi, axis=2)
        inter = jnp.einsum('bhtk,bhkv->bhtv', qi * jnp.exp(b), s_prev)
        diff = b[:, :, :, None, :] - b[:, :, None, :, :]
        decay = jnp.exp(jnp.where(mask, diff, -jnp.inf))
        scores = jnp.einsum('bhtk,bhsk,bhtsk->bhts', qi, ki, decay)
        o = inter + jnp.einsum('bhts,bhsv->bhtv', scores, vi)
        b_last = b[:, :, -1:, :]
        s_new = (jnp.exp(b_last[:, :, 0, :])[..., None] * s_prev
                 + jnp.einsum('bhsk,bhsv->bhkv', ki * jnp.exp(b_last - b), vi))
        return s_new, o

    s0 = jnp.zeros((B, H, dk, dv), jnp.float32)
    _, oc = lax.scan(step, s0, (qc, kc, vc, gc))
    return jnp.moveaxis(oc, 0, 2).reshape(B, H, S, dv)


def diff_attention(q1, q2, k1, k2, v, lam, bias_table):
    B, H, S, d = q1.shape
    Q = DA_Q_BLOCK
    N = S // Q
    scale = d ** -0.5
    kpos = jnp.arange(S, dtype=jnp.int32)

    def blk(inp):
        qb1, qb2, qpos = inp
        bias = bias_table[rel_bucket(kpos[None, :] - qpos[:, None])]
        bias = jnp.moveaxis(bias.astype(jnp.float32), -1, 0)[None]
        s1 = jnp.einsum('bhqd,bhkd->bhqk', qb1, k1).astype(jnp.float32) * scale + bias
        s2 = jnp.einsum('bhqd,bhkd->bhqk', qb2, k2).astype(jnp.float32) * scale + bias
        p = jax.nn.softmax(s1, axis=-1) - lam * jax.nn.softmax(s2, axis=-1)
        return jnp.einsum('bhqk,bhkv->bhqv', p.astype(v.dtype), v)

    qb1 = jnp.moveaxis(q1.reshape(B, H, N, Q, d), 2, 0)
    qb2 = jnp.moveaxis(q2.reshape(B, H, N, Q, d), 2, 0)
    qpos = jnp.arange(S, dtype=jnp.int32).reshape(N, Q)
    o = lax.map(blk, (qb1, qb2, qpos))
    return jnp.moveaxis(o, 0, 2).reshape(B, H, S, v.shape[-1])


def setup_inputs(seed: int = 0):
    key = jax.random.key(seed)
    ks = jax.random.split(key, 17)
    f32 = jnp.float32

    def nrm(k, shape, scale):
        return jax.random.normal(k, shape, f32) * scale

    def gain(k, shape):
        return 1.0 + 0.02 * jax.random.normal(k, shape, f32)

    return {
        'x': nrm(ks[0], (BATCH, SEQ, D_MODEL), 1.0),
        'norm1_w': gain(ks[1], (DEPTH, D_MODEL)),
        'w_in': nrm(ks[2], (DEPTH, D_MODEL, IN_COLS), D_MODEL ** -0.5),
        'hg_lb_logits': nrm(ks[3], (2, DEPTH + 1, HG_WIDTH), 0.5),
        'hg_onorm_w': gain(ks[4], (DEPTH, HG_HEAD_DIM)),
        'lambda_q1': nrm(ks[5], (DEPTH, DA_HEAD_DIM), 0.1),
        'lambda_k1': nrm(ks[6], (DEPTH, DA_HEAD_DIM), 0.1),
        'lambda_q2': nrm(ks[7], (DEPTH, DA_HEAD_DIM), 0.1),
        'lambda_k2': nrm(ks[8], (DEPTH, DA_HEAD_DIM), 0.1),
        'da_subln_w': gain(ks[9], (DEPTH, 2 * DA_HEAD_DIM)),
        'rel_bias': nrm(ks[10], (N_BUCKETS, DA_HEADS), 0.5),
        'w_out': nrm(ks[11], (DEPTH, D_MODEL, D_MODEL), D_MODEL ** -0.5),
        'norm2_w': gain(ks[12], (DEPTH, D_MODEL)),
        'w_gate': nrm(ks[13], (DEPTH, D_MODEL, D_FF), D_MODEL ** -0.5),
        'w_up': nrm(ks[14], (DEPTH, D_MODEL, D_FF), D_MODEL ** -0.5),
        'w_down': nrm(ks[15], (DEPTH, D_FF, D_MODEL), D_FF ** -0.5),
        'final_norm_w': gain(ks[16], (D_MODEL,)),
    }


def reference(x, norm1_w, w_in, hg_lb_logits, hg_onorm_w, lambda_q1, lambda_k1,
              lambda_q2, lambda_k2, da_subln_w, rel_bias, w_out, norm2_w,
              w_gate, w_up, w_down, final_norm_w):
    B, S, _ = x.shape
    splits = [HG_WIDTH, 2 * HG_WIDTH, 3 * HG_WIDTH, 4 * HG_WIDTH, 5 * HG_WIDTH,
              5 * HG_WIDTH + DA_WIDTH, 5 * HG_WIDTH + 2 * DA_WIDTH]
    lower_bounds = jnp.cumsum(jax.nn.softmax(hg_lb_logits.astype(jnp.float32), axis=1), axis=1)

    def heads(t, dh):
        return t.reshape(B, S, -1, dh).transpose(0, 2, 1, 3)

    h = x
    for l in range(DEPTH):
        u = rms_norm(h, norm1_w[l])
        proj = u @ w_in[l]
        hq, hi, hf_fwd, hf_bwd, hg, dq, dk, dv = jnp.split(proj, splits, axis=-1)

        q = heads(jax.nn.silu(hq), HG_HEAD_DIM)
        vin = heads(hi, HG_HEAD_DIM)
        lb_f = lower_bounds[0, l]
        lb_b = lower_bounds[1, l]
        f_f = lb_f + (1.0 - lb_f) * jax.nn.sigmoid(hf_fwd.astype(jnp.float32))
        f_b = lb_b + (1.0 - lb_b) * jax.nn.sigmoid(hf_bwd.astype(jnp.float32))
        f_f = heads(f_f, HG_HEAD_DIM)
        f_b = heads(f_b, HG_HEAD_DIM)
        o_fwd = hgrn2_scan(q, 1.0 - f_f, vin, jnp.log(f_f))
        o_bwd = jnp.flip(hgrn2_scan(jnp.flip(q, 2), jnp.flip(1.0 - f_b, 2),
                                    jnp.flip(vin, 2), jnp.flip(jnp.log(f_b), 2)), 2)
        o_hg = (o_fwd + o_bwd).astype(x.dtype).transpose(0, 2, 1, 3)
        o_hg = rms_norm(o_hg, hg_onorm_w[l]) * jax.nn.silu(hg.reshape(B, S, HG_HEADS, HG_HEAD_DIM))
        o_hg = o_hg.reshape(B, S, HG_WIDTH)

        dq5 = dq.reshape(B, S, DA_HEADS, 2, DA_HEAD_DIM).transpose(0, 2, 3, 1, 4)
        dk5 = dk.reshape(B, S, DA_HEADS, 2, DA_HEAD_DIM).transpose(0, 2, 3, 1, 4)
        dvh = heads(dv, 2 * DA_HEAD_DIM)
        lam_init = 0.8 - 0.6 * math.exp(-0.3 * l)
        lam = (jnp.exp(jnp.sum(lambda_q1[l].astype(jnp.float32) * lambda_k1[l].astype(jnp.float32)))
               - jnp.exp(jnp.sum(lambda_q2[l].astype(jnp.float32) * lambda_k2[l].astype(jnp.float32)))
               + lam_init)
        o_da = diff_attention(dq5[:, :, 0], dq5[:, :, 1], dk5[:, :, 0], dk5[:, :, 1],
                              dvh, lam, rel_bias)
        o_da = rms_norm(o_da.transpose(0, 2, 1, 3), da_subln_w[l]) * (1.0 - lam_init)
        o_da = o_da.reshape(B, S, DA_WIDTH)

        h = h + jnp.concatenate([o_hg, o_da], axis=-1) @ w_out[l]

        u2 = rms_norm(h, norm2_w[l])
        h = h + (jax.nn.silu(u2 @ w_gate[l]) * (u2 @ w_up[l])) @ w_down[l]

    return rms_norm(h, final_norm_w)
```

```cpp
#include <hip/hip_runtime.h>
#include <stdint.h>
#include <cstdio>

typedef unsigned short u16;
typedef float f32x4 __attribute__((ext_vector_type(4)));
typedef unsigned u32x4 __attribute__((ext_vector_type(4)));

constexpr int BATCH = 8, SEQ = 2048, DM = 2048, M = BATCH * SEQ;
constexpr int HGW = 1024, DAW = 1024, INC = 8192, DFF = 5632;
constexpr float EPS = 1e-6f;
constexpr float LOG2E = 1.4426950408889634f;
constexpr float C2 = 0.125f * LOG2E;
constexpr size_t MiB = 1u << 20;
constexpr size_t WS_XN = 0, WS_B = 64 * MiB, WS_PROJ = 128 * MiB, WS_ATT = 384 * MiB, WS_NEED = 512 * MiB;

__device__ __forceinline__ u16 f2bf(float f) { unsigned u = __float_as_uint(f); u += 0x7fffu + ((u >> 16) & 1u); return (u16)(u >> 16); }
__device__ __forceinline__ float bf2f(u16 h) { return __uint_as_float(((unsigned)h) << 16); }
__device__ __forceinline__ u16 f2h(float f) { return __builtin_bit_cast(u16, (_Float16)f); }
__device__ __forceinline__ float h2f(u16 h) { return (float)__builtin_bit_cast(_Float16, h); }
__device__ __forceinline__ float wave_sum(float v) {
#pragma unroll
    for (int o = 1; o < 64; o <<= 1) v += __shfl_xor(v, o);
    return v;
}
__device__ __forceinline__ float sigmoidf_(float x) { return 1.0f / (1.0f + __expf(-x)); }
__device__ __forceinline__ float siluf_(float x) { return x / (1.0f + __expf(-x)); }

__global__ __launch_bounds__(256) void k_rms_bf16(const float* __restrict__ x, const float* __restrict__ w, u16* __restrict__ out) {
    const int row = blockIdx.x * 4 + (threadIdx.x >> 6), lane = threadIdx.x & 63;
    const f32x4* xr = (const f32x4*)(x + (size_t)row * DM) + lane;
    f32x4 v[8]; float s = 0.f;
#pragma unroll
    for (int j = 0; j < 8; ++j) { v[j] = xr[64 * j]; s += v[j].x * v[j].x + v[j].y * v[j].y + v[j].z * v[j].z + v[j].w * v[j].w; }
    const float r = rsqrtf(wave_sum(s) * (1.0f / DM) + EPS);
    const f32x4* wr = (const f32x4*)w + lane;
    uint2* o = (uint2*)(out + (size_t)row * DM) + lane;
#pragma unroll
    for (int j = 0; j < 8; ++j) { const f32x4 ww = wr[64 * j]; uint2 p;
        p.x = (unsigned)f2bf(v[j].x * r * ww.x) | ((unsigned)f2bf(v[j].y * r * ww.y) << 16);
        p.y = (unsigned)f2bf(v[j].z * r * ww.z) | ((unsigned)f2bf(v[j].w * r * ww.w) << 16);
        o[64 * j] = p; }
}
__global__ __launch_bounds__(256) void k_rms_final(float* __restrict__ h, const float* __restrict__ w) {
    const int row = blockIdx.x * 4 + (threadIdx.x >> 6), lane = threadIdx.x & 63;
    f32x4* xr = (f32x4*)(h + (size_t)row * DM) + lane;
    f32x4 v[8]; float s = 0.f;
#pragma unroll
    for (int j = 0; j < 8; ++j) { v[j] = xr[64 * j]; s += v[j].x * v[j].x + v[j].y * v[j].y + v[j].z * v[j].z + v[j].w * v[j].w; }
    const float r = rsqrtf(wave_sum(s) * (1.0f / DM) + EPS);
    const f32x4* wr = (const f32x4*)w + lane;
#pragma unroll
    for (int j = 0; j < 8; ++j) { const f32x4 ww = wr[64 * j]; xr[64 * j] = v[j] * r * ww; }
}

template <class Epi, bool DUAL>
__global__ __launch_bounds__(256) void k_gemm(const u16* __restrict__ A, int lda, const float* __restrict__ W, const float* __restrict__ W2, int ldw, int K, Epi epi) {
    __shared__ float As[16][132];
    __shared__ float Bs[16][128];
    __shared__ float Bs2[DUAL ? 16 : 1][128];
    const int tid = threadIdx.x, tx = tid & 15, ty = tid >> 4;
    const int m0 = blockIdx.y * 128, n0 = blockIdx.x * 128;
    float acc[8][8], acc2[DUAL ? 8 : 1][8];
#pragma unroll
    for (int i = 0; i < 8; ++i)
#pragma unroll
        for (int j = 0; j < 8; ++j) { acc[i][j] = 0.f; if (DUAL) acc2[i][j] = 0.f; }
    const int ar = tid >> 1, ak = (tid & 1) * 8;
    const int bk = tid >> 4, bn = (tid & 15) * 8;
    for (int k0 = 0; k0 < K; k0 += 16) {
        const u32x4 av = *(const u32x4*)(A + (size_t)(m0 + ar) * lda + k0 + ak);
        const f32x4 b0 = *(const f32x4*)(W + (size_t)(k0 + bk) * ldw + n0 + bn), b1 = *(const f32x4*)(W + (size_t)(k0 + bk) * ldw + n0 + bn + 4);
        f32x4 c0, c1;
        if (DUAL) { c0 = *(const f32x4*)(W2 + (size_t)(k0 + bk) * ldw + n0 + bn); c1 = *(const f32x4*)(W2 + (size_t)(k0 + bk) * ldw + n0 + bn + 4); }
        __syncthreads();
        As[ak + 0][ar] = __uint_as_float(av.x << 16); As[ak + 1][ar] = __uint_as_float(av.x & 0xffff0000u);
        As[ak + 2][ar] = __uint_as_float(av.y << 16); As[ak + 3][ar] = __uint_as_float(av.y & 0xffff0000u);
        As[ak + 4][ar] = __uint_as_float(av.z << 16); As[ak + 5][ar] = __uint_as_float(av.z & 0xffff0000u);
        As[ak + 6][ar] = __uint_as_float(av.w << 16); As[ak + 7][ar] = __uint_as_float(av.w & 0xffff0000u);
        *(f32x4*)&Bs[bk][bn] = b0; *(f32x4*)&Bs[bk][bn + 4] = b1;
        if (DUAL) { *(f32x4*)&Bs2[bk][bn] = c0; *(f32x4*)&Bs2[bk][bn + 4] = c1; }
        __syncthreads();
#pragma unroll
        for (int k = 0; k < 16; ++k) {
            float a[8], b[8], b2[8];
            const f32x4 a0 = *(const f32x4*)&As[k][ty * 8], a1 = *(const f32x4*)&As[k][ty * 8 + 4];
            a[0] = a0.x; a[1] = a0.y; a[2] = a0.z; a[3] = a0.w; a[4] = a1.x; a[5] = a1.y; a[6] = a1.z; a[7] = a1.w;
            const f32x4 p0 = *(const f32x4*)&Bs[k][tx * 8], p1 = *(const f32x4*)&Bs[k][tx * 8 + 4];
            b[0] = p0.x; b[1] = p0.y; b[2] = p0.z; b[3] = p0.w; b[4] = p1.x; b[5] = p1.y; b[6] = p1.z; b[7] = p1.w;
            if (DUAL) { const f32x4 q0 = *(const f32x4*)&Bs2[k][tx * 8], q1 = *(const f32x4*)&Bs2[k][tx * 8 + 4];
                b2[0] = q0.x; b2[1] = q0.y; b2[2] = q0.z; b2[3] = q0.w; b2[4] = q1.x; b2[5] = q1.y; b2[6] = q1.z; b2[7] = q1.w; }
#pragma unroll
            for (int i = 0; i < 8; ++i)
#pragma unroll
                for (int j = 0; j < 8; ++j) { acc[i][j] += a[i] * b[j]; if (DUAL) acc2[i][j] += a[i] * b2[j]; }
        }
    }
#pragma unroll
    for (int i = 0; i < 8; ++i) { if constexpr (DUAL) epi(m0 + ty * 8 + i, n0 + tx * 8, acc[i], acc2[i]); else epi(m0 + ty * 8 + i, n0 + tx * 8, acc[i], acc[i]); }
}

struct EpiInProj {
    u16* proj; const float* lbl;
    __device__ __forceinline__ void operator()(int m, int n, const float* v, const float*) const {
        const int t = n >> 10; u16* o = proj + (size_t)m * INC + n; u16 r[8];
#pragma unroll
        for (int j = 0; j < 8; ++j) {
            const float a = v[j]; float y;
            if (t == 0 || t == 4) { y = siluf_(a); r[j] = f2bf(y); }
            else if (t == 2 || t == 3) { const int c = (n & 1023) + j, dir = t - 2;
                const float lb = sigmoidf_(lbl[dir * 2048 + c] - lbl[dir * 2048 + 1024 + c]);
                const float f = lb + (1.0f - lb) * sigmoidf_(a); r[j] = f2h(__logf(f)); }
            else if (t == 5) { r[j] = f2bf(a * C2); }
            else { r[j] = f2bf(a); }
        }
        u32x4 w; w.x = r[0] | ((unsigned)r[1] << 16); w.y = r[2] | ((unsigned)r[3] << 16); w.z = r[4] | ((unsigned)r[5] << 16); w.w = r[6] | ((unsigned)r[7] << 16);
        *(u32x4*)o = w;
    }
};
struct EpiResid {
    const float* base; float* out;
    __device__ __forceinline__ void operator()(int m, int n, const float* v, const float*) const {
        const size_t off = (size_t)m * DM + n;
        const f32x4 b0 = *(const f32x4*)(base + off), b1 = *(const f32x4*)(base + off + 4);
        *(f32x4*)(out + off) = (f32x4){b0.x + v[0], b0.y + v[1], b0.z + v[2], b0.w + v[3]};
        *(f32x4*)(out + off + 4) = (f32x4){b1.x + v[4], b1.y + v[5], b1.z + v[6], b1.w + v[7]};
    }
};
struct EpiSwiGLU {
    u16* hid;
    __device__ __forceinline__ void operator()(int m, int n, const float* g, const float* u) const {
        u16 r[8];
#pragma unroll
        for (int j = 0; j < 8; ++j) r[j] = f2bf(siluf_(g[j]) * u[j]);
        u32x4 w; w.x = r[0] | ((unsigned)r[1] << 16); w.y = r[2] | ((unsigned)r[3] << 16); w.z = r[4] | ((unsigned)r[5] << 16); w.w = r[6] | ((unsigned)r[7] << 16);
        *(u32x4*)(hid + (size_t)m * DFF + n) = w;
    }
};

__global__ __launch_bounds__(128) void k_hgrn(const u16* __restrict__ proj, u16* __restrict__ odir) {
    const int seq = blockIdx.x, dir = seq & 1, h = (seq >> 1) & 7, b = seq >> 4, c = threadIdx.x;
    __shared__ float sq[2][128], sf[2][128], sk[2][128];
    float S[128];
#pragma unroll
    for (int k = 0; k < 128; ++k) S[k] = 0.f;
    for (int step = 0; step < SEQ; ++step) {
        const int t = dir ? (SEQ - 1 - step) : step, buf = step & 1;
        const size_t m = (size_t)b * SEQ + t;
        const u16* row = proj + m * INC;
        const float q = bf2f(row[h * 128 + c]), lf = h2f(row[2048 + dir * 1024 + h * 128 + c]), v = bf2f(row[1024 + h * 128 + c]);
        sq[buf][c] = q; sf[buf][c] = __expf(lf); sk[buf][c] = -expm1f(lf);
        __syncthreads();
        float o = 0.f;
#pragma unroll
        for (int k = 0; k < 128; k += 4) {
            const f32x4 f4 = *(const f32x4*)&sf[buf][k], k4 = *(const f32x4*)&sk[buf][k], q4 = *(const f32x4*)&sq[buf][k];
            S[k] = f4.x * S[k] + k4.x * v; o += q4.x * S[k];
            S[k + 1] = f4.y * S[k + 1] + k4.y * v; o += q4.y * S[k + 1];
            S[k + 2] = f4.z * S[k + 2] + k4.z * v; o += q4.z * S[k + 2];
            S[k + 3] = f4.w * S[k + 3] + k4.w * v; o += q4.w * S[k + 3];
        }
        odir[((size_t)dir * M + m) * HGW + h * 128 + c] = f2bf(o);
    }
}
__global__ __launch_bounds__(256) void k_hgrn_fin(const u16* __restrict__ odir, const u16* __restrict__ proj, const float* __restrict__ w, u16* __restrict__ cat) {
    const int gw = blockIdx.x * 4 + (threadIdx.x >> 6), lane = threadIdx.x & 63;
    const int m = gw >> 3, h = gw & 7, c = h * 128 + lane * 2;
    const unsigned a = *(const unsigned*)(odir + (size_t)m * HGW + c), bb = *(const unsigned*)(odir + ((size_t)M + m) * HGW + c);
    const float o0 = bf2f((u16)a) + bf2f((u16)bb), o1 = bf2f((u16)(a >> 16)) + bf2f((u16)(bb >> 16));
    const float r = rsqrtf(wave_sum(o0 * o0 + o1 * o1) * (1.0f / 128.0f) + EPS);
    const unsigned g = *(const unsigned*)(proj + (size_t)m * INC + 4096 + c);
    const float y0 = o0 * r * w[lane * 2] * bf2f((u16)g), y1 = o1 * r * w[lane * 2 + 1] * bf2f((u16)(g >> 16));
    *(unsigned*)(cat + (size_t)m * DM + c) = (unsigned)f2bf(y0) | ((unsigned)f2bf(y1) << 16);
}

__device__ __forceinline__ int rel_bucket(int rel) {
    const int n = rel < 0 ? -rel : rel; int bk;
    if (n < 8) bk = n; else if (n < 12) bk = 8; else if (n < 16) bk = 9; else if (n < 23) bk = 10; else if (n < 32) bk = 11;
    else if (n < 46) bk = 12; else if (n < 64) bk = 13; else if (n < 91) bk = 14; else bk = 15;
    return bk + (rel > 0 ? 16 : 0);
}
__global__ __launch_bounds__(256) void k_attn(const u16* __restrict__ proj, const float* __restrict__ rel_bias, float* __restrict__ On) {
    const int qb = blockIdx.x, h = blockIdx.y, b = blockIdx.z >> 1, mp = blockIdx.z & 1, tid = threadIdx.x;
    const int qpos = qb * 256 + tid; const size_t m = (size_t)b * SEQ + qpos;
    __shared__ float sk[32][64];
    __shared__ float sv[32][128];
    __shared__ float sb[32];
    float q[64], o[128];
    { const u16* qp = proj + m * INC + 5120 + h * 128 + mp * 64;
#pragma unroll
      for (int d = 0; d < 64; ++d) q[d] = bf2f(qp[d]); }
#pragma unroll
    for (int d = 0; d < 128; ++d) o[d] = 0.f;
    if (tid < 32) sb[tid] = rel_bias[tid * 8 + h] * LOG2E;
    float mx = -1e30f, l = 0.f;
    const int lk = tid >> 3, ld8 = (tid & 7) * 8, ld16 = (tid & 7) * 16;
    for (int kt = 0; kt < SEQ / 32; ++kt) {
        const u16* kr = proj + ((size_t)b * SEQ + kt * 32 + lk) * INC;
        const u32x4 kv = *(const u32x4*)(kr + 6144 + h * 128 + mp * 64 + ld8);
        const u32x4 v0 = *(const u32x4*)(kr + 7168 + h * 128 + ld16), v1 = *(const u32x4*)(kr + 7168 + h * 128 + ld16 + 8);
        __syncthreads();
        { float* d = &sk[lk][ld8];
          d[0] = __uint_as_float(kv.x << 16); d[1] = __uint_as_float(kv.x & 0xffff0000u); d[2] = __uint_as_float(kv.y << 16); d[3] = __uint_as_float(kv.y & 0xffff0000u);
          d[4] = __uint_as_float(kv.z << 16); d[5] = __uint_as_float(kv.z & 0xffff0000u); d[6] = __uint_as_float(kv.w << 16); d[7] = __uint_as_float(kv.w & 0xffff0000u);
          float* e = &sv[lk][ld16];
          e[0] = __uint_as_float(v0.x << 16); e[1] = __uint_as_float(v0.x & 0xffff0000u); e[2] = __uint_as_float(v0.y << 16); e[3] = __uint_as_float(v0.y & 0xffff0000u);
          e[4] = __uint_as_float(v0.z << 16); e[5] = __uint_as_float(v0.z & 0xffff0000u); e[6] = __uint_as_float(v0.w << 16); e[7] = __uint_as_float(v0.w & 0xffff0000u);
          e[8] = __uint_as_float(v1.x << 16); e[9] = __uint_as_float(v1.x & 0xffff0000u); e[10] = __uint_as_float(v1.y << 16); e[11] = __uint_as_float(v1.y & 0xffff0000u);
          e[12] = __uint_as_float(v1.z << 16); e[13] = __uint_as_float(v1.z & 0xffff0000u); e[14] = __uint_as_float(v1.w << 16); e[15] = __uint_as_float(v1.w & 0xffff0000u); }
        __syncthreads();
        for (int j = 0; j < 32; ++j) {
            float s = 0.f;
#pragma unroll
            for (int d = 0; d < 64; d += 4) { const f32x4 k4 = *(const f32x4*)&sk[j][d]; s += q[d] * k4.x + q[d + 1] * k4.y + q[d + 2] * k4.z + q[d + 3] * k4.w; }
            s += sb[rel_bucket(kt * 32 + j - qpos)];
            if (s > mx) { const float al = exp2f(mx - s); l *= al;
#pragma unroll
                for (int d = 0; d < 128; ++d) o[d] *= al;
                mx = s; }
            const float p = exp2f(s - mx); l += p;
#pragma unroll
            for (int d = 0; d < 128; d += 4) { const f32x4 v4 = *(const f32x4*)&sv[j][d]; o[d] += p * v4.x; o[d + 1] += p * v4.y; o[d + 2] += p * v4.z; o[d + 3] += p * v4.w; }
        }
    }
    const float il = 1.0f / l;
    float* op = On + ((size_t)mp * M + m) * DAW + h * 128;
#pragma unroll
    for (int d = 0; d < 128; d += 4) *(f32x4*)(op + d) = (f32x4){o[d] * il, o[d + 1] * il, o[d + 2] * il, o[d + 3] * il};
}
__global__ __launch_bounds__(256) void k_attn_fin(const float* __restrict__ On, const float* __restrict__ lq1, const float* __restrict__ lk1, const float* __restrict__ lq2, const float* __restrict__ lk2,
                                                  const float* __restrict__ w, u16* __restrict__ cat) {
    const int gw = blockIdx.x * 4 + (threadIdx.x >> 6), lane = threadIdx.x & 63;
    const int m = gw >> 3, h = gw & 7, c = h * 128 + lane * 2;
    const float lam = __expf(wave_sum(lq1[lane] * lk1[lane])) - __expf(wave_sum(lq2[lane] * lk2[lane])) + 0.2f;
    const float2 a = *(const float2*)(On + (size_t)m * DAW + c), bb = *(const float2*)(On + ((size_t)M + m) * DAW + c);
    const float o0 = a.x - lam * bb.x, o1 = a.y - lam * bb.y;
    const float r = rsqrtf(wave_sum(o0 * o0 + o1 * o1) * (1.0f / 128.0f) + EPS) * 0.8f;
    *(unsigned*)(cat + (size_t)m * DM + 1024 + c) = (unsigned)f2bf(o0 * r * w[lane * 2]) | ((unsigned)f2bf(o1 * r * w[lane * 2 + 1]) << 16);
}

extern "C" void kernel_launch(void* const* d_in, const int* in_sizes, int n_in, void* d_out, int out_size, void* d_ws, size_t ws_size, hipStream_t stream) {
    if (n_in != 17 || ws_size < WS_NEED || out_size != M * DM) { fprintf(stderr, "kernel_launch: unexpected shapes (n_in %d, ws %zu, out %d)\n", n_in, ws_size, out_size); return; }
    const float* x = (const float*)d_in[0];      const float* norm1_w = (const float*)d_in[1];  const float* w_in = (const float*)d_in[2];
    const float* lbl = (const float*)d_in[3];    const float* onorm_w = (const float*)d_in[4];
    const float* lq1 = (const float*)d_in[5];    const float* lk1 = (const float*)d_in[6];      const float* lq2 = (const float*)d_in[7];  const float* lk2 = (const float*)d_in[8];
    const float* subln_w = (const float*)d_in[9]; const float* rel_bias = (const float*)d_in[10]; const float* w_out = (const float*)d_in[11];
    const float* norm2_w = (const float*)d_in[12]; const float* w_gate = (const float*)d_in[13]; const float* w_up = (const float*)d_in[14];
    const float* w_down = (const float*)d_in[15]; const float* final_w = (const float*)d_in[16];
    float* out = (float*)d_out; unsigned char* ws = (unsigned char*)d_ws;
    u16* XN = (u16*)(ws + WS_XN); u16* BB = (u16*)(ws + WS_B); u16* PROJ = (u16*)(ws + WS_PROJ); float* ATT = (float*)(ws + WS_ATT);

    k_rms_bf16<<<M / 4, 256, 0, stream>>>(x, norm1_w, XN);
    k_gemm<EpiInProj, false><<<dim3(INC / 128, M / 128), 256, 0, stream>>>(XN, DM, w_in, nullptr, INC, DM, EpiInProj{PROJ, lbl});
    k_hgrn<<<128, 128, 0, stream>>>(PROJ, BB);
    k_attn<<<dim3(8, 8, 16), 256, 0, stream>>>(PROJ, rel_bias, ATT);
    k_hgrn_fin<<<M * 8 / 4, 256, 0, stream>>>(BB, PROJ, onorm_w, XN);
    k_attn_fin<<<M * 8 / 4, 256, 0, stream>>>(ATT, lq1, lk1, lq2, lk2, subln_w, XN);
    k_gemm<EpiResid, false><<<dim3(DM / 128, M / 128), 256, 0, stream>>>(XN, DM, w_out, nullptr, DM, DM, EpiResid{x, out});
    k_rms_bf16<<<M / 4, 256, 0, stream>>>(out, norm2_w, BB);
    k_gemm<EpiSwiGLU, true><<<dim3(DFF / 128, M / 128), 256, 0, stream>>>(BB, DM, w_gate, w_up, DFF, DM, EpiSwiGLU{PROJ});
    k_gemm<EpiResid, false><<<dim3(DM / 128, M / 128), 256, 0, stream>>>(PROJ, DFF, w_down, nullptr, DM, DFF, EpiResid{out, out});
    k_rms_final<<<M / 4, 256, 0, stream>>>(out, final_w);
}
```

```cpp
#include <hip/hip_runtime.h>
#include <stdint.h>
#include <cstdio>

typedef unsigned short u16;
constexpr int BATCH = 8, SEQ = 2048, DM = 2048, M = BATCH * SEQ;
constexpr int HGW = 1024, DAW = 1024, INC = 8192, DFF = 5632, NGU = 2 * DFF;
constexpr float EPS = 1e-6f;
constexpr float LOG2E = 1.4426950408889634f;
constexpr float C2 = 0.125f * LOG2E;
constexpr size_t MiB = 1u << 20;
constexpr size_t WS_CTL = 0, CTL_ZERO_BYTES = 1 * MiB, WS_PART = 2 * MiB, WS_WIN = 4 * MiB, WS_WO = 36 * MiB, WS_WGU = 44 * MiB, WS_WD = 88 * MiB,
                 WS_XN = 112 * MiB, WS_B = 176 * MiB, WS_PROJ = 240 * MiB, WS_NEED = 496 * MiB;
namespace pg8 {
#define PG8_LAS __attribute__((address_space(3)))
typedef unsigned short bf16_t;
typedef short bf16x8 __attribute__((ext_vector_type(8)));
typedef float f32x4 __attribute__((ext_vector_type(4)));
typedef unsigned u32x4 __attribute__((ext_vector_type(4)));
constexpr int BM = 256, BK = 64, HALF = 128, HTB = HALF * BK * 2  , STAGE_BYTES = 8 * HTB, NXCD = 8, WGM = 8;

__host__ __device__ __forceinline__ int lds_byte(int r, int c) { const int st = (r >> 4) * 2 + (c >> 5), rr = r & 15, cc = c & 31, ob = rr * 64 + cc * 2; return st * 1024 + (ob ^ (((ob >> 9) & 1) << 5)); }
__host__ __device__ __forceinline__ void stage_rc(int b, int& R, int& C) { const int st = b / 1024, sb = b % 1024, swz = sb ^ (((sb >> 9) & 1) << 5); R = (st >> 1) * 16 + swz / 64; C = (st & 1) * 32 + (swz % 64) / 2; }
__host__ __device__ __forceinline__ int perm32(int rho) { const int n = rho >> 4, i = rho & 15; return 8 * (i >> 2) + 4 * n + (i & 3); }

struct Unit { int pm, pn; };
struct Gemm { const bf16_t* A; const bf16_t* Bt; int M, N, K; };

struct StaticOrder {
    int nM, nN, nwg, G, c;
    __host__ __device__ void init(int M, int N, int G_, int c_) { nM = M / BM; nN = N / BM; nwg = nM * nN; G = G_; c = c_; }
    __host__ __device__ bool next(int i, Unit& u) const {
        const long L = (long)i * G + c; if (L >= nwg) return false;
        int wgid = (int)L; { const int q = nwg / NXCD, r = nwg % NXCD, xcd = wgid % NXCD, off = wgid / NXCD; wgid = (xcd < r ? xcd * (q + 1) : r * (q + 1) + (xcd - r) * q) + off; }
        const int nig = WGM * nN, gid = wgid / nig, fm = gid * WGM, gsz = (nM - fm) < WGM ? (nM - fm) : WGM;
        u.pm = fm + ((wgid % nig) % gsz); u.pn = (wgid % nig) / gsz; return true;
    }
    __device__ __forceinline__ void a_ready(const Unit&) const {}
    __device__ __forceinline__ void done(const Unit&) const {}
};
__device__ __forceinline__ unsigned cvt_pk_bf16(float lo, float hi) { unsigned r; asm volatile("v_cvt_pk_bf16_f32 %0, %1, %2" : "=v"(r) : "v"(lo), "v"(hi)); return r; }
typedef float f32x2 __attribute__((ext_vector_type(2)));
__device__ __forceinline__ unsigned pk_h2(float lo, float hi) { return (unsigned)__builtin_bit_cast(unsigned short, (_Float16)lo) | ((unsigned)__builtin_bit_cast(unsigned short, (_Float16)hi) << 16); }
__device__ __forceinline__ float fsig(float x) { return __builtin_amdgcn_rcpf(1.0f + __builtin_amdgcn_exp2f(-1.4426950408889634f * x)); }
__device__ __forceinline__ float fsilu(float x) { return x * fsig(x); }
struct EpiInProj {
    static constexpr bool PERM = true, AFTER_DRAIN = false;
    bf16_t* proj; const float* lbl;
    __device__ __forceinline__ void operator()(const f32x4 (&acc)[2][2][4][2], const Unit& u, int wr, int wc, int fr, int fq) const {
        const int row0 = u.pm * BM + wr * 64 + fr, t = u.pn >> 2, col0 = u.pn * BM + wc * 32 + 8 * fq;
        bf16_t* base = proj + (size_t)row0 * 8192 + col0;
        if (t == 2 || t == 3) {
#pragma unroll
            for (int bj = 0; bj < 2; ++bj) {
                float lb[8];
                { const float* l0 = lbl + (t - 2) * 2048 + (col0 & 1023) + bj * HALF;
                  const f32x4 a0 = *(const f32x4*)(l0), a1 = *(const f32x4*)(l0 + 4), b0 = *(const f32x4*)(l0 + 1024), b1 = *(const f32x4*)(l0 + 1028);
#pragma unroll
                  for (int j = 0; j < 4; ++j) { lb[j] = fsig(a0[j] - b0[j]); lb[4 + j] = fsig(a1[j] - b1[j]); } }
#pragma unroll
                for (int ai = 0; ai < 2; ++ai)
#pragma unroll
                    for (int m = 0; m < 4; ++m) { float y[8];
#pragma unroll
                        for (int j = 0; j < 8; ++j) { const float a = acc[ai][bj][m][j >> 2][j & 3]; const float f = lb[j] + (1.0f - lb[j]) * fsig(a); y[j] = 0.6931471805599453f * __builtin_amdgcn_logf(f); }
                        u32x4 w; w.x = pk_h2(y[0], y[1]); w.y = pk_h2(y[2], y[3]); w.z = pk_h2(y[4], y[5]); w.w = pk_h2(y[6], y[7]);
                        *(u32x4*)(base + (size_t)(ai * HALF + m * 16) * 8192 + bj * HALF) = w; }
            }
        } else if (t == 0 || t == 4) {
#pragma unroll
            for (int ai = 0; ai < 2; ++ai)
#pragma unroll
                for (int m = 0; m < 4; ++m)
#pragma unroll
                    for (int bj = 0; bj < 2; ++bj) { float y[8];
#pragma unroll
                        for (int j = 0; j < 8; ++j) y[j] = fsilu(acc[ai][bj][m][j >> 2][j & 3]);
                        u32x4 w; w.x = cvt_pk_bf16(y[0], y[1]); w.y = cvt_pk_bf16(y[2], y[3]); w.z = cvt_pk_bf16(y[4], y[5]); w.w = cvt_pk_bf16(y[6], y[7]);
                        *(u32x4*)(base + (size_t)(ai * HALF + m * 16) * 8192 + bj * HALF) = w; }
        } else {
            const float sc = (t == 5) ? 0.18033688011112042f : 1.0f;
#pragma unroll
            for (int ai = 0; ai < 2; ++ai)
#pragma unroll
                for (int m = 0; m < 4; ++m)
#pragma unroll
                    for (int bj = 0; bj < 2; ++bj) { const f32x4 v0 = acc[ai][bj][m][0] * sc, v1 = acc[ai][bj][m][1] * sc;
                        u32x4 w; w.x = cvt_pk_bf16(v0[0], v0[1]); w.y = cvt_pk_bf16(v0[2], v0[3]); w.z = cvt_pk_bf16(v1[0], v1[1]); w.w = cvt_pk_bf16(v1[2], v1[3]);
                        *(u32x4*)(base + (size_t)(ai * HALF + m * 16) * 8192 + bj * HALF) = w; }
        }
    }
};
struct EpiOutProj {
    static constexpr bool PERM = false, AFTER_DRAIN = false;
    const float* x; float* out; bf16_t* h1b; float* part;
    __device__ __forceinline__ void operator()(const f32x4 (&acc)[2][2][4][2], const Unit& u, int wr, int wc, int fr, int fq) const {
        const int row0 = u.pm * BM + wr * 64 + fr, col0 = u.pn * BM + wc * 32 + 4 * fq;
#pragma unroll
        for (int ai = 0; ai < 2; ++ai)
#pragma unroll
            for (int m = 0; m < 4; ++m) { const int row = row0 + ai * HALF + m * 16; const size_t off = (size_t)row * 2048 + col0; float ss = 0.f;
#pragma unroll
                for (int bj = 0; bj < 2; ++bj)
#pragma unroll
                    for (int n = 0; n < 2; ++n) { const size_t o = off + bj * HALF + n * 16; const f32x4 h = *(const f32x4*)(x + o) + acc[ai][bj][m][n];
                        *(f32x4*)(out + o) = h; ss += (h[0] * h[0] + h[1] * h[1]) + (h[2] * h[2] + h[3] * h[3]);
                        uint2 w; w.x = cvt_pk_bf16(h[0], h[1]); w.y = cvt_pk_bf16(h[2], h[3]); *(uint2*)(h1b + o) = w; }
                ss += __shfl_xor(ss, 16); ss += __shfl_xor(ss, 32);
                if (fq == 0) part[(size_t)row * 32 + u.pn * 4 + wc] = ss; }
    }
};
struct EpiSwiGLU {
    static constexpr bool PERM = true, AFTER_DRAIN = false;
    bf16_t* hid; const PG8_LAS float* rtab; int pm_tab; const float* part;
    __device__ __forceinline__ void operator()(const f32x4 (&acc)[2][2][4][2], const Unit& u, int wr, int wc, int fr, int fq) const {
        const int rt0 = wr * 64 + fr, col0 = u.pn * HALF + wc * 32 + 8 * fq;
#pragma unroll
        for (int ai = 0; ai < 2; ++ai)
#pragma unroll
            for (int m = 0; m < 4; ++m) { const int rt = rt0 + ai * HALF + m * 16; float r;
                if (u.pm == pm_tab) r = rtab[rt];
                else { const f32x4* p = (const f32x4*)(part + (size_t)(u.pm * BM + rt) * 32); float s = 0.f;
#pragma unroll
                    for (int j = 0; j < 8; ++j) { const f32x4 q = p[j]; s += (q[0] + q[1]) + (q[2] + q[3]); }
                    r = __builtin_amdgcn_rsqf(s * (1.0f / 2048.0f) + 1e-6f); }
                float y[8];
#pragma unroll
                for (int j = 0; j < 8; ++j) { const float g = acc[ai][0][m][j >> 2][j & 3] * r, up = acc[ai][1][m][j >> 2][j & 3] * r; y[j] = fsilu(g) * up; }
                u32x4 w; w.x = cvt_pk_bf16(y[0], y[1]); w.y = cvt_pk_bf16(y[2], y[3]); w.z = cvt_pk_bf16(y[4], y[5]); w.w = cvt_pk_bf16(y[6], y[7]);
                *(u32x4*)(hid + (size_t)(u.pm * BM + rt) * 5632 + col0) = w; }
    }
};
struct EpiDown {
    static constexpr bool PERM = false, AFTER_DRAIN = false;
    float* out;
    __device__ __forceinline__ void operator()(const f32x4 (&acc)[2][2][4][2], const Unit& u, int wr, int wc, int fr, int fq) const {
        const int row0 = u.pm * BM + wr * 64 + fr, col0 = u.pn * BM + wc * 32 + 4 * fq;
#pragma unroll
        for (int ai = 0; ai < 2; ++ai)
#pragma unroll
            for (int m = 0; m < 4; ++m) { float* rowp = out + (size_t)(row0 + ai * HALF + m * 16) * 2048 + col0;
#pragma unroll
                for (int bj = 0; bj < 2; ++bj)
#pragma unroll
                    for (int n = 0; n < 2; ++n) { f32x4* p = (f32x4*)(rowp + bj * HALF + n * 16); *p = *p + acc[ai][bj][m][n]; } }
    }
};

template <class Epi, class Sched, bool ALIGN_EPI = false, bool SP2 = false>
__device__ __forceinline__ void gemm_phase(PG8_LAS unsigned char* lds, const Gemm g, const Sched& S, const Epi& E) {
    const int tid = threadIdx.x, wid = __builtin_amdgcn_readfirstlane(tid >> 6), lane = tid & 63, wr = wid >> 2, wc = wid & 3, fr = lane & 15, fq = lane >> 4;
    const int K = g.K, nt = K / BK;
    unsigned voffA[2], voffB[2];
#pragma unroll
    for (int i = 0; i < 2; ++i) { int R, C; stage_rc(tid * 16 + i * 8192, R, C); const int Rb = Epi::PERM ? ((R & ~31) + perm32(R & 31)) : R;
        voffA[i] = (unsigned)(R * K + C) * 2u; voffB[i] = (unsigned)(Rb * K + C) * 2u; }
    const size_t kstep = (size_t)(BK * 2);
    const size_t hstep = (size_t)HALF * K * 2;
    const size_t tstep = 2 * hstep;
    const unsigned ldsw = (unsigned)wid * 1024u;
    const int aoff = lds_byte(wr * 64 + fr, fq * 8), boff = lds_byte(wc * 32 + fr, fq * 8);
#define PG8_SA(b, h) (((b) * 2 + (h)) * HTB)
#define PG8_SB(b, h) ((4 + (b) * 2 + (h)) * HTB)
#define PG8_STAGE(bufoff, gbase, voff) do { _Pragma("unroll") for (int _i = 0; _i < 2; ++_i) \
        __builtin_amdgcn_global_load_lds((const unsigned*)((const char*)(gbase) + (voff)[_i]), (PG8_LAS unsigned*)(lds + (bufoff) + ldsw + _i * 8192), 16, 0, 0); } while (0)
#define PG8_LDA(dst, b, h) do { _Pragma("unroll") for (int m = 0; m < 4; ++m) _Pragma("unroll") for (int k = 0; k < 2; ++k) dst[m][k] = *(const PG8_LAS bf16x8*)(lds + PG8_SA(b, h) + aoff + m * 2048 + k * 1024); } while (0)
#define PG8_LDB(dst, b, h) do { _Pragma("unroll") for (int n = 0; n < 2; ++n) _Pragma("unroll") for (int k = 0; k < 2; ++k) dst[n][k] = *(const PG8_LAS bf16x8*)(lds + PG8_SB(b, h) + boff + n * 2048 + k * 1024); } while (0)
#define PG8_MMA(ai, bj, At, Bt) do { __builtin_amdgcn_s_setprio(1); _Pragma("unroll") for (int m = 0; m < 4; ++m) _Pragma("unroll") for (int n = 0; n < 2; ++n) _Pragma("unroll") for (int k = 0; k < 2; ++k) \
        acc[ai][bj][m][n] = __builtin_amdgcn_mfma_f32_16x16x32_bf16(Bt[n][k], At[m][k], acc[ai][bj][m][n], 0, 0, 0); __builtin_amdgcn_s_setprio(0); } while (0)
#define PG8_WAIT_V(n) asm volatile("s_waitcnt vmcnt(" #n ")" ::: "memory")
#define PG8_WAIT_L(n) asm volatile("s_waitcnt lgkmcnt(" #n ")" ::: "memory")
#define PG8_BAR __builtin_amdgcn_s_barrier()
#define PG8_SCHED __builtin_amdgcn_sched_barrier(0)
    Unit cur, nxt; int ui = 0;
    if (!S.next(0, cur)) return;
    f32x4 acc[2][2][4][2];
#pragma unroll
    for (int a = 0; a < 2; ++a)
#pragma unroll
        for (int b = 0; b < 2; ++b)
#pragma unroll
            for (int m = 0; m < 4; ++m)
#pragma unroll
                for (int n = 0; n < 2; ++n) acc[a][b][m][n] = (f32x4){0.f, 0.f, 0.f, 0.f};
    bf16x8 At[4][2], B0[2][2], B1[2][2];
    const char* cA = (const char*)g.A + (size_t)cur.pm * tstep; const char* cB = (const char*)g.Bt + (size_t)cur.pn * tstep;
    S.a_ready(cur);
    if constexpr (SP2) {
        PG8_STAGE(PG8_SB(0, 0), cB, voffB); PG8_STAGE(PG8_SB(0, 1), cB + hstep, voffB); PG8_STAGE(PG8_SA(0, 0), cA, voffA); PG8_STAGE(PG8_SA(0, 1), cA + hstep, voffA);
        if (wr == 1) PG8_BAR;
        PG8_WAIT_V(2); PG8_BAR;
        PG8_STAGE(PG8_SB(1, 0), cB + kstep, voffB); PG8_STAGE(PG8_SA(1, 0), cA + kstep, voffA); PG8_STAGE(PG8_SB(1, 1), cB + hstep + kstep, voffB);
        PG8_WAIT_V(6); PG8_BAR;
    } else {
        PG8_STAGE(PG8_SB(0, 0), cB, voffB); PG8_STAGE(PG8_SA(0, 0), cA, voffA); PG8_STAGE(PG8_SB(0, 1), cB + hstep, voffB); PG8_STAGE(PG8_SA(0, 1), cA + hstep, voffA);
        if (wr == 1) PG8_BAR;
        PG8_WAIT_V(4); PG8_BAR;
        PG8_STAGE(PG8_SB(1, 0), cB + kstep, voffB); PG8_STAGE(PG8_SA(1, 0), cA + kstep, voffA); PG8_STAGE(PG8_SB(1, 1), cB + hstep + kstep, voffB);
        PG8_WAIT_V(6); PG8_BAR;
    }
    for (;;) {
        const bool has_next = S.next(ui + 1, nxt);
        const char* nA = has_next ? (const char*)g.A + (size_t)nxt.pm * tstep : cA; const char* nB = has_next ? (const char*)g.Bt + (size_t)nxt.pn * tstep : cB;
        for (int t = 0; t < nt; t += 2) {
            const bool last = (t == nt - 2);
            const char* a1 = cA + (size_t)(t + 1) * kstep;
            const char* a2 = last ? nA : cA + (size_t)(t + 2) * kstep; const char* b2 = last ? nB : cB + (size_t)(t + 2) * kstep;
            const char* a3 = a2 + kstep; const char* b3 = b2 + kstep;
            if (last && has_next) S.a_ready(nxt);
            if constexpr (SP2) {
            PG8_LDB(B0, 0, 0); PG8_LDB(B1, 0, 1); PG8_SCHED; PG8_LDA(At, 0, 0); PG8_STAGE(PG8_SA(1, 1), a1 + hstep, voffA);
            PG8_WAIT_V(8); PG8_WAIT_L(0); PG8_BAR; PG8_MMA(0, 0, At, B0); PG8_MMA(0, 1, At, B1); PG8_BAR; PG8_SCHED;
            PG8_LDA(At, 0, 1); PG8_STAGE(PG8_SB(0, 0), b2, voffB); PG8_STAGE(PG8_SB(0, 1), b2 + hstep, voffB); PG8_STAGE(PG8_SA(0, 0), a2, voffA);
            PG8_WAIT_V(8); PG8_WAIT_L(0); PG8_BAR; PG8_MMA(1, 0, At, B0); PG8_MMA(1, 1, At, B1); PG8_BAR; PG8_SCHED;
            PG8_LDB(B0, 1, 0); PG8_LDB(B1, 1, 1); PG8_SCHED; PG8_LDA(At, 1, 0); PG8_STAGE(PG8_SA(0, 1), a2 + hstep, voffA);
            PG8_WAIT_V(8); PG8_WAIT_L(0); PG8_BAR; PG8_MMA(0, 0, At, B0); PG8_MMA(0, 1, At, B1); PG8_BAR; PG8_SCHED;
            PG8_LDA(At, 1, 1); PG8_STAGE(PG8_SB(1, 0), b3, voffB); PG8_STAGE(PG8_SB(1, 1), b3 + hstep, voffB); PG8_STAGE(PG8_SA(1, 0), a3, voffA);
            PG8_WAIT_V(8); PG8_WAIT_L(0); PG8_BAR; PG8_MMA(1, 0, At, B0); PG8_MMA(1, 1, At, B1); PG8_BAR; PG8_SCHED;
            } else {
            PG8_LDB(B0, 0, 0); PG8_SCHED; PG8_LDA(At, 0, 0); PG8_STAGE(PG8_SA(1, 1), a1 + hstep, voffA);
            PG8_WAIT_L(8); PG8_BAR; PG8_WAIT_L(0); PG8_MMA(0, 0, At, B0); PG8_BAR; PG8_SCHED;
            PG8_LDB(B1, 0, 1); PG8_STAGE(PG8_SB(0, 0), b2, voffB);
            PG8_BAR; PG8_WAIT_L(0); PG8_MMA(0, 1, At, B1); PG8_BAR;
            PG8_LDA(At, 0, 1); PG8_STAGE(PG8_SA(0, 0), a2, voffA);
            PG8_BAR; PG8_WAIT_L(0); PG8_MMA(1, 0, At, B0); PG8_BAR; PG8_SCHED;
            PG8_STAGE(PG8_SB(0, 1), b2 + hstep, voffB);
            PG8_WAIT_V(6); PG8_BAR; PG8_MMA(1, 1, At, B1); PG8_BAR;
            PG8_LDB(B0, 1, 0); PG8_SCHED; PG8_LDA(At, 1, 0); PG8_STAGE(PG8_SA(0, 1), a2 + hstep, voffA);
            PG8_WAIT_L(8); PG8_BAR; PG8_WAIT_L(0); PG8_MMA(0, 0, At, B0); PG8_BAR; PG8_SCHED;
            PG8_LDB(B1, 1, 1); PG8_STAGE(PG8_SB(1, 0), b3, voffB);
            PG8_BAR; PG8_WAIT_L(0); PG8_MMA(0, 1, At, B1); PG8_BAR;
            PG8_LDA(At, 1, 1); PG8_STAGE(PG8_SA(1, 0), a3, voffA);
            PG8_BAR; PG8_WAIT_L(0); PG8_MMA(1, 0, At, B0); PG8_BAR; PG8_SCHED;
            PG8_STAGE(PG8_SB(1, 1), b3 + hstep, voffB);
            PG8_WAIT_V(6); PG8_BAR; PG8_MMA(1, 1, At, B1); PG8_BAR;
            }
        }
        if constexpr (ALIGN_EPI) { if (wr == 0) PG8_BAR; }
        if constexpr (!Epi::AFTER_DRAIN) { E(acc, cur, wr, wc, fr, fq); S.done(cur); }
        if (!has_next) break;
#pragma unroll
        for (int a = 0; a < 2; ++a)
#pragma unroll
            for (int b = 0; b < 2; ++b)
#pragma unroll
                for (int m = 0; m < 4; ++m)
#pragma unroll
                    for (int n = 0; n < 2; ++n) acc[a][b][m][n] = (f32x4){0.f, 0.f, 0.f, 0.f};
        cur = nxt; cA = nA; cB = nB; ++ui;
        if constexpr (ALIGN_EPI) { if (wr == 1) PG8_BAR; }
    }
    PG8_WAIT_V(0);
    if constexpr (!ALIGN_EPI) { if (wr == 0) PG8_BAR; }
    PG8_BAR;
    if constexpr (Epi::AFTER_DRAIN) { E.fused(acc, cur, wr, wc, fr, fq, lds, wid, lane); S.done(cur); }
#undef PG8_SA
#undef PG8_SB
#undef PG8_STAGE
#undef PG8_LDA
#undef PG8_LDB
#undef PG8_MMA
#undef PG8_WAIT_V
#undef PG8_WAIT_L
#undef PG8_BAR
#undef PG8_SCHED
}
}

#ifndef PG8_SP2
#define PG8_SP2 true
#endif
#ifndef PG8_ALIGN
#define PG8_ALIGN true
#endif
constexpr int RING_OFF = 0, RING_BYTES = 131072;
constexpr int LDSCTL_OFF = RING_BYTES, MISC_OFF = LDSCTL_OFF + 320;
constexpr int RTAB_OFF = RING_BYTES + 1024;
constexpr int LDS_BYTES = 147456;
constexpr int NWAVES = 8;
constexpr int CW_BAR = 4096;

#define GAS __attribute__((address_space(1)))
#define LAS __attribute__((address_space(3)))
typedef unsigned v4u __attribute__((ext_vector_type(4)));
typedef float f32x4 __attribute__((ext_vector_type(4)));
typedef GAS unsigned gu32;
#define LDS_WAIT() asm volatile("s_waitcnt lgkmcnt(0)" ::: "memory")
#define VM_WAIT() asm volatile("s_waitcnt vmcnt(0)" ::: "memory")
__device__ __forceinline__ unsigned f2bf_u(float f) { unsigned u = __builtin_bit_cast(unsigned, f); return (u + 0x7fffu + ((u >> 16) & 1u)) >> 16; }
__device__ __forceinline__ unsigned pk2(float lo, float hi) { return f2bf_u(lo) | (f2bf_u(hi) << 16); }
__device__ __forceinline__ float wave_sum(float v) {
#pragma unroll
    for (int o = 1; o < 64; o <<= 1) v += __shfl_xor(v, o);
    return v;
}

#define XB_TMO      128
#define XB_XCNT(j)  (256  + 64 * (j))
#define XB_XSUB(j)  (1280 + 64 * (j))
#define XB_XGEN(j)  (2304 + 64 * (j))
#define XB_TOP      3328
#define XB_TOPGEN   3392
#define XCD_BAR_WORDS 3456
#define XB_SPIN_CAP (1u << 18)

__device__ __forceinline__ unsigned xb_ld(unsigned* p)              { return __hip_atomic_load(p, __ATOMIC_RELAXED, __HIP_MEMORY_SCOPE_AGENT); }
__device__ __forceinline__ unsigned xb_add(unsigned* p, unsigned v) { return __hip_atomic_fetch_add(p, v, __ATOMIC_RELAXED, __HIP_MEMORY_SCOPE_AGENT); }
__device__ __forceinline__ unsigned xb_xcc_id() { return (unsigned)__builtin_amdgcn_s_getreg((3 << 11) | 20) & 0xFu; }
#define XB_SPIN(cond, bar) do { unsigned _sp = 0; while (cond) { __builtin_amdgcn_s_sleep(1); \
    if ((++_sp & 255u) == 0u) { if (xb_ld(&(bar)[XB_TMO])) break; if (_sp > XB_SPIN_CAP) { atomicAdd(&(bar)[XB_TMO], 1u); break; } } } } while (0)

struct XcdBarrier {
    unsigned* bar; unsigned x;
    volatile LAS unsigned* st;
};

__device__ __forceinline__ XcdBarrier xcd_barrier_post(unsigned* bar, volatile LAS unsigned* st) {
    XcdBarrier b; b.bar = bar; b.x = xb_xcc_id(); b.st = st;
    if (threadIdx.x == 0) (void)xb_add(&bar[XB_XCNT(b.x)], 1u);
    return b;
}
__device__ __forceinline__ void xcd_barrier_complete(unsigned* bar, unsigned x, unsigned& nloc, unsigned& nx) {
    const unsigned G = gridDim.x * gridDim.y * gridDim.z;
    unsigned sum, cnt, mine, sp = 0u;
    for (;;) {
        sum = 0u; cnt = 0u; mine = 0u;
#pragma unroll
        for (unsigned j = 0; j < 16; ++j) { const unsigned c = xb_ld(&bar[XB_XCNT(j)]); sum += c; cnt += (c > 0u) ? 1u : 0u; mine = (j == x) ? c : mine; }
        if (sum == G) break;
        __builtin_amdgcn_s_sleep(1);
        if ((++sp & 255u) == 0u) { if (xb_ld(&bar[XB_TMO])) break; if (sp > XB_SPIN_CAP) { atomicAdd(&bar[XB_TMO], 1u); break; } }
    }
    nloc = mine > 0u ? mine : 1u; nx = cnt > 0u ? cnt : 1u;
}

__device__ __forceinline__ void xcd_barrier(const XcdBarrier& b) {
    asm volatile("s_waitcnt vmcnt(0)" ::: "memory");
    __syncthreads();
    if (threadIdx.x == 0) {
        unsigned* bar = b.bar;
        __builtin_amdgcn_s_waitcnt(0);
        unsigned nloc = b.st[0], nx = b.st[1];
        if (nloc == 0u) { xcd_barrier_complete(bar, b.x, nloc, nx); b.st[0] = nloc; b.st[1] = nx; }
        const unsigned old = xb_add(&bar[XB_XSUB(b.x)], 1u);
        const unsigned gen = old / nloc;
        if (old + 1u == (gen + 1u) * nloc) {
            __builtin_amdgcn_fence(__ATOMIC_RELEASE, "agent");
            asm volatile("s_waitcnt vmcnt(0)" ::: "memory");
            const unsigned og = xb_add(&bar[XB_TOP], 1u);
            const unsigned tg = og / nx;
            if (og + 1u == (tg + 1u) * nx) xb_add(&bar[XB_TOPGEN], 1u);
            else XB_SPIN(xb_ld(&bar[XB_TOPGEN]) == tg, bar);
            __builtin_amdgcn_fence(__ATOMIC_ACQUIRE, "agent");
            xb_add(&bar[XB_XGEN(b.x)], 1u);
            asm volatile("s_waitcnt vmcnt(0)" ::: "memory");
        } else {
            XB_SPIN(xb_ld(&bar[XB_XGEN(b.x)]) == gen, bar);
            __builtin_amdgcn_fence(__ATOMIC_ACQUIRE, "agent");
            asm volatile("s_waitcnt vmcnt(0)" ::: "memory");
        }
    }
    __syncthreads();
}

__device__ __forceinline__ void p0_item(const float* W, int K, int N, const float* ksc, u16* WT, LAS float* scr, int k0, int n0, int drow0, int lane) {
#pragma unroll 8
    for (int i = 0; i < 32; ++i) { const int kk = 2 * i + (lane >> 5); float w = W[(size_t)(k0 + kk) * N + n0 + (lane & 31)]; if (ksc) w *= ksc[k0 + kk]; scr[kk * 33 + (lane & 31)] = w; }
    LDS_WAIT(); asm volatile("" ::: "memory");
    const int c = lane & 7;
#pragma unroll
    for (int j = 0; j < 4; ++j) { const int n = (lane >> 3) + 8 * j; const LAS float* s = scr + (8 * c) * 33 + n;
        v4u o; o.x = pk2(s[0 * 33], s[1 * 33]); o.y = pk2(s[2 * 33], s[3 * 33]); o.z = pk2(s[4 * 33], s[5 * 33]); o.w = pk2(s[6 * 33], s[7 * 33]);
        *(GAS v4u*)(WT + (size_t)(drow0 + n) * K + k0 + 8 * c) = o; }
    LDS_WAIT(); asm volatile("" ::: "memory");
}
__device__ __forceinline__ void rms_row_to_bf16(const float* xrow, const float* w, u16* orow, int lane) {
    const f32x4* xr = (const f32x4*)xrow + lane;
    f32x4 v[8]; float s = 0.f;
#pragma unroll
    for (int j = 0; j < 8; ++j) { v[j] = xr[64 * j]; s += (v[j].x * v[j].x + v[j].y * v[j].y) + (v[j].z * v[j].z + v[j].w * v[j].w); }
    const float r = __builtin_amdgcn_rsqf(wave_sum(s) * (1.0f / DM) + EPS);
    const f32x4* wr = (const f32x4*)w + lane;
    uint2* o = (uint2*)orow + lane;
#pragma unroll
    for (int j = 0; j < 8; ++j) { const f32x4 ww = wr[64 * j]; uint2 p; p.x = pk2(v[j].x * r * ww.x, v[j].y * r * ww.y); p.y = pk2(v[j].z * r * ww.z, v[j].w * r * ww.w); o[64 * j] = p; }
}
__device__ __forceinline__ void rms_row_inplace(float* xrow, const float* w, int lane) {
    f32x4* xr = (f32x4*)xrow + lane;
    f32x4 v[8]; float s = 0.f;
#pragma unroll
    for (int j = 0; j < 8; ++j) { v[j] = xr[64 * j]; s += (v[j].x * v[j].x + v[j].y * v[j].y) + (v[j].z * v[j].z + v[j].w * v[j].w); }
    const float r = __builtin_amdgcn_rsqf(wave_sum(s) * (1.0f / DM) + EPS);
    const f32x4* wr = (const f32x4*)w + lane;
#pragma unroll
    for (int j = 0; j < 8; ++j) { const f32x4 ww = wr[64 * j]; xr[64 * j] = v[j] * r * ww; }
}

struct Args { const float* in[17]; float* out; unsigned char* ws; int ph_lo, ph_hi, li, pad; };
enum { PH_PRO = 0, PH_INPROJ = 1, PH_MIX = 2, PH_HGFIN = 3, PH_OUTPROJ = 4, PH_GATEUP = 5, PH_DOWN = 6, PH_FINAL = 7, PH_N = 8 };

__global__ void __launch_bounds__(NWAVES * 64, 2) mk_fwd(Args args) {
    extern __shared__ __attribute__((aligned(16))) unsigned char lds_raw[];
    LAS unsigned char* lds = (LAS unsigned char*)lds_raw;
    volatile LAS unsigned* MISC = (volatile LAS unsigned*)(lds + MISC_OFF);
    const int tid = threadIdx.x, lane = tid & 63, wave = __builtin_amdgcn_readfirstlane(tid >> 6);
    const int G = gridDim.x; const int bx = blockIdx.x; const int vcu = (G % 8 == 0) ? (bx % 8) * (G / 8) + bx / 8 : bx;
    unsigned char* ws = args.ws;
    gu32* ctl = (gu32*)(ws + WS_CTL);
    float* part = (float*)(ws + WS_PART);
    u16* WinT = (u16*)(ws + WS_WIN); u16* WoT = (u16*)(ws + WS_WO); u16* WguT = (u16*)(ws + WS_WGU); u16* WdT = (u16*)(ws + WS_WD);
    u16* XN = (u16*)(ws + WS_XN); u16* BB = (u16*)(ws + WS_B); u16* PROJ = (u16*)(ws + WS_PROJ);
    for (int u = tid; u < (LDS_BYTES - LDSCTL_OFF) / 4; u += NWAVES * 64) ((LAS unsigned*)(lds + LDSCTL_OFF))[u] = 0u;
    __syncthreads();
    XcdBarrier bar = xcd_barrier_post((unsigned*)(ctl + CW_BAR) + args.li * XCD_BAR_WORDS, MISC + 8);
    const int lo = args.ph_lo, hi = args.ph_hi;
#define IN(k) (lo <= (k) && (k) < hi)
#define SEAM(k) do { if (IN(k) && (k) + 1 < hi) xcd_barrier(bar); } while (0)
    const int gw = vcu * NWAVES + wave, NGW = G * NWAVES;

    if (IN(PH_PRO)) {
        LAS float* scr = (LAS float*)(lds + RING_OFF + wave * 16384);
        constexpr int I_IN = (DM / 64) * (INC / 32), I_O = (DM / 64) * (DM / 32), I_G = (DM / 64) * (DFF / 32), I_D = (DFF / 64) * (DM / 32);
        constexpr int NITEMS = I_IN + I_O + 2 * I_G + I_D;
        for (int it = gw; it < NITEMS; it += NGW) {
            int r = it;
            if (r < I_IN) { const int nblk = INC / 32, k0 = 64 * (r / nblk), n0 = 32 * (r % nblk); p0_item(args.in[2], DM, INC, nullptr, WinT, scr, k0, n0, n0, lane); continue; } r -= I_IN;
            if (r < I_O) { const int nblk = DM / 32, k0 = 64 * (r / nblk), n0 = 32 * (r % nblk); p0_item(args.in[11], DM, DM, nullptr, WoT, scr, k0, n0, n0, lane); continue; } r -= I_O;
            if (r < 2 * I_G) { const int up = r >= I_G ? 1 : 0; if (up) r -= I_G; const int nblk = DFF / 32, k0 = 64 * (r / nblk), n0 = 32 * (r % nblk);
                p0_item(args.in[up ? 14 : 13], DM, DFF, args.in[12], WguT, scr, k0, n0, 256 * (n0 >> 7) + 128 * up + (n0 & 127), lane); continue; } r -= 2 * I_G;
            { const int nblk = DM / 32, k0 = 64 * (r / nblk), n0 = 32 * (r % nblk); p0_item(args.in[15], DFF, DM, nullptr, WdT, scr, k0, n0, n0, lane); }
        }
        for (int m = gw; m < M; m += NGW) rms_row_to_bf16(args.in[0] + (size_t)m * DM, args.in[1], XN + (size_t)m * DM, lane);
    }
    SEAM(PH_PRO);
    if (IN(PH_INPROJ)) {
        pg8::Gemm g{XN, WinT, M, INC, DM}; pg8::StaticOrder S; S.init(M, INC, G, bx);
        pg8::EpiInProj E{PROJ, args.in[3]};
        pg8::gemm_phase<pg8::EpiInProj, pg8::StaticOrder, PG8_ALIGN, PG8_SP2>(lds + RING_OFF, g, S, E);
    }
    SEAM(PH_INPROJ);
    if (IN(PH_OUTPROJ)) {
        pg8::Gemm g{XN, WoT, M, DM, DM}; pg8::StaticOrder S; S.init(M, DM, G, bx);
        pg8::EpiOutProj E{args.in[0], args.out, BB, part};
        pg8::gemm_phase<pg8::EpiOutProj, pg8::StaticOrder, PG8_ALIGN, PG8_SP2>(lds + RING_OFF, g, S, E);
    }
    SEAM(PH_OUTPROJ);
    if (IN(PH_GATEUP)) {
        pg8::Gemm g{BB, WguT, M, NGU, DM}; pg8::StaticOrder S; S.init(M, NGU, G, bx);
        pg8::Unit u0; u0.pm = 0; u0.pn = 0; (void)S.next(0, u0);
        LAS float* rtab = (LAS float*)(lds + RTAB_OFF);
        if (tid < 256) { const GAS f32x4* p = (const GAS f32x4*)(part + (size_t)(u0.pm * 256 + tid) * 32); float s = 0.f;
#pragma unroll
            for (int j = 0; j < 8; ++j) { const f32x4 q = p[j]; s += (q[0] + q[1]) + (q[2] + q[3]); }
            rtab[tid] = __builtin_amdgcn_rsqf(s * (1.0f / DM) + EPS); }
        __syncthreads();
        pg8::EpiSwiGLU E{PROJ, (const LAS float*)rtab, u0.pm, part};
        pg8::gemm_phase<pg8::EpiSwiGLU, pg8::StaticOrder, PG8_ALIGN, PG8_SP2>(lds + RING_OFF, g, S, E);
    }
    SEAM(PH_GATEUP);
    if (IN(PH_DOWN)) {
        pg8::Gemm g{PROJ, WdT, M, DM, DFF}; pg8::StaticOrder S; S.init(M, DM, G, bx);
        pg8::EpiDown E{args.out};
        pg8::gemm_phase<pg8::EpiDown, pg8::StaticOrder, PG8_ALIGN, PG8_SP2>(lds + RING_OFF, g, S, E);
    }
    SEAM(PH_DOWN);
    if (IN(PH_FINAL)) {
        for (int m = gw; m < M; m += NGW) rms_row_inplace(args.out + (size_t)m * DM, args.in[16], lane);
    }
#undef IN
#undef SEAM
}

__device__ __forceinline__ u16 f2bf(float f) { unsigned u = __float_as_uint(f); u += 0x7fffu + ((u >> 16) & 1u); return (u16)(u >> 16); }
__device__ __forceinline__ float bf2f(u16 h) { return __uint_as_float(((unsigned)h) << 16); }
__device__ __forceinline__ u16 f2h(float f) { return __builtin_bit_cast(u16, (_Float16)f); }
__device__ __forceinline__ float h2f(u16 h) { return (float)__builtin_bit_cast(_Float16, h); }
typedef unsigned u32x4 __attribute__((ext_vector_type(4)));
__global__ __launch_bounds__(128) void k_hgrn(const u16* __restrict__ proj, u16* __restrict__ odir) {
    const int seq = blockIdx.x, dir = seq & 1, h = (seq >> 1) & 7, b = seq >> 4, c = threadIdx.x;
    __shared__ float sq[2][128], sf[2][128], sk[2][128];
    float S[128];
#pragma unroll
    for (int k = 0; k < 128; ++k) S[k] = 0.f;
    for (int step = 0; step < SEQ; ++step) {
        const int t = dir ? (SEQ - 1 - step) : step, buf = step & 1;
        const size_t m = (size_t)b * SEQ + t;
        const u16* row = proj + m * INC;
        const float q = bf2f(row[h * 128 + c]), lf = h2f(row[2048 + dir * 1024 + h * 128 + c]), v = bf2f(row[1024 + h * 128 + c]);
        sq[buf][c] = q; sf[buf][c] = __expf(lf); sk[buf][c] = -expm1f(lf);
        __syncthreads();
        float o = 0.f;
#pragma unroll
        for (int k = 0; k < 128; k += 4) {
            const f32x4 f4 = *(const f32x4*)&sf[buf][k], k4 = *(const f32x4*)&sk[buf][k], q4 = *(const f32x4*)&sq[buf][k];
            S[k] = f4.x * S[k] + k4.x * v; o += q4.x * S[k];
            S[k + 1] = f4.y * S[k + 1] + k4.y * v; o += q4.y * S[k + 1];
            S[k + 2] = f4.z * S[k + 2] + k4.z * v; o += q4.z * S[k + 2];
            S[k + 3] = f4.w * S[k + 3] + k4.w * v; o += q4.w * S[k + 3];
        }
        odir[((size_t)dir * M + m) * HGW + h * 128 + c] = f2bf(o);
    }
}
__global__ __launch_bounds__(256) void k_hgrn_fin(const u16* __restrict__ odir, const u16* __restrict__ proj, const float* __restrict__ w, u16* __restrict__ cat) {
    const int gw = blockIdx.x * 4 + (threadIdx.x >> 6), lane = threadIdx.x & 63;
    const int m = gw >> 3, h = gw & 7, c = h * 128 + lane * 2;
    const unsigned a = *(const unsigned*)(odir + (size_t)m * HGW + c), bb = *(const unsigned*)(odir + ((size_t)M + m) * HGW + c);
    const float o0 = bf2f((u16)a) + bf2f((u16)bb), o1 = bf2f((u16)(a >> 16)) + bf2f((u16)(bb >> 16));
    const float r = rsqrtf(wave_sum(o0 * o0 + o1 * o1) * (1.0f / 128.0f) + EPS);
    const unsigned g = *(const unsigned*)(proj + (size_t)m * INC + 4096 + c);
    const float y0 = o0 * r * w[lane * 2] * bf2f((u16)g), y1 = o1 * r * w[lane * 2 + 1] * bf2f((u16)(g >> 16));
    *(unsigned*)(cat + (size_t)m * DM + c) = (unsigned)f2bf(y0) | ((unsigned)f2bf(y1) << 16);
}

__device__ __forceinline__ int rel_bucket(int rel) {
    const int n = rel < 0 ? -rel : rel; int bk;
    if (n < 8) bk = n; else if (n < 12) bk = 8; else if (n < 16) bk = 9; else if (n < 23) bk = 10; else if (n < 32) bk = 11;
    else if (n < 46) bk = 12; else if (n < 64) bk = 13; else if (n < 91) bk = 14; else bk = 15;
    return bk + (rel > 0 ? 16 : 0);
}
__global__ __launch_bounds__(256) void k_attn(const u16* __restrict__ proj, const float* __restrict__ rel_bias, float* __restrict__ On) {
    const int qb = blockIdx.x, h = blockIdx.y, b = blockIdx.z >> 1, mp = blockIdx.z & 1, tid = threadIdx.x;
    const int qpos = qb * 256 + tid; const size_t m = (size_t)b * SEQ + qpos;
    __shared__ float sk[32][64];
    __shared__ float sv[32][128];
    __shared__ float sb[32];
    float q[64], o[128];
    { const u16* qp = proj + m * INC + 5120 + h * 128 + mp * 64;
#pragma unroll
      for (int d = 0; d < 64; ++d) q[d] = bf2f(qp[d]); }
#pragma unroll
    for (int d = 0; d < 128; ++d) o[d] = 0.f;
    if (tid < 32) sb[tid] = rel_bias[tid * 8 + h] * LOG2E;
    float mx = -1e30f, l = 0.f;
    const int lk = tid >> 3, ld8 = (tid & 7) * 8, ld16 = (tid & 7) * 16;
    for (int kt = 0; kt < SEQ / 32; ++kt) {
        const u16* kr = proj + ((size_t)b * SEQ + kt * 32 + lk) * INC;
        const u32x4 kv = *(const u32x4*)(kr + 6144 + h * 128 + mp * 64 + ld8);
        const u32x4 v0 = *(const u32x4*)(kr + 7168 + h * 128 + ld16), v1 = *(const u32x4*)(kr + 7168 + h * 128 + ld16 + 8);
        __syncthreads();
        { float* d = &sk[lk][ld8];
          d[0] = __uint_as_float(kv.x << 16); d[1] = __uint_as_float(kv.x & 0xffff0000u); d[2] = __uint_as_float(kv.y << 16); d[3] = __uint_as_float(kv.y & 0xffff0000u);
          d[4] = __uint_as_float(kv.z << 16); d[5] = __uint_as_float(kv.z & 0xffff0000u); d[6] = __uint_as_float(kv.w << 16); d[7] = __uint_as_float(kv.w & 0xffff0000u);
          float* e = &sv[lk][ld16];
          e[0] = __uint_as_float(v0.x << 16); e[1] = __uint_as_float(v0.x & 0xffff0000u); e[2] = __uint_as_float(v0.y << 16); e[3] = __uint_as_float(v0.y & 0xffff0000u);
          e[4] = __uint_as_float(v0.z << 16); e[5] = __uint_as_float(v0.z & 0xffff0000u); e[6] = __uint_as_float(v0.w << 16); e[7] = __uint_as_float(v0.w & 0xffff0000u);
          e[8] = __uint_as_float(v1.x << 16); e[9] = __uint_as_float(v1.x & 0xffff0000u); e[10] = __uint_as_float(v1.y << 16); e[11] = __uint_as_float(v1.y & 0xffff0000u);
          e[12] = __uint_as_float(v1.z << 16); e[13] = __uint_as_float(v1.z & 0xffff0000u); e[14] = __uint_as_float(v1.w << 16); e[15] = __uint_as_float(v1.w & 0xffff0000u); }
        __syncthreads();
        for (int j = 0; j < 32; ++j) {
            float s = 0.f;
#pragma unroll
            for (int d = 0; d < 64; d += 4) { const f32x4 k4 = *(const f32x4*)&sk[j][d]; s += q[d] * k4.x + q[d + 1] * k4.y + q[d + 2] * k4.z + q[d + 3] * k4.w; }
            s += sb[rel_bucket(kt * 32 + j - qpos)];
            if (s > mx) { const float al = exp2f(mx - s); l *= al;
#pragma unroll
                for (int d = 0; d < 128; ++d) o[d] *= al;
                mx = s; }
            const float p = exp2f(s - mx); l += p;
#pragma unroll
            for (int d = 0; d < 128; d += 4) { const f32x4 v4 = *(const f32x4*)&sv[j][d]; o[d] += p * v4.x; o[d + 1] += p * v4.y; o[d + 2] += p * v4.z; o[d + 3] += p * v4.w; }
        }
    }
    const float il = 1.0f / l;
    float* op = On + ((size_t)mp * M + m) * DAW + h * 128;
#pragma unroll
    for (int d = 0; d < 128; d += 4) *(f32x4*)(op + d) = (f32x4){o[d] * il, o[d + 1] * il, o[d + 2] * il, o[d + 3] * il};
}
__global__ __launch_bounds__(256) void k_attn_fin(const float* __restrict__ On, const float* __restrict__ lq1, const float* __restrict__ lk1, const float* __restrict__ lq2, const float* __restrict__ lk2,
                                                  const float* __restrict__ w, u16* __restrict__ cat) {
    const int gw = blockIdx.x * 4 + (threadIdx.x >> 6), lane = threadIdx.x & 63;
    const int m = gw >> 3, h = gw & 7, c = h * 128 + lane * 2;
    const float lam = __expf(wave_sum(lq1[lane] * lk1[lane])) - __expf(wave_sum(lq2[lane] * lk2[lane])) + 0.2f;
    const float2 a = *(const float2*)(On + (size_t)m * DAW + c), bb = *(const float2*)(On + ((size_t)M + m) * DAW + c);
    const float o0 = a.x - lam * bb.x, o1 = a.y - lam * bb.y;
    const float r = rsqrtf(wave_sum(o0 * o0 + o1 * o1) * (1.0f / 128.0f) + EPS) * 0.8f;
    *(unsigned*)(cat + (size_t)m * DM + 1024 + c) = (unsigned)f2bf(o0 * r * w[lane * 2]) | ((unsigned)f2bf(o1 * r * w[lane * 2 + 1]) << 16);
}

extern "C" void kernel_launch(void* const* d_in, const int* in_sizes, int n_in, void* d_out, int out_size, void* d_ws, size_t ws_size, hipStream_t stream) {
    static int grid = 0;
    if (grid == 0) {
        if (n_in != 17 || ws_size < WS_NEED || out_size != M * DM) { fprintf(stderr, "kernel_launch: unexpected shapes (n_in %d, ws %zu, out %d)\n", n_in, ws_size, out_size); grid = -1; return; }
        int dev = 0, cus = 0;
        if (hipGetDevice(&dev) != hipSuccess || hipDeviceGetAttribute(&cus, hipDeviceAttributeMultiprocessorCount, dev) != hipSuccess) { grid = -1; return; }
        if (hipFuncSetAttribute((const void*)mk_fwd, hipFuncAttributeMaxDynamicSharedMemorySize, LDS_BYTES) != hipSuccess) { fprintf(stderr, "kernel_launch: hipFuncSetAttribute failed\n"); grid = -1; return; }
        (void)hipGetLastError();
        grid = cus;
    }
    if (grid < 0) return;
    float* out = (float*)d_out; unsigned char* ws = (unsigned char*)d_ws;
    u16* XN = (u16*)(ws + WS_XN); u16* BB = (u16*)(ws + WS_B); u16* PROJ = (u16*)(ws + WS_PROJ);
    (void)hipMemsetAsync(ws + WS_CTL, 0, CTL_ZERO_BYTES, stream);
    Args a{};
    for (int i = 0; i < 17; ++i) a.in[i] = (const float*)d_in[i];
    a.out = out; a.ws = ws;
    a.ph_lo = PH_PRO; a.ph_hi = PH_MIX; a.li = 0;
    hipLaunchKernelGGL(mk_fwd, dim3(grid), dim3(NWAVES * 64), LDS_BYTES, stream, a);
    k_hgrn<<<128, 128, 0, stream>>>(PROJ, BB);
    k_attn<<<dim3(8, 8, 16), 256, 0, stream>>>(PROJ, (const float*)d_in[10], out);
    k_hgrn_fin<<<M * 8 / 4, 256, 0, stream>>>(BB, PROJ, (const float*)d_in[4], XN);
    k_attn_fin<<<M * 8 / 4, 256, 0, stream>>>(out, (const float*)d_in[5], (const float*)d_in[6], (const float*)d_in[7], (const float*)d_in[8], (const float*)d_in[9], XN);
    a.ph_lo = PH_OUTPROJ; a.ph_hi = PH_N; a.li = 1;
    hipLaunchKernelGGL(mk_fwd, dim3(grid), dim3(NWAVES * 64), LDS_BYTES, stream, a);
}
```

```cpp
#include <hip/hip_runtime.h>
#include <stdint.h>
#include <cstdio>

typedef unsigned short u16;
constexpr int BATCH = 8, SEQ = 2048, DM = 2048, M = BATCH * SEQ;
constexpr int HGW = 1024, DAW = 1024, INC = 8192, DFF = 5632, NGU = 2 * DFF;
constexpr float EPS = 1e-6f;
constexpr float LOG2E = 1.4426950408889634f;
constexpr float C2 = 0.125f * LOG2E;
constexpr size_t MiB = 1u << 20;
constexpr size_t WS_CTL = 0, CTL_ZERO_BYTES = 1 * MiB, WS_PART = 2 * MiB, WS_WIN = 4 * MiB, WS_WO = 36 * MiB, WS_WGU = 44 * MiB, WS_WD = 88 * MiB,
                 WS_XN = 112 * MiB, WS_B = 176 * MiB, WS_PROJ = 240 * MiB, WS_NEED = 496 * MiB;
namespace pg8 {
#define PG8_LAS __attribute__((address_space(3)))
typedef unsigned short bf16_t;
typedef short bf16x8 __attribute__((ext_vector_type(8)));
typedef float f32x4 __attribute__((ext_vector_type(4)));
typedef unsigned u32x4 __attribute__((ext_vector_type(4)));
constexpr int BM = 256, BK = 64, HALF = 128, HTB = HALF * BK * 2  , STAGE_BYTES = 8 * HTB, NXCD = 8, WGM = 8;

__host__ __device__ __forceinline__ int lds_byte(int r, int c) { const int st = (r >> 4) * 2 + (c >> 5), rr = r & 15, cc = c & 31, ob = rr * 64 + cc * 2; return st * 1024 + (ob ^ (((ob >> 9) & 1) << 5)); }
__host__ __device__ __forceinline__ void stage_rc(int b, int& R, int& C) { const int st = b / 1024, sb = b % 1024, swz = sb ^ (((sb >> 9) & 1) << 5); R = (st >> 1) * 16 + swz / 64; C = (st & 1) * 32 + (swz % 64) / 2; }
__host__ __device__ __forceinline__ int perm32(int rho) { const int n = rho >> 4, i = rho & 15; return 8 * (i >> 2) + 4 * n + (i & 3); }

struct Unit { int pm, pn; };
struct Gemm { const bf16_t* A; const bf16_t* Bt; int M, N, K; };

struct StaticOrder {
    int nM, nN, nwg, G, c;
    __host__ __device__ void init(int M, int N, int G_, int c_) { nM = M / BM; nN = N / BM; nwg = nM * nN; G = G_; c = c_; }
    __host__ __device__ bool next(int i, Unit& u) const {
        const long L = (long)i * G + c; if (L >= nwg) return false;
        int wgid = (int)L; { const int q = nwg / NXCD, r = nwg % NXCD, xcd = wgid % NXCD, off = wgid / NXCD; wgid = (xcd < r ? xcd * (q + 1) : r * (q + 1) + (xcd - r) * q) + off; }
        const int nig = WGM * nN, gid = wgid / nig, fm = gid * WGM, gsz = (nM - fm) < WGM ? (nM - fm) : WGM;
        u.pm = fm + ((wgid % nig) % gsz); u.pn = (wgid % nig) / gsz; return true;
    }
    __device__ __forceinline__ void a_ready(const Unit&) const {}
    __device__ __forceinline__ void done(const Unit&) const {}
};
__device__ __forceinline__ unsigned cvt_pk_bf16(float lo, float hi) { unsigned r; asm volatile("v_cvt_pk_bf16_f32 %0, %1, %2" : "=v"(r) : "v"(lo), "v"(hi)); return r; }
typedef float f32x2 __attribute__((ext_vector_type(2)));
__device__ __forceinline__ unsigned pk_h2(float lo, float hi) { return (unsigned)__builtin_bit_cast(unsigned short, (_Float16)lo) | ((unsigned)__builtin_bit_cast(unsigned short, (_Float16)hi) << 16); }
__device__ __forceinline__ float fsig(float x) { return __builtin_amdgcn_rcpf(1.0f + __builtin_amdgcn_exp2f(-1.4426950408889634f * x)); }
__device__ __forceinline__ float fsilu(float x) { return x * fsig(x); }
struct EpiInProj {
    static constexpr bool PERM = true, AFTER_DRAIN = false;
    bf16_t* proj; const float* lbl;
    __device__ __forceinline__ void operator()(const f32x4 (&acc)[2][2][4][2], const Unit& u, int wr, int wc, int fr, int fq) const {
        const int row0 = u.pm * BM + wr * 64 + fr, t = u.pn >> 2, col0 = u.pn * BM + wc * 32 + 8 * fq;
        bf16_t* base = proj + (size_t)row0 * 8192 + col0;
        if (t == 2 || t == 3) {
#pragma unroll
            for (int bj = 0; bj < 2; ++bj) {
                float lb[8];
                { const float* l0 = lbl + (t - 2) * 2048 + (col0 & 1023) + bj * HALF;
                  const f32x4 a0 = *(const f32x4*)(l0), a1 = *(const f32x4*)(l0 + 4), b0 = *(const f32x4*)(l0 + 1024), b1 = *(const f32x4*)(l0 + 1028);
#pragma unroll
                  for (int j = 0; j < 4; ++j) { lb[j] = fsig(a0[j] - b0[j]); lb[4 + j] = fsig(a1[j] - b1[j]); } }
#pragma unroll
                for (int ai = 0; ai < 2; ++ai)
#pragma unroll
                    for (int m = 0; m < 4; ++m) { float y[8];
#pragma unroll
                        for (int j = 0; j < 8; ++j) { const float a = acc[ai][bj][m][j >> 2][j & 3]; const float f = lb[j] + (1.0f - lb[j]) * fsig(a); y[j] = 0.6931471805599453f * __builtin_amdgcn_logf(f); }
                        u32x4 w; w.x = pk_h2(y[0], y[1]); w.y = pk_h2(y[2], y[3]); w.z = pk_h2(y[4], y[5]); w.w = pk_h2(y[6], y[7]);
                        *(u32x4*)(base + (size_t)(ai * HALF + m * 16) * 8192 + bj * HALF) = w; }
            }
        } else if (t == 0 || t == 4) {
#pragma unroll
            for (int ai = 0; ai < 2; ++ai)
#pragma unroll
                for (int m = 0; m < 4; ++m)
#pragma unroll
                    for (int bj = 0; bj < 2; ++bj) { float y[8];
#pragma unroll
                        for (int j = 0; j < 8; ++j) y[j] = fsilu(acc[ai][bj][m][j >> 2][j & 3]);
                        u32x4 w; w.x = cvt_pk_bf16(y[0], y[1]); w.y = cvt_pk_bf16(y[2], y[3]); w.z = cvt_pk_bf16(y[4], y[5]); w.w = cvt_pk_bf16(y[6], y[7]);
                        *(u32x4*)(base + (size_t)(ai * HALF + m * 16) * 8192 + bj * HALF) = w; }
        } else {
            const float sc = (t == 5) ? 0.18033688011112042f : 1.0f;
#pragma unroll
            for (int ai = 0; ai < 2; ++ai)
#pragma unroll
                for (int m = 0; m < 4; ++m)
#pragma unroll
                    for (int bj = 0; bj < 2; ++bj) { const f32x4 v0 = acc[ai][bj][m][0] * sc, v1 = acc[ai][bj][m][1] * sc;
                        u32x4 w; w.x = cvt_pk_bf16(v0[0], v0[1]); w.y = cvt_pk_bf16(v0[2], v0[3]); w.z = cvt_pk_bf16(v1[0], v1[1]); w.w = cvt_pk_bf16(v1[2], v1[3]);
                        *(u32x4*)(base + (size_t)(ai * HALF + m * 16) * 8192 + bj * HALF) = w; }
        }
    }
};
struct EpiOutProj {
    static constexpr bool PERM = false, AFTER_DRAIN = false;
    const float* x; float* out; bf16_t* h1b; float* part;
    __device__ __forceinline__ void operator()(const f32x4 (&acc)[2][2][4][2], const Unit& u, int wr, int wc, int fr, int fq) const {
        const int row0 = u.pm * BM + wr * 64 + fr, col0 = u.pn * BM + wc * 32 + 4 * fq;
#pragma unroll
        for (int ai = 0; ai < 2; ++ai)
#pragma unroll
            for (int m = 0; m < 4; ++m) { const int row = row0 + ai * HALF + m * 16; const size_t off = (size_t)row * 2048 + col0; float ss = 0.f;
#pragma unroll
                for (int bj = 0; bj < 2; ++bj)
#pragma unroll
                    for (int n = 0; n < 2; ++n) { const size_t o = off + bj * HALF + n * 16; const f32x4 h = *(const f32x4*)(x + o) + acc[ai][bj][m][n];
                        *(f32x4*)(out + o) = h; ss += (h[0] * h[0] + h[1] * h[1]) + (h[2] * h[2] + h[3] * h[3]);
                        uint2 w; w.x = cvt_pk_bf16(h[0], h[1]); w.y = cvt_pk_bf16(h[2], h[3]); *(uint2*)(h1b + o) = w; }
                ss += __shfl_xor(ss, 16); ss += __shfl_xor(ss, 32);
                if (fq == 0) part[(size_t)row * 32 + u.pn * 4 + wc] = ss; }
    }
};
struct EpiSwiGLU {
    static constexpr bool PERM = true, AFTER_DRAIN = false;
    bf16_t* hid; const PG8_LAS float* rtab; int pm_tab; const float* part;
    __device__ __forceinline__ void operator()(const f32x4 (&acc)[2][2][4][2], const Unit& u, int wr, int wc, int fr, int fq) const {
        const int rt0 = wr * 64 + fr, col0 = u.pn * HALF + wc * 32 + 8 * fq;
#pragma unroll
        for (int ai = 0; ai < 2; ++ai)
#pragma unroll
            for (int m = 0; m < 4; ++m) { const int rt = rt0 + ai * HALF + m * 16; float r;
                if (u.pm == pm_tab) r = rtab[rt];
                else { const f32x4* p = (const f32x4*)(part + (size_t)(u.pm * BM + rt) * 32); float s = 0.f;
#pragma unroll
                    for (int j = 0; j < 8; ++j) { const f32x4 q = p[j]; s += (q[0] + q[1]) + (q[2] + q[3]); }
                    r = __builtin_amdgcn_rsqf(s * (1.0f / 2048.0f) + 1e-6f); }
                float y[8];
#pragma unroll
                for (int j = 0; j < 8; ++j) { const float g = acc[ai][0][m][j >> 2][j & 3] * r, up = acc[ai][1][m][j >> 2][j & 3] * r; y[j] = fsilu(g) * up; }
                u32x4 w; w.x = cvt_pk_bf16(y[0], y[1]); w.y = cvt_pk_bf16(y[2], y[3]); w.z = cvt_pk_bf16(y[4], y[5]); w.w = cvt_pk_bf16(y[6], y[7]);
                *(u32x4*)(hid + (size_t)(u.pm * BM + rt) * 5632 + col0) = w; }
    }
};
struct EpiDown {
    static constexpr bool PERM = false, AFTER_DRAIN = false;
    float* out;
    __device__ __forceinline__ void operator()(const f32x4 (&acc)[2][2][4][2], const Unit& u, int wr, int wc, int fr, int fq) const {
        const int row0 = u.pm * BM + wr * 64 + fr, col0 = u.pn * BM + wc * 32 + 4 * fq;
#pragma unroll
        for (int ai = 0; ai < 2; ++ai)
#pragma unroll
            for (int m = 0; m < 4; ++m) { float* rowp = out + (size_t)(row0 + ai * HALF + m * 16) * 2048 + col0;
#pragma unroll
                for (int bj = 0; bj < 2; ++bj)
#pragma unroll
                    for (int n = 0; n < 2; ++n) { f32x4* p = (f32x4*)(rowp + bj * HALF + n * 16); *p = *p + acc[ai][bj][m][n]; } }
    }
};

template <class Epi, class Sched, bool ALIGN_EPI = false, bool SP2 = false>
__device__ __forceinline__ void gemm_phase(PG8_LAS unsigned char* lds, const Gemm g, const Sched& S, const Epi& E) {
    const int tid = threadIdx.x, wid = __builtin_amdgcn_readfirstlane(tid >> 6), lane = tid & 63, wr = wid >> 2, wc = wid & 3, fr = lane & 15, fq = lane >> 4;
    const int K = g.K, nt = K / BK;
    unsigned voffA[2], voffB[2];
#pragma unroll
    for (int i = 0; i < 2; ++i) { int R, C; stage_rc(tid * 16 + i * 8192, R, C); const int Rb = Epi::PERM ? ((R & ~31) + perm32(R & 31)) : R;
        voffA[i] = (unsigned)(R * K + C) * 2u; voffB[i] = (unsigned)(Rb * K + C) * 2u; }
    const size_t kstep = (size_t)(BK * 2);
    const size_t hstep = (size_t)HALF * K * 2;
    const size_t tstep = 2 * hstep;
    const unsigned ldsw = (unsigned)wid * 1024u;
    const int aoff = lds_byte(wr * 64 + fr, fq * 8), boff = lds_byte(wc * 32 + fr, fq * 8);
#define PG8_SA(b, h) (((b) * 2 + (h)) * HTB)
#define PG8_SB(b, h) ((4 + (b) * 2 + (h)) * HTB)
#define PG8_STAGE(bufoff, gbase, voff) do { _Pragma("unroll") for (int _i = 0; _i < 2; ++_i) \
        __builtin_amdgcn_global_load_lds((const unsigned*)((const char*)(gbase) + (voff)[_i]), (PG8_LAS unsigned*)(lds + (bufoff) + ldsw + _i * 8192), 16, 0, 0); } while (0)
#define PG8_LDA(dst, b, h) do { _Pragma("unroll") for (int m = 0; m < 4; ++m) _Pragma("unroll") for (int k = 0; k < 2; ++k) dst[m][k] = *(const PG8_LAS bf16x8*)(lds + PG8_SA(b, h) + aoff + m * 2048 + k * 1024); } while (0)
#define PG8_LDB(dst, b, h) do { _Pragma("unroll") for (int n = 0; n < 2; ++n) _Pragma("unroll") for (int k = 0; k < 2; ++k) dst[n][k] = *(const PG8_LAS bf16x8*)(lds + PG8_SB(b, h) + boff + n * 2048 + k * 1024); } while (0)
#define PG8_MMA(ai, bj, At, Bt) do { __builtin_amdgcn_s_setprio(1); _Pragma("unroll") for (int m = 0; m < 4; ++m) _Pragma("unroll") for (int n = 0; n < 2; ++n) _Pragma("unroll") for (int k = 0; k < 2; ++k) \
        acc[ai][bj][m][n] = __builtin_amdgcn_mfma_f32_16x16x32_bf16(Bt[n][k], At[m][k], acc[ai][bj][m][n], 0, 0, 0); __builtin_amdgcn_s_setprio(0); } while (0)
#define PG8_WAIT_V(n) asm volatile("s_waitcnt vmcnt(" #n ")" ::: "memory")
#define PG8_WAIT_L(n) asm volatile("s_waitcnt lgkmcnt(" #n ")" ::: "memory")
#define PG8_BAR __builtin_amdgcn_s_barrier()
#define PG8_SCHED __builtin_amdgcn_sched_barrier(0)
    Unit cur, nxt; int ui = 0;
    if (!S.next(0, cur)) return;
    f32x4 acc[2][2][4][2];
#pragma unroll
    for (int a = 0; a < 2; ++a)
#pragma unroll
        for (int b = 0; b < 2; ++b)
#pragma unroll
            for (int m = 0; m < 4; ++m)
#pragma unroll
                for (int n = 0; n < 2; ++n) acc[a][b][m][n] = (f32x4){0.f, 0.f, 0.f, 0.f};
    bf16x8 At[4][2], B0[2][2], B1[2][2];
    const char* cA = (const char*)g.A + (size_t)cur.pm * tstep; const char* cB = (const char*)g.Bt + (size_t)cur.pn * tstep;
    S.a_ready(cur);
    if constexpr (SP2) {
        PG8_STAGE(PG8_SB(0, 0), cB, voffB); PG8_STAGE(PG8_SB(0, 1), cB + hstep, voffB); PG8_STAGE(PG8_SA(0, 0), cA, voffA); PG8_STAGE(PG8_SA(0, 1), cA + hstep, voffA);
        if (wr == 1) PG8_BAR;
        PG8_WAIT_V(2); PG8_BAR;
        PG8_STAGE(PG8_SB(1, 0), cB + kstep, voffB); PG8_STAGE(PG8_SA(1, 0), cA + kstep, voffA); PG8_STAGE(PG8_SB(1, 1), cB + hstep + kstep, voffB);
        PG8_WAIT_V(6); PG8_BAR;
    } else {
        PG8_STAGE(PG8_SB(0, 0), cB, voffB); PG8_STAGE(PG8_SA(0, 0), cA, voffA); PG8_STAGE(PG8_SB(0, 1), cB + hstep, voffB); PG8_STAGE(PG8_SA(0, 1), cA + hstep, voffA);
        if (wr == 1) PG8_BAR;
        PG8_WAIT_V(4); PG8_BAR;
        PG8_STAGE(PG8_SB(1, 0), cB + kstep, voffB); PG8_STAGE(PG8_SA(1, 0), cA + kstep, voffA); PG8_STAGE(PG8_SB(1, 1), cB + hstep + kstep, voffB);
        PG8_WAIT_V(6); PG8_BAR;
    }
    for (;;) {
        const bool has_next = S.next(ui + 1, nxt);
        const char* nA = has_next ? (const char*)g.A + (size_t)nxt.pm * tstep : cA; const char* nB = has_next ? (const char*)g.Bt + (size_t)nxt.pn * tstep : cB;
        for (int t = 0; t < nt; t += 2) {
            const bool last = (t == nt - 2);
            const char* a1 = cA + (size_t)(t + 1) * kstep;
            const char* a2 = last ? nA : cA + (size_t)(t + 2) * kstep; const char* b2 = last ? nB : cB + (size_t)(t + 2) * kstep;
            const char* a3 = a2 + kstep; const char* b3 = b2 + kstep;
            if (last && has_next) S.a_ready(nxt);
            if constexpr (SP2) {
            PG8_LDB(B0, 0, 0); PG8_LDB(B1, 0, 1); PG8_SCHED; PG8_LDA(At, 0, 0); PG8_STAGE(PG8_SA(1, 1), a1 + hstep, voffA);
            PG8_WAIT_V(8); PG8_WAIT_L(0); PG8_BAR; PG8_MMA(0, 0, At, B0); PG8_MMA(0, 1, At, B1); PG8_BAR; PG8_SCHED;
            PG8_LDA(At, 0, 1); PG8_STAGE(PG8_SB(0, 0), b2, voffB); PG8_STAGE(PG8_SB(0, 1), b2 + hstep, voffB); PG8_STAGE(PG8_SA(0, 0), a2, voffA);
            PG8_WAIT_V(8); PG8_WAIT_L(0); PG8_BAR; PG8_MMA(1, 0, At, B0); PG8_MMA(1, 1, At, B1); PG8_BAR; PG8_SCHED;
            PG8_LDB(B0, 1, 0); PG8_LDB(B1, 1, 1); PG8_SCHED; PG8_LDA(At, 1, 0); PG8_STAGE(PG8_SA(0, 1), a2 + hstep, voffA);
            PG8_WAIT_V(8); PG8_WAIT_L(0); PG8_BAR; PG8_MMA(0, 0, At, B0); PG8_MMA(0, 1, At, B1); PG8_BAR; PG8_SCHED;
            PG8_LDA(At, 1, 1); PG8_STAGE(PG8_SB(1, 0), b3, voffB); PG8_STAGE(PG8_SB(1, 1), b3 + hstep, voffB); PG8_STAGE(PG8_SA(1, 0), a3, voffA);
            PG8_WAIT_V(8); PG8_WAIT_L(0); PG8_BAR; PG8_MMA(1, 0, At, B0); PG8_MMA(1, 1, At, B1); PG8_BAR; PG8_SCHED;
            } else {
            PG8_LDB(B0, 0, 0); PG8_SCHED; PG8_LDA(At, 0, 0); PG8_STAGE(PG8_SA(1, 1), a1 + hstep, voffA);
            PG8_WAIT_L(8); PG8_BAR; PG8_WAIT_L(0); PG8_MMA(0, 0, At, B0); PG8_BAR; PG8_SCHED;
            PG8_LDB(B1, 0, 1); PG8_STAGE(PG8_SB(0, 0), b2, voffB);
            PG8_BAR; PG8_WAIT_L(0); PG8_MMA(0, 1, At, B1); PG8_BAR;
            PG8_LDA(At, 0, 1); PG8_STAGE(PG8_SA(0, 0), a2, voffA);
            PG8_BAR; PG8_WAIT_L(0); PG8_MMA(1, 0, At, B0); PG8_BAR; PG8_SCHED;
            PG8_STAGE(PG8_SB(0, 1), b2 + hstep, voffB);
            PG8_WAIT_V(6); PG8_BAR; PG8_MMA(1, 1, At, B1); PG8_BAR;
            PG8_LDB(B0, 1, 0); PG8_SCHED; PG8_LDA(At, 1, 0); PG8_STAGE(PG8_SA(0, 1), a2 + hstep, voffA);
            PG8_WAIT_L(8); PG8_BAR; PG8_WAIT_L(0); PG8_MMA(0, 0, At, B0); PG8_BAR; PG8_SCHED;
            PG8_LDB(B1, 1, 1); PG8_STAGE(PG8_SB(1, 0), b3, voffB);
            PG8_BAR; PG8_WAIT_L(0); PG8_MMA(0, 1, At, B1); PG8_BAR;
            PG8_LDA(At, 1, 1); PG8_STAGE(PG8_SA(1, 0), a3, voffA);
            PG8_BAR; PG8_WAIT_L(0); PG8_MMA(1, 0, At, B0); PG8_BAR; PG8_SCHED;
            PG8_STAGE(PG8_SB(1, 1), b3 + hstep, voffB);
            PG8_WAIT_V(6); PG8_BAR; PG8_MMA(1, 1, At, B1); PG8_BAR;
            }
        }
        if constexpr (ALIGN_EPI) { if (wr == 0) PG8_BAR; }
        if constexpr (!Epi::AFTER_DRAIN) { E(acc, cur, wr, wc, fr, fq); S.done(cur); }
        if (!has_next) break;
#pragma unroll
        for (int a = 0; a < 2; ++a)
#pragma unroll
            for (int b = 0; b < 2; ++b)
#pragma unroll
                for (int m = 0; m < 4; ++m)
#pragma unroll
                    for (int n = 0; n < 2; ++n) acc[a][b][m][n] = (f32x4){0.f, 0.f, 0.f, 0.f};
        cur = nxt; cA = nA; cB = nB; ++ui;
        if constexpr (ALIGN_EPI) { if (wr == 1) PG8_BAR; }
    }
    PG8_WAIT_V(0);
    if constexpr (!ALIGN_EPI) { if (wr == 0) PG8_BAR; }
    PG8_BAR;
    if constexpr (Epi::AFTER_DRAIN) { E.fused(acc, cur, wr, wc, fr, fq, lds, wid, lane); S.done(cur); }
#undef PG8_SA
#undef PG8_SB
#undef PG8_STAGE
#undef PG8_LDA
#undef PG8_LDB
#undef PG8_MMA
#undef PG8_WAIT_V
#undef PG8_WAIT_L
#undef PG8_BAR
#undef PG8_SCHED
}
}

#ifndef PG8_SP2
#define PG8_SP2 true
#endif
#ifndef PG8_ALIGN
#define PG8_ALIGN true
#endif
constexpr int RING_OFF = 0, RING_BYTES = 131072;
constexpr int LDSCTL_OFF = RING_BYTES, MISC_OFF = LDSCTL_OFF + 320;
constexpr int RTAB_OFF = RING_BYTES + 1024;
constexpr int LDS_BYTES = 147456;
constexpr int NWAVES = 8;
constexpr int CW_BAR = 4096;

#define GAS __attribute__((address_space(1)))
#define LAS __attribute__((address_space(3)))
typedef unsigned v4u __attribute__((ext_vector_type(4)));
typedef float f32x4 __attribute__((ext_vector_type(4)));
typedef GAS unsigned gu32;
#define LDS_WAIT() asm volatile("s_waitcnt lgkmcnt(0)" ::: "memory")
#define VM_WAIT() asm volatile("s_waitcnt vmcnt(0)" ::: "memory")
__device__ __forceinline__ unsigned f2bf_u(float f) { unsigned u = __builtin_bit_cast(unsigned, f); return (u + 0x7fffu + ((u >> 16) & 1u)) >> 16; }
__device__ __forceinline__ unsigned pk2(float lo, float hi) { return f2bf_u(lo) | (f2bf_u(hi) << 16); }
__device__ __forceinline__ float wave_sum(float v) {
#pragma unroll
    for (int o = 1; o < 64; o <<= 1) v += __shfl_xor(v, o);
    return v;
}

#define XB_TMO      128
#define XB_XCNT(j)  (256  + 64 * (j))
#define XB_XSUB(j)  (1280 + 64 * (j))
#define XB_XGEN(j)  (2304 + 64 * (j))
#define XB_TOP      3328
#define XB_TOPGEN   3392
#define XCD_BAR_WORDS 3456
#define XB_SPIN_CAP (1u << 18)

__device__ __forceinline__ unsigned xb_ld(unsigned* p)              { return __hip_atomic_load(p, __ATOMIC_RELAXED, __HIP_MEMORY_SCOPE_AGENT); }
__device__ __forceinline__ unsigned xb_add(unsigned* p, unsigned v) { return __hip_atomic_fetch_add(p, v, __ATOMIC_RELAXED, __HIP_MEMORY_SCOPE_AGENT); }
__device__ __forceinline__ unsigned xb_xcc_id() { return (unsigned)__builtin_amdgcn_s_getreg((3 << 11) | 20) & 0xFu; }
#define XB_SPIN(cond, bar) do { unsigned _sp = 0; while (cond) { __builtin_amdgcn_s_sleep(1); \
    if ((++_sp & 255u) == 0u) { if (xb_ld(&(bar)[XB_TMO])) break; if (_sp > XB_SPIN_CAP) { atomicAdd(&(bar)[XB_TMO], 1u); break; } } } } while (0)

struct XcdBarrier {
    unsigned* bar; unsigned x;
    volatile LAS unsigned* st;
};

__device__ __forceinline__ XcdBarrier xcd_barrier_post(unsigned* bar, volatile LAS unsigned* st) {
    XcdBarrier b; b.bar = bar; b.x = xb_xcc_id(); b.st = st;
    if (threadIdx.x == 0) (void)xb_add(&bar[XB_XCNT(b.x)], 1u);
    return b;
}
__device__ __forceinline__ void xcd_barrier_complete(unsigned* bar, unsigned x, unsigned& nloc, unsigned& nx) {
    const unsigned G = gridDim.x * gridDim.y * gridDim.z;
    unsigned sum, cnt, mine, sp = 0u;
    for (;;) {
        sum = 0u; cnt = 0u; mine = 0u;
#pragma unroll
        for (unsigned j = 0; j < 16; ++j) { const unsigned c = xb_ld(&bar[XB_XCNT(j)]); sum += c; cnt += (c > 0u) ? 1u : 0u; mine = (j == x) ? c : mine; }
        if (sum == G) break;
        __builtin_amdgcn_s_sleep(1);
        if ((++sp & 255u) == 0u) { if (xb_ld(&bar[XB_TMO])) break; if (sp > XB_SPIN_CAP) { atomicAdd(&bar[XB_TMO], 1u); break; } }
    }
    nloc = mine > 0u ? mine : 1u; nx = cnt > 0u ? cnt : 1u;
}

__device__ __forceinline__ void xcd_barrier(const XcdBarrier& b) {
    asm volatile("s_waitcnt vmcnt(0)" ::: "memory");
    __syncthreads();
    if (threadIdx.x == 0) {
        unsigned* bar = b.bar;
        __builtin_amdgcn_s_waitcnt(0);
        unsigned nloc = b.st[0], nx = b.st[1];
        if (nloc == 0u) { xcd_barrier_complete(bar, b.x, nloc, nx); b.st[0] = nloc; b.st[1] = nx; }
        const unsigned old = xb_add(&bar[XB_XSUB(b.x)], 1u);
        const unsigned gen = old / nloc;
        if (old + 1u == (gen + 1u) * nloc) {
            __builtin_amdgcn_fence(__ATOMIC_RELEASE, "agent");
            asm volatile("s_waitcnt vmcnt(0)" ::: "memory");
            const unsigned og = xb_add(&bar[XB_TOP], 1u);
            const unsigned tg = og / nx;
            if (og + 1u == (tg + 1u) * nx) xb_add(&bar[XB_TOPGEN], 1u);
            else XB_SPIN(xb_ld(&bar[XB_TOPGEN]) == tg, bar);
            __builtin_amdgcn_fence(__ATOMIC_ACQUIRE, "agent");
            xb_add(&bar[XB_XGEN(b.x)], 1u);
            asm volatile("s_waitcnt vmcnt(0)" ::: "memory");
        } else {
            XB_SPIN(xb_ld(&bar[XB_XGEN(b.x)]) == gen, bar);
            __builtin_amdgcn_fence(__ATOMIC_ACQUIRE, "agent");
            asm volatile("s_waitcnt vmcnt(0)" ::: "memory");
        }
    }
    __syncthreads();
}

namespace hg {
typedef short bf16x8 __attribute__((ext_vector_type(8)));
typedef short s16x4 __attribute__((ext_vector_type(4)));
typedef short v4i16_t __attribute__((ext_vector_type(4)));
typedef float f32x16 __attribute__((ext_vector_type(16)));
typedef float f32x4 __attribute__((ext_vector_type(4)));
typedef float f32x2 __attribute__((ext_vector_type(2)));
typedef unsigned u32x4 __attribute__((ext_vector_type(4)));
typedef unsigned u32x2 __attribute__((ext_vector_type(2)));
#define HG_LAS __attribute__((address_space(3)))
constexpr int L_QS = 0, L_KS = 16384, L_QD = 32768, L_KD = 49152, L_V = 65536, L_TOT = 73728, L_DL = 77824, L_SLAB = 78848, L_END = L_SLAB + 16384;
constexpr float L2E = 1.4426950408889634f;
__device__ __forceinline__ unsigned cvtpk(float lo, float hi) { unsigned r; asm volatile("v_cvt_pk_bf16_f32 %0, %1, %2" : "=v"(r) : "v"(lo), "v"(hi)); return r; }
__device__ __forceinline__ float bf_lo(unsigned u) { return __uint_as_float(u << 16); }
__device__ __forceinline__ float bf_hi(unsigned u) { return __uint_as_float(u & 0xffff0000u); }
__device__ __forceinline__ float h_lo(unsigned u) { return (float)__builtin_bit_cast(_Float16, (unsigned short)(u & 0xffffu)); }
__device__ __forceinline__ float h_hi(unsigned u) { return (float)__builtin_bit_cast(_Float16, (unsigned short)(u >> 16)); }
__device__ __forceinline__ s16x4 vtr(const HG_LAS unsigned char* p) { return __builtin_bit_cast(s16x4, __builtin_amdgcn_ds_read_tr16_b64_v4i16((HG_LAS v4i16_t*)p)); }
__device__ __forceinline__ bf16x8 pk8(const f32x16& x, int b) {
    u32x4 w; w.x = cvtpk(x[b], x[b + 1]); w.y = cvtpk(x[b + 2], x[b + 3]); w.z = cvtpk(x[b + 4], x[b + 5]); w.w = cvtpk(x[b + 6], x[b + 7]); return __builtin_bit_cast(bf16x8, w); }
__device__ __forceinline__ bf16x8 cat8(s16x4 lo, s16x4 hi) { return (bf16x8){lo[0], lo[1], lo[2], lo[3], hi[0], hi[1], hi[2], hi[3]}; }

__device__ __forceinline__ void hgrn_item(HG_LAS unsigned char* lds, const u16* __restrict__ PROJ, u16* __restrict__ ODIR, int item, int tid) {
    const int lane = tid & 63, w = __builtin_amdgcn_readfirstlane(tid >> 6), hi = lane >> 5, c32 = lane & 31;
    const int vh = item & 1, dir = (item >> 1) & 1, h = (item >> 2) & 7, b = item >> 5;
    const int ib = w & 1, jb = (w >> 1) & 1, kh = w >> 2;
    const size_t rowbase = (size_t)b * SEQ;
    const int cq = h * 128 + 2 * lane, cf = 2048 + dir * 1024 + h * 128 + 2 * lane, cv = 1024 + h * 128 + vh * 64 + (tid & 7) * 8;
    const int vs = tid >> 3, vc8 = tid & 7;
    f32x16 S0, S1;
#pragma unroll
    for (int r = 0; r < 16; ++r) { S0[r] = 0.f; S1[r] = 0.f; }
    unsigned q2[8], l2[8]; u32x4 vreg;
#define HG_TOK(c, i) (dir ? (SEQ - 1 - (64 * (c) + (i))) : (64 * (c) + (i)))
#define HG_LOAD(c) do { _Pragma("unroll") for (int r = 0; r < 8; ++r) { const u16* rp = PROJ + (rowbase + HG_TOK(c, 8 * w + r)) * 8192; q2[r] = *(const unsigned*)(rp + cq); l2[r] = *(const unsigned*)(rp + cf); } \
        vreg = *(const u32x4*)(PROJ + (rowbase + HG_TOK(c, vs)) * 8192 + cv); } while (0)
    HG_LOAD(0);
    const int trb = (4 * hi + ((lane & 15) >> 2)) * 64 + ((lane >> 4) & 1) * 32 + (lane & 3) * 8;
    HG_LAS float* tot = (HG_LAS float*)(lds + L_TOT);
    HG_LAS float* dl = (HG_LAS float*)(lds + L_DL);
    for (int c = 0; c < SEQ / 64; ++c) {
        float c0[8], c1[8]; float a0 = 0.f, a1 = 0.f;
#pragma unroll
        for (int r = 0; r < 8; ++r) { a0 += h_lo(l2[r]); a1 += h_hi(l2[r]); c0[r] = a0; c1[r] = a1; }
        *(HG_LAS f32x2*)(tot + w * 128 + 2 * lane) = (f32x2){a0, a1};
        __syncthreads();
        float p0 = 0.f, p1 = 0.f, m0 = 0.f, m1 = 0.f, t0 = 0.f, t1 = 0.f;
#pragma unroll
        for (int ww = 0; ww < 8; ++ww) { const f32x2 x = *(const HG_LAS f32x2*)(tot + ww * 128 + 2 * lane);
            if (ww < w) { p0 += x.x; p1 += x.y; } if (ww < 4) { m0 += x.x; m1 += x.y; } t0 += x.x; t1 += x.y; }
        const float Em0 = __builtin_amdgcn_exp2f(m0 * L2E), Em1 = __builtin_amdgcn_exp2f(m1 * L2E);
        const float El0 = __builtin_amdgcn_exp2f((t0 - m0) * L2E), El1 = __builtin_amdgcn_exp2f((t1 - m1) * L2E);
        if (w == 0) *(HG_LAS f32x2*)(dl + 2 * lane) = (f32x2){__builtin_amdgcn_exp2f(t0 * L2E), __builtin_amdgcn_exp2f(t1 * L2E)};
#pragma unroll
        for (int r = 0; r < 8; ++r) {
            const int i = 8 * w + r;
            float x0 = (p0 + c0[r] - m0) * L2E, x1 = (p1 + c1[r] - m1) * L2E;
            x0 = __builtin_fminf(__builtin_fmaxf(x0, -115.f), 115.f); x1 = __builtin_fminf(__builtin_fmaxf(x1, -115.f), 115.f);
            const float e0 = __builtin_amdgcn_exp2f(x0), e1 = __builtin_amdgcn_exp2f(x1), g0 = __builtin_amdgcn_exp2f(-x0), g1 = __builtin_amdgcn_exp2f(-x1);
            const float kk0 = 1.0f - __builtin_amdgcn_exp2f(h_lo(l2[r]) * L2E), kk1 = 1.0f - __builtin_amdgcn_exp2f(h_hi(l2[r]) * L2E);
            const float qs0 = bf_lo(q2[r]) * e0, qs1 = bf_hi(q2[r]) * e1, ks0 = kk0 * g0, ks1 = kk1 * g1;
            const int sw = i * 256 + ((((lane >> 2) ^ (i & 15))) << 4) + (lane & 3) * 4;
            *(HG_LAS unsigned*)(lds + L_QS + sw) = cvtpk(qs0, qs1);
            *(HG_LAS unsigned*)(lds + L_KS + sw) = cvtpk(ks0, ks1);
            *(HG_LAS unsigned*)(lds + L_QD + sw) = cvtpk(qs0 * Em0, qs1 * Em1);
            *(HG_LAS unsigned*)(lds + L_KD + (((lane >> 4) * 4 + (i >> 4)) * 1024) + (i & 15) * 64 + (lane & 15) * 4) = cvtpk(ks0 * El0, ks1 * El1);
        }
        *(HG_LAS u32x4*)(lds + L_V + (((vc8 >> 2) * 4 + (vs >> 4)) * 1024) + (vs & 15) * 64 + (vc8 & 3) * 16) = vreg;
        if (c + 1 < SEQ / 64) HG_LOAD(c + 1);
        __syncthreads();
        f32x16 o;
#pragma unroll
        for (int r = 0; r < 16; ++r) o[r] = 0.f;
        { const int row = ib * 32 + c32; const HG_LAS unsigned char* qd = lds + L_QD + row * 256 + 8 * hi;
#pragma unroll
          for (int t2 = 0; t2 < 2; ++t2)
#pragma unroll
            for (int sp = 0; sp < 2; ++sp) { const int ch = (2 * kh + t2) * 4 + 2 * sp;
                const u32x2 lo = *(const HG_LAS u32x2*)(qd + ((ch ^ (row & 15)) << 4)), hh = *(const HG_LAS u32x2*)(qd + (((ch + 1) ^ (row & 15)) << 4));
                const bf16x8 a = __builtin_bit_cast(bf16x8, (u32x4){lo.x, lo.y, hh.x, hh.y});
                o = __builtin_amdgcn_mfma_f32_32x32x16_bf16(a, pk8(t2 ? S1 : S0, 8 * sp), o, 0, 0, 0); } }
        if (kh <= ib) {
            f32x16 X;
#pragma unroll
            for (int r = 0; r < 16; ++r) X[r] = 0.f;
            const int rs = kh * 32 + c32, ri = ib * 32 + c32;
            const HG_LAS unsigned char* ksp = lds + L_KS + rs * 256; const HG_LAS unsigned char* qsp = lds + L_QS + ri * 256;
#pragma unroll
            for (int st = 0; st < 8; ++st) { const int ch = 2 * st + hi;
                const bf16x8 a = *(const HG_LAS bf16x8*)(ksp + ((ch ^ (rs & 15)) << 4)), bq = *(const HG_LAS bf16x8*)(qsp + ((ch ^ (ri & 15)) << 4));
                X = __builtin_amdgcn_mfma_f32_32x32x16_bf16(a, bq, X, 0, 0, 0); }
            if (kh == ib) {
#pragma unroll
                for (int r = 0; r < 16; ++r) { const int sl = (r & 3) + 8 * (r >> 2) + 4 * hi; X[r] = (sl <= c32) ? X[r] : 0.f; }
            }
#pragma unroll
            for (int sp = 0; sp < 2; ++sp) { const HG_LAS unsigned char* vp = lds + L_V + (jb * 4 + 2 * kh + sp) * 1024 + trb;
                const bf16x8 vb = cat8(vtr(vp), vtr(vp + 512));
                o = __builtin_amdgcn_mfma_f32_32x32x16_bf16(pk8(X, 8 * sp), vb, o, 0, 0, 0); }
        }
#pragma unroll
        for (int t2 = 0; t2 < 2; ++t2) {
            const int kt = 2 * kh + t2; f32x16 S = t2 ? S1 : S0;
#pragma unroll
            for (int g = 0; g < 4; ++g) { const f32x4 d = *(const HG_LAS f32x4*)(dl + kt * 32 + 8 * g + 4 * hi); S[4 * g] *= d[0]; S[4 * g + 1] *= d[1]; S[4 * g + 2] *= d[2]; S[4 * g + 3] *= d[3]; }
#pragma unroll
            for (int ks = 0; ks < 4; ++ks) { const HG_LAS unsigned char* kp = lds + L_KD + (kt * 4 + ks) * 1024 + trb; const HG_LAS unsigned char* vp = lds + L_V + (jb * 4 + ks) * 1024 + trb;
                const bf16x8 a = cat8(vtr(kp), vtr(kp + 512)), vb = cat8(vtr(vp), vtr(vp + 512));
                S = __builtin_amdgcn_mfma_f32_32x32x16_bf16(a, vb, S, 0, 0, 0); }
            if (t2) S1 = S; else S0 = S;
        }
        HG_LAS float* slab = (HG_LAS float*)(lds + L_SLAB) + (ib * 2 + jb) * 1024 + lane;
        if (kh == 1) {
#pragma unroll
            for (int r = 0; r < 16; ++r) slab[r * 64] = o[r];
        }
        __syncthreads();
        if (kh == 0) {
            u16* op = ODIR + ((size_t)dir * M + rowbase) * 1024 + h * 128 + vh * 64 + jb * 32 + c32;
#pragma unroll
            for (int r = 0; r < 16; ++r) { const int i = ib * 32 + (r & 3) + 8 * (r >> 2) + 4 * hi; const float v = o[r] + slab[r * 64];
                op[(size_t)HG_TOK(c, i) * 1024] = (u16)(cvtpk(v, v) & 0xffffu); }
        }
    }
#undef HG_TOK
#undef HG_LOAD
}
}

__device__ __forceinline__ void p0_item(const float* W, int K, int N, const float* ksc, u16* WT, LAS float* scr, int k0, int n0, int drow0, int lane) {
#pragma unroll 8
    for (int i = 0; i < 32; ++i) { const int kk = 2 * i + (lane >> 5); float w = W[(size_t)(k0 + kk) * N + n0 + (lane & 31)]; if (ksc) w *= ksc[k0 + kk]; scr[kk * 33 + (lane & 31)] = w; }
    LDS_WAIT(); asm volatile("" ::: "memory");
    const int c = lane & 7;
#pragma unroll
    for (int j = 0; j < 4; ++j) { const int n = (lane >> 3) + 8 * j; const LAS float* s = scr + (8 * c) * 33 + n;
        v4u o; o.x = pk2(s[0 * 33], s[1 * 33]); o.y = pk2(s[2 * 33], s[3 * 33]); o.z = pk2(s[4 * 33], s[5 * 33]); o.w = pk2(s[6 * 33], s[7 * 33]);
        *(GAS v4u*)(WT + (size_t)(drow0 + n) * K + k0 + 8 * c) = o; }
    LDS_WAIT(); asm volatile("" ::: "memory");
}
__device__ __forceinline__ void rms_row_to_bf16(const float* xrow, const float* w, u16* orow, int lane) {
    const f32x4* xr = (const f32x4*)xrow + lane;
    f32x4 v[8]; float s = 0.f;
#pragma unroll
    for (int j = 0; j < 8; ++j) { v[j] = xr[64 * j]; s += (v[j].x * v[j].x + v[j].y * v[j].y) + (v[j].z * v[j].z + v[j].w * v[j].w); }
    const float r = __builtin_amdgcn_rsqf(wave_sum(s) * (1.0f / DM) + EPS);
    const f32x4* wr = (const f32x4*)w + lane;
    uint2* o = (uint2*)orow + lane;
#pragma unroll
    for (int j = 0; j < 8; ++j) { const f32x4 ww = wr[64 * j]; uint2 p; p.x = pk2(v[j].x * r * ww.x, v[j].y * r * ww.y); p.y = pk2(v[j].z * r * ww.z, v[j].w * r * ww.w); o[64 * j] = p; }
}
__device__ __forceinline__ void rms_row_inplace(float* xrow, const float* w, int lane) {
    f32x4* xr = (f32x4*)xrow + lane;
    f32x4 v[8]; float s = 0.f;
#pragma unroll
    for (int j = 0; j < 8; ++j) { v[j] = xr[64 * j]; s += (v[j].x * v[j].x + v[j].y * v[j].y) + (v[j].z * v[j].z + v[j].w * v[j].w); }
    const float r = __builtin_amdgcn_rsqf(wave_sum(s) * (1.0f / DM) + EPS);
    const f32x4* wr = (const f32x4*)w + lane;
#pragma unroll
    for (int j = 0; j < 8; ++j) { const f32x4 ww = wr[64 * j]; xr[64 * j] = v[j] * r * ww; }
}

struct Args { const float* in[17]; float* out; unsigned char* ws; int ph_lo, ph_hi, li, pad; };
enum { PH_PRO = 0, PH_INPROJ = 1, PH_MIX = 2, PH_HGFIN = 3, PH_OUTPROJ = 4, PH_GATEUP = 5, PH_DOWN = 6, PH_FINAL = 7, PH_N = 8 };

__global__ void __launch_bounds__(NWAVES * 64, 2) mk_fwd(Args args) {
    extern __shared__ __attribute__((aligned(16))) unsigned char lds_raw[];
    LAS unsigned char* lds = (LAS unsigned char*)lds_raw;
    volatile LAS unsigned* MISC = (volatile LAS unsigned*)(lds + MISC_OFF);
    const int tid = threadIdx.x, lane = tid & 63, wave = __builtin_amdgcn_readfirstlane(tid >> 6);
    const int G = gridDim.x; const int bx = blockIdx.x; const int vcu = (G % 8 == 0) ? (bx % 8) * (G / 8) + bx / 8 : bx;
    unsigned char* ws = args.ws;
    gu32* ctl = (gu32*)(ws + WS_CTL);
    float* part = (float*)(ws + WS_PART);
    u16* WinT = (u16*)(ws + WS_WIN); u16* WoT = (u16*)(ws + WS_WO); u16* WguT = (u16*)(ws + WS_WGU); u16* WdT = (u16*)(ws + WS_WD);
    u16* XN = (u16*)(ws + WS_XN); u16* BB = (u16*)(ws + WS_B); u16* PROJ = (u16*)(ws + WS_PROJ);
    for (int u = tid; u < (LDS_BYTES - LDSCTL_OFF) / 4; u += NWAVES * 64) ((LAS unsigned*)(lds + LDSCTL_OFF))[u] = 0u;
    __syncthreads();
    XcdBarrier bar = xcd_barrier_post((unsigned*)(ctl + CW_BAR) + args.li * XCD_BAR_WORDS, MISC + 8);
    const int lo = args.ph_lo, hi = args.ph_hi;
#define IN(k) (lo <= (k) && (k) < hi)
#define SEAM(k) do { if (IN(k) && (k) + 1 < hi) xcd_barrier(bar); } while (0)
    const int gw = vcu * NWAVES + wave, NGW = G * NWAVES;

    if (IN(PH_PRO)) {
        LAS float* scr = (LAS float*)(lds + RING_OFF + wave * 16384);
        constexpr int I_IN = (DM / 64) * (INC / 32), I_O = (DM / 64) * (DM / 32), I_G = (DM / 64) * (DFF / 32), I_D = (DFF / 64) * (DM / 32);
        constexpr int NITEMS = I_IN + I_O + 2 * I_G + I_D;
        for (int it = gw; it < NITEMS; it += NGW) {
            int r = it;
            if (r < I_IN) { const int nblk = INC / 32, k0 = 64 * (r / nblk), n0 = 32 * (r % nblk); p0_item(args.in[2], DM, INC, nullptr, WinT, scr, k0, n0, n0, lane); continue; } r -= I_IN;
            if (r < I_O) { const int nblk = DM / 32, k0 = 64 * (r / nblk), n0 = 32 * (r % nblk); p0_item(args.in[11], DM, DM, nullptr, WoT, scr, k0, n0, n0, lane); continue; } r -= I_O;
            if (r < 2 * I_G) { const int up = r >= I_G ? 1 : 0; if (up) r -= I_G; const int nblk = DFF / 32, k0 = 64 * (r / nblk), n0 = 32 * (r % nblk);
                p0_item(args.in[up ? 14 : 13], DM, DFF, args.in[12], WguT, scr, k0, n0, 256 * (n0 >> 7) + 128 * up + (n0 & 127), lane); continue; } r -= 2 * I_G;
            { const int nblk = DM / 32, k0 = 64 * (r / nblk), n0 = 32 * (r % nblk); p0_item(args.in[15], DFF, DM, nullptr, WdT, scr, k0, n0, n0, lane); }
        }
        for (int m = gw; m < M; m += NGW) rms_row_to_bf16(args.in[0] + (size_t)m * DM, args.in[1], XN + (size_t)m * DM, lane);
    }
    SEAM(PH_PRO);
    if (IN(PH_INPROJ)) {
        pg8::Gemm g{XN, WinT, M, INC, DM}; pg8::StaticOrder S; S.init(M, INC, G, bx);
        pg8::EpiInProj E{PROJ, args.in[3]};
        pg8::gemm_phase<pg8::EpiInProj, pg8::StaticOrder, PG8_ALIGN, PG8_SP2>(lds + RING_OFF, g, S, E);
    }
    SEAM(PH_INPROJ);
    if (IN(PH_MIX)) {
        for (int item = vcu; item < 256; item += G) { hg::hgrn_item(lds + RING_OFF, PROJ, BB, item, tid); __syncthreads(); }
    }
    SEAM(PH_MIX);
    if (IN(PH_HGFIN)) {
        const float w0 = args.in[4][lane * 2], w1 = args.in[4][lane * 2 + 1];
        for (int p = gw; p < M * 8; p += NGW) { const int m = p >> 3, c = (p & 7) * 128 + lane * 2;
            const unsigned a = *(const unsigned*)(BB + (size_t)m * HGW + c), bb = *(const unsigned*)(BB + ((size_t)M + m) * HGW + c);
            const float o0 = __uint_as_float(a << 16) + __uint_as_float(bb << 16), o1 = __uint_as_float(a & 0xffff0000u) + __uint_as_float(bb & 0xffff0000u);
            const float r = __builtin_amdgcn_rsqf(wave_sum(o0 * o0 + o1 * o1) * (1.0f / 128.0f) + EPS);
            const unsigned g = *(const unsigned*)(PROJ + (size_t)m * INC + 4096 + c);
            *(unsigned*)(XN + (size_t)m * DM + c) = pk2(o0 * r * w0 * __uint_as_float(g << 16), o1 * r * w1 * __uint_as_float(g & 0xffff0000u)); }
    }
    SEAM(PH_HGFIN);
    if (IN(PH_OUTPROJ)) {
        pg8::Gemm g{XN, WoT, M, DM, DM}; pg8::StaticOrder S; S.init(M, DM, G, bx);
        pg8::EpiOutProj E{args.in[0], args.out, BB, part};
        pg8::gemm_phase<pg8::EpiOutProj, pg8::StaticOrder, PG8_ALIGN, PG8_SP2>(lds + RING_OFF, g, S, E);
    }
    SEAM(PH_OUTPROJ);
    if (IN(PH_GATEUP)) {
        pg8::Gemm g{BB, WguT, M, NGU, DM}; pg8::StaticOrder S; S.init(M, NGU, G, bx);
        pg8::Unit u0; u0.pm = 0; u0.pn = 0; (void)S.next(0, u0);
        LAS float* rtab = (LAS float*)(lds + RTAB_OFF);
        if (tid < 256) { const GAS f32x4* p = (const GAS f32x4*)(part + (size_t)(u0.pm * 256 + tid) * 32); float s = 0.f;
#pragma unroll
            for (int j = 0; j < 8; ++j) { const f32x4 q = p[j]; s += (q[0] + q[1]) + (q[2] + q[3]); }
            rtab[tid] = __builtin_amdgcn_rsqf(s * (1.0f / DM) + EPS); }
        __syncthreads();
        pg8::EpiSwiGLU E{PROJ, (const LAS float*)rtab, u0.pm, part};
        pg8::gemm_phase<pg8::EpiSwiGLU, pg8::StaticOrder, PG8_ALIGN, PG8_SP2>(lds + RING_OFF, g, S, E);
    }
    SEAM(PH_GATEUP);
    if (IN(PH_DOWN)) {
        pg8::Gemm g{PROJ, WdT, M, DM, DFF}; pg8::StaticOrder S; S.init(M, DM, G, bx);
        pg8::EpiDown E{args.out};
        pg8::gemm_phase<pg8::EpiDown, pg8::StaticOrder, PG8_ALIGN, PG8_SP2>(lds + RING_OFF, g, S, E);
    }
    SEAM(PH_DOWN);
    if (IN(PH_FINAL)) {
        for (int m = gw; m < M; m += NGW) rms_row_inplace(args.out + (size_t)m * DM, args.in[16], lane);
    }
#undef IN
#undef SEAM
}

__device__ __forceinline__ u16 f2bf(float f) { unsigned u = __float_as_uint(f); u += 0x7fffu + ((u >> 16) & 1u); return (u16)(u >> 16); }
__device__ __forceinline__ float bf2f(u16 h) { return __uint_as_float(((unsigned)h) << 16); }
__device__ __forceinline__ u16 f2h(float f) { return __builtin_bit_cast(u16, (_Float16)f); }
__device__ __forceinline__ float h2f(u16 h) { return (float)__builtin_bit_cast(_Float16, h); }
typedef unsigned u32x4 __attribute__((ext_vector_type(4)));
__global__ __launch_bounds__(128) void k_hgrn(const u16* __restrict__ proj, u16* __restrict__ odir) {
    const int seq = blockIdx.x, dir = seq & 1, h = (seq >> 1) & 7, b = seq >> 4, c = threadIdx.x;
    __shared__ float sq[2][128], sf[2][128], sk[2][128];
    float S[128];
#pragma unroll
    for (int k = 0; k < 128; ++k) S[k] = 0.f;
    for (int step = 0; step < SEQ; ++step) {
        const int t = dir ? (SEQ - 1 - step) : step, buf = step & 1;
        const size_t m = (size_t)b * SEQ + t;
        const u16* row = proj + m * INC;
        const float q = bf2f(row[h * 128 + c]), lf = h2f(row[2048 + dir * 1024 + h * 128 + c]), v = bf2f(row[1024 + h * 128 + c]);
        sq[buf][c] = q; sf[buf][c] = __expf(lf); sk[buf][c] = -expm1f(lf);
        __syncthreads();
        float o = 0.f;
#pragma unroll
        for (int k = 0; k < 128; k += 4) {
            const f32x4 f4 = *(const f32x4*)&sf[buf][k], k4 = *(const f32x4*)&sk[buf][k], q4 = *(const f32x4*)&sq[buf][k];
            S[k] = f4.x * S[k] + k4.x * v; o += q4.x * S[k];
            S[k + 1] = f4.y * S[k + 1] + k4.y * v; o += q4.y * S[k + 1];
            S[k + 2] = f4.z * S[k + 2] + k4.z * v; o += q4.z * S[k + 2];
            S[k + 3] = f4.w * S[k + 3] + k4.w * v; o += q4.w * S[k + 3];
        }
        odir[((size_t)dir * M + m) * HGW + h * 128 + c] = f2bf(o);
    }
}
__global__ __launch_bounds__(256) void k_hgrn_fin(const u16* __restrict__ odir, const u16* __restrict__ proj, const float* __restrict__ w, u16* __restrict__ cat) {
    const int gw = blockIdx.x * 4 + (threadIdx.x >> 6), lane = threadIdx.x & 63;
    const int m = gw >> 3, h = gw & 7, c = h * 128 + lane * 2;
    const unsigned a = *(const unsigned*)(odir + (size_t)m * HGW + c), bb = *(const unsigned*)(odir + ((size_t)M + m) * HGW + c);
    const float o0 = bf2f((u16)a) + bf2f((u16)bb), o1 = bf2f((u16)(a >> 16)) + bf2f((u16)(bb >> 16));
    const float r = rsqrtf(wave_sum(o0 * o0 + o1 * o1) * (1.0f / 128.0f) + EPS);
    const unsigned g = *(const unsigned*)(proj + (size_t)m * INC + 4096 + c);
    const float y0 = o0 * r * w[lane * 2] * bf2f((u16)g), y1 = o1 * r * w[lane * 2 + 1] * bf2f((u16)(g >> 16));
    *(unsigned*)(cat + (size_t)m * DM + c) = (unsigned)f2bf(y0) | ((unsigned)f2bf(y1) << 16);
}

__device__ __forceinline__ int rel_bucket(int rel) {
    const int n = rel < 0 ? -rel : rel; int bk;
    if (n < 8) bk = n; else if (n < 12) bk = 8; else if (n < 16) bk = 9; else if (n < 23) bk = 10; else if (n < 32) bk = 11;
    else if (n < 46) bk = 12; else if (n < 64) bk = 13; else if (n < 91) bk = 14; else bk = 15;
    return bk + (rel > 0 ? 16 : 0);
}
__global__ __launch_bounds__(256) void k_attn(const u16* __restrict__ proj, const float* __restrict__ rel_bias, float* __restrict__ On) {
    const int qb = blockIdx.x, h = blockIdx.y, b = blockIdx.z >> 1, mp = blockIdx.z & 1, tid = threadIdx.x;
    const int qpos = qb * 256 + tid; const size_t m = (size_t)b * SEQ + qpos;
    __shared__ float sk[32][64];
    __shared__ float sv[32][128];
    __shared__ float sb[32];
    float q[64], o[128];
    { const u16* qp = proj + m * INC + 5120 + h * 128 + mp * 64;
#pragma unroll
      for (int d = 0; d < 64; ++d) q[d] = bf2f(qp[d]); }
#pragma unroll
    for (int d = 0; d < 128; ++d) o[d] = 0.f;
    if (tid < 32) sb[tid] = rel_bias[tid * 8 + h] * LOG2E;
    float mx = -1e30f, l = 0.f;
    const int lk = tid >> 3, ld8 = (tid & 7) * 8, ld16 = (tid & 7) * 16;
    for (int kt = 0; kt < SEQ / 32; ++kt) {
        const u16* kr = proj + ((size_t)b * SEQ + kt * 32 + lk) * INC;
        const u32x4 kv = *(const u32x4*)(kr + 6144 + h * 128 + mp * 64 + ld8);
        const u32x4 v0 = *(const u32x4*)(kr + 7168 + h * 128 + ld16), v1 = *(const u32x4*)(kr + 7168 + h * 128 + ld16 + 8);
        __syncthreads();
        { float* d = &sk[lk][ld8];
          d[0] = __uint_as_float(kv.x << 16); d[1] = __uint_as_float(kv.x & 0xffff0000u); d[2] = __uint_as_float(kv.y << 16); d[3] = __uint_as_float(kv.y & 0xffff0000u);
          d[4] = __uint_as_float(kv.z << 16); d[5] = __uint_as_float(kv.z & 0xffff0000u); d[6] = __uint_as_float(kv.w << 16); d[7] = __uint_as_float(kv.w & 0xffff0000u);
          float* e = &sv[lk][ld16];
          e[0] = __uint_as_float(v0.x << 16); e[1] = __uint_as_float(v0.x & 0xffff0000u); e[2] = __uint_as_float(v0.y << 16); e[3] = __uint_as_float(v0.y & 0xffff0000u);
          e[4] = __uint_as_float(v0.z << 16); e[5] = __uint_as_float(v0.z & 0xffff0000u); e[6] = __uint_as_float(v0.w << 16); e[7] = __uint_as_float(v0.w & 0xffff0000u);
          e[8] = __uint_as_float(v1.x << 16); e[9] = __uint_as_float(v1.x & 0xffff0000u); e[10] = __uint_as_float(v1.y << 16); e[11] = __uint_as_float(v1.y & 0xffff0000u);
          e[12] = __uint_as_float(v1.z << 16); e[13] = __uint_as_float(v1.z & 0xffff0000u); e[14] = __uint_as_float(v1.w << 16); e[15] = __uint_as_float(v1.w & 0xffff0000u); }
        __syncthreads();
        for (int j = 0; j < 32; ++j) {
            float s = 0.f;
#pragma unroll
            for (int d = 0; d < 64; d += 4) { const f32x4 k4 = *(const f32x4*)&sk[j][d]; s += q[d] * k4.x + q[d + 1] * k4.y + q[d + 2] * k4.z + q[d + 3] * k4.w; }
            s += sb[rel_bucket(kt * 32 + j - qpos)];
            if (s > mx) { const float al = exp2f(mx - s); l *= al;
#pragma unroll
                for (int d = 0; d < 128; ++d) o[d] *= al;
                mx = s; }
            const float p = exp2f(s - mx); l += p;
#pragma unroll
            for (int d = 0; d < 128; d += 4) { const f32x4 v4 = *(const f32x4*)&sv[j][d]; o[d] += p * v4.x; o[d + 1] += p * v4.y; o[d + 2] += p * v4.z; o[d + 3] += p * v4.w; }
        }
    }
    const float il = 1.0f / l;
    float* op = On + ((size_t)mp * M + m) * DAW + h * 128;
#pragma unroll
    for (int d = 0; d < 128; d += 4) *(f32x4*)(op + d) = (f32x4){o[d] * il, o[d + 1] * il, o[d + 2] * il, o[d + 3] * il};
}
__global__ __launch_bounds__(256) void k_attn_fin(const float* __restrict__ On, const float* __restrict__ lq1, const float* __restrict__ lk1, const float* __restrict__ lq2, const float* __restrict__ lk2,
                                                  const float* __restrict__ w, u16* __restrict__ cat) {
    const int gw = blockIdx.x * 4 + (threadIdx.x >> 6), lane = threadIdx.x & 63;
    const int m = gw >> 3, h = gw & 7, c = h * 128 + lane * 2;
    const float lam = __expf(wave_sum(lq1[lane] * lk1[lane])) - __expf(wave_sum(lq2[lane] * lk2[lane])) + 0.2f;
    const float2 a = *(const float2*)(On + (size_t)m * DAW + c), bb = *(const float2*)(On + ((size_t)M + m) * DAW + c);
    const float o0 = a.x - lam * bb.x, o1 = a.y - lam * bb.y;
    const float r = rsqrtf(wave_sum(o0 * o0 + o1 * o1) * (1.0f / 128.0f) + EPS) * 0.8f;
    *(unsigned*)(cat + (size_t)m * DM + 1024 + c) = (unsigned)f2bf(o0 * r * w[lane * 2]) | ((unsigned)f2bf(o1 * r * w[lane * 2 + 1]) << 16);
}

extern "C" void kernel_launch(void* const* d_in, const int* in_sizes, int n_in, void* d_out, int out_size, void* d_ws, size_t ws_size, hipStream_t stream) {
    static int grid = 0;
    if (grid == 0) {
        if (n_in != 17 || ws_size < WS_NEED || out_size != M * DM) { fprintf(stderr, "kernel_launch: unexpected shapes (n_in %d, ws %zu, out %d)\n", n_in, ws_size, out_size); grid = -1; return; }
        int dev = 0, cus = 0;
        if (hipGetDevice(&dev) != hipSuccess || hipDeviceGetAttribute(&cus, hipDeviceAttributeMultiprocessorCount, dev) != hipSuccess) { grid = -1; return; }
        if (hipFuncSetAttribute((const void*)mk_fwd, hipFuncAttributeMaxDynamicSharedMemorySize, LDS_BYTES) != hipSuccess) { fprintf(stderr, "kernel_launch: hipFuncSetAttribute failed\n"); grid = -1; return; }
        (void)hipGetLastError();
        grid = cus;
    }
    if (grid < 0) return;
    float* out = (float*)d_out; unsigned char* ws = (unsigned char*)d_ws;
    u16* XN = (u16*)(ws + WS_XN); u16* BB = (u16*)(ws + WS_B); u16* PROJ = (u16*)(ws + WS_PROJ);
    (void)hipMemsetAsync(ws + WS_CTL, 0, CTL_ZERO_BYTES, stream);
    Args a{};
    for (int i = 0; i < 17; ++i) a.in[i] = (const float*)d_in[i];
    a.out = out; a.ws = ws;
    a.ph_lo = PH_PRO; a.ph_hi = PH_HGFIN; a.li = 0;
    hipLaunchKernelGGL(mk_fwd, dim3(grid), dim3(NWAVES * 64), LDS_BYTES, stream, a);
    k_attn<<<dim3(8, 8, 16), 256, 0, stream>>>(PROJ, (const float*)d_in[10], out);
    k_attn_fin<<<M * 8 / 4, 256, 0, stream>>>(out, (const float*)d_in[5], (const float*)d_in[6], (const float*)d_in[7], (const float*)d_in[8], (const float*)d_in[9], XN);
    a.ph_lo = PH_HGFIN; a.ph_hi = PH_N; a.li = 1;
    hipLaunchKernelGGL(mk_fwd, dim3(grid), dim3(NWAVES * 64), LDS_BYTES, stream, a);
}
```

```cpp
#include <hip/hip_runtime.h>
#include <stdint.h>
#include <cstdio>

typedef unsigned short u16;
constexpr int BATCH = 8, SEQ = 2048, DM = 2048, M = BATCH * SEQ;
constexpr int HGW = 1024, DAW = 1024, INC = 8192, DFF = 5632, NGU = 2 * DFF;
constexpr float EPS = 1e-6f;
constexpr float LOG2E = 1.4426950408889634f;
constexpr float C2 = 0.125f * LOG2E;
constexpr size_t MiB = 1u << 20;
constexpr size_t WS_CTL = 0, CTL_ZERO_BYTES = 1 * MiB, WS_PART = 2 * MiB, WS_WIN = 4 * MiB, WS_WO = 36 * MiB, WS_WGU = 44 * MiB, WS_WD = 88 * MiB,
                 WS_XN = 112 * MiB, WS_B = 176 * MiB, WS_PROJ = 240 * MiB, WS_NEED = 496 * MiB;
namespace pg8 {
#define PG8_LAS __attribute__((address_space(3)))
typedef unsigned short bf16_t;
typedef short bf16x8 __attribute__((ext_vector_type(8)));
typedef float f32x4 __attribute__((ext_vector_type(4)));
typedef unsigned u32x4 __attribute__((ext_vector_type(4)));
constexpr int BM = 256, BK = 64, HALF = 128, HTB = HALF * BK * 2  , STAGE_BYTES = 8 * HTB, NXCD = 8, WGM = 8;

__host__ __device__ __forceinline__ int lds_byte(int r, int c) { const int st = (r >> 4) * 2 + (c >> 5), rr = r & 15, cc = c & 31, ob = rr * 64 + cc * 2; return st * 1024 + (ob ^ (((ob >> 9) & 1) << 5)); }
__host__ __device__ __forceinline__ void stage_rc(int b, int& R, int& C) { const int st = b / 1024, sb = b % 1024, swz = sb ^ (((sb >> 9) & 1) << 5); R = (st >> 1) * 16 + swz / 64; C = (st & 1) * 32 + (swz % 64) / 2; }
__host__ __device__ __forceinline__ int perm32(int rho) { const int n = rho >> 4, i = rho & 15; return 8 * (i >> 2) + 4 * n + (i & 3); }

struct Unit { int pm, pn; };
struct Gemm { const bf16_t* A; const bf16_t* Bt; int M, N, K; };

struct StaticOrder {
    int nM, nN, nwg, G, c;
    __host__ __device__ void init(int M, int N, int G_, int c_) { nM = M / BM; nN = N / BM; nwg = nM * nN; G = G_; c = c_; }
    __host__ __device__ bool next(int i, Unit& u) const {
        const long L = (long)i * G + c; if (L >= nwg) return false;
        int wgid = (int)L; { const int q = nwg / NXCD, r = nwg % NXCD, xcd = wgid % NXCD, off = wgid / NXCD; wgid = (xcd < r ? xcd * (q + 1) : r * (q + 1) + (xcd - r) * q) + off; }
        const int nig = WGM * nN, gid = wgid / nig, fm = gid * WGM, gsz = (nM - fm) < WGM ? (nM - fm) : WGM;
        u.pm = fm + ((wgid % nig) % gsz); u.pn = (wgid % nig) / gsz; return true;
    }
    __device__ __forceinline__ void a_ready(const Unit&) const {}
    __device__ __forceinline__ void done(const Unit&) const {}
};
__device__ __forceinline__ unsigned cvt_pk_bf16(float lo, float hi) { unsigned r; asm volatile("v_cvt_pk_bf16_f32 %0, %1, %2" : "=v"(r) : "v"(lo), "v"(hi)); return r; }
typedef float f32x2 __attribute__((ext_vector_type(2)));
__device__ __forceinline__ unsigned pk_h2(float lo, float hi) { return (unsigned)__builtin_bit_cast(unsigned short, (_Float16)lo) | ((unsigned)__builtin_bit_cast(unsigned short, (_Float16)hi) << 16); }
__device__ __forceinline__ float fsig(float x) { return __builtin_amdgcn_rcpf(1.0f + __builtin_amdgcn_exp2f(-1.4426950408889634f * x)); }
__device__ __forceinline__ float fsilu(float x) { return x * fsig(x); }
struct EpiInProj {
    static constexpr bool PERM = true, AFTER_DRAIN = false;
    bf16_t* proj; const float* lbl;
    __device__ __forceinline__ void operator()(const f32x4 (&acc)[2][2][4][2], const Unit& u, int wr, int wc, int fr, int fq) const {
        const int row0 = u.pm * BM + wr * 64 + fr, t = u.pn >> 2, col0 = u.pn * BM + wc * 32 + 8 * fq;
        bf16_t* base = proj + (size_t)row0 * 8192 + col0;
        if (t == 2 || t == 3) {
#pragma unroll
            for (int bj = 0; bj < 2; ++bj) {
                float lb[8];
                { const float* l0 = lbl + (t - 2) * 2048 + (col0 & 1023) + bj * HALF;
                  const f32x4 a0 = *(const f32x4*)(l0), a1 = *(const f32x4*)(l0 + 4), b0 = *(const f32x4*)(l0 + 1024), b1 = *(const f32x4*)(l0 + 1028);
#pragma unroll
                  for (int j = 0; j < 4; ++j) { lb[j] = fsig(a0[j] - b0[j]); lb[4 + j] = fsig(a1[j] - b1[j]); } }
#pragma unroll
                for (int ai = 0; ai < 2; ++ai)
#pragma unroll
                    for (int m = 0; m < 4; ++m) { float y[8];
#pragma unroll
                        for (int j = 0; j < 8; ++j) { const float a = acc[ai][bj][m][j >> 2][j & 3]; const float f = lb[j] + (1.0f - lb[j]) * fsig(a); y[j] = 0.6931471805599453f * __builtin_amdgcn_logf(f); }
                        u32x4 w; w.x = pk_h2(y[0], y[1]); w.y = pk_h2(y[2], y[3]); w.z = pk_h2(y[4], y[5]); w.w = pk_h2(y[6], y[7]);
                        *(u32x4*)(base + (size_t)(ai * HALF + m * 16) * 8192 + bj * HALF) = w; }
            }
        } else if (t == 0 || t == 4) {
#pragma unroll
            for (int ai = 0; ai < 2; ++ai)
#pragma unroll
                for (int m = 0; m < 4; ++m)
#pragma unroll
                    for (int bj = 0; bj < 2; ++bj) { float y[8];
#pragma unroll
                        for (int j = 0; j < 8; ++j) y[j] = fsilu(acc[ai][bj][m][j >> 2][j & 3]);
                        u32x4 w; w.x = cvt_pk_bf16(y[0], y[1]); w.y = cvt_pk_bf16(y[2], y[3]); w.z = cvt_pk_bf16(y[4], y[5]); w.w = cvt_pk_bf16(y[6], y[7]);
                        *(u32x4*)(base + (size_t)(ai * HALF + m * 16) * 8192 + bj * HALF) = w; }
        } else {
            const float sc = (t == 5) ? 0.18033688011112042f : 1.0f;
#pragma unroll
            for (int ai = 0; ai < 2; ++ai)
#pragma unroll
                for (int m = 0; m < 4; ++m)
#pragma unroll
                    for (int bj = 0; bj < 2; ++bj) { const f32x4 v0 = acc[ai][bj][m][0] * sc, v1 = acc[ai][bj][m][1] * sc;
                        u32x4 w; w.x = cvt_pk_bf16(v0[0], v0[1]); w.y = cvt_pk_bf16(v0[2], v0[3]); w.z = cvt_pk_bf16(v1[0], v1[1]); w.w = cvt_pk_bf16(v1[2], v1[3]);
                        *(u32x4*)(base + (size_t)(ai * HALF + m * 16) * 8192 + bj * HALF) = w; }
        }
    }
};
struct EpiOutProj {
    static constexpr bool PERM = false, AFTER_DRAIN = false;
    const float* x; float* out; bf16_t* h1b; float* part;
    __device__ __forceinline__ void operator()(const f32x4 (&acc)[2][2][4][2], const Unit& u, int wr, int wc, int fr, int fq) const {
        const int row0 = u.pm * BM + wr * 64 + fr, col0 = u.pn * BM + wc * 32 + 4 * fq;
#pragma unroll
        for (int ai = 0; ai < 2; ++ai)
#pragma unroll
            for (int m = 0; m < 4; ++m) { const int row = row0 + ai * HALF + m * 16; const size_t off = (size_t)row * 2048 + col0; float ss = 0.f;
#pragma unroll
                for (int bj = 0; bj < 2; ++bj)
#pragma unroll
                    for (int n = 0; n < 2; ++n) { const size_t o = off + bj * HALF + n * 16; const f32x4 h = *(const f32x4*)(x + o) + acc[ai][bj][m][n];
                        *(f32x4*)(out + o) = h; ss += (h[0] * h[0] + h[1] * h[1]) + (h[2] * h[2] + h[3] * h[3]);
                        uint2 w; w.x = cvt_pk_bf16(h[0], h[1]); w.y = cvt_pk_bf16(h[2], h[3]); *(uint2*)(h1b + o) = w; }
                ss += __shfl_xor(ss, 16); ss += __shfl_xor(ss, 32);
                if (fq == 0) part[(size_t)row * 32 + u.pn * 4 + wc] = ss; }
    }
};
struct EpiSwiGLU {
    static constexpr bool PERM = true, AFTER_DRAIN = false;
    bf16_t* hid; const PG8_LAS float* rtab; int pm_tab; const float* part;
    __device__ __forceinline__ void operator()(const f32x4 (&acc)[2][2][4][2], const Unit& u, int wr, int wc, int fr, int fq) const {
        const int rt0 = wr * 64 + fr, col0 = u.pn * HALF + wc * 32 + 8 * fq;
#pragma unroll
        for (int ai = 0; ai < 2; ++ai)
#pragma unroll
            for (int m = 0; m < 4; ++m) { const int rt = rt0 + ai * HALF + m * 16; float r;
                if (u.pm == pm_tab) r = rtab[rt];
                else { const f32x4* p = (const f32x4*)(part + (size_t)(u.pm * BM + rt) * 32); float s = 0.f;
#pragma unroll
                    for (int j = 0; j < 8; ++j) { const f32x4 q = p[j]; s += (q[0] + q[1]) + (q[2] + q[3]); }
                    r = __builtin_amdgcn_rsqf(s * (1.0f / 2048.0f) + 1e-6f); }
                float y[8];
#pragma unroll
                for (int j = 0; j < 8; ++j) { const float g = acc[ai][0][m][j >> 2][j & 3] * r, up = acc[ai][1][m][j >> 2][j & 3] * r; y[j] = fsilu(g) * up; }
                u32x4 w; w.x = cvt_pk_bf16(y[0], y[1]); w.y = cvt_pk_bf16(y[2], y[3]); w.z = cvt_pk_bf16(y[4], y[5]); w.w = cvt_pk_bf16(y[6], y[7]);
                *(u32x4*)(hid + (size_t)(u.pm * BM + rt) * 5632 + col0) = w; }
    }
};
struct EpiDown {
    static constexpr bool PERM = false, AFTER_DRAIN = false;
    float* out;
    __device__ __forceinline__ void operator()(const f32x4 (&acc)[2][2][4][2], const Unit& u, int wr, int wc, int fr, int fq) const {
        const int row0 = u.pm * BM + wr * 64 + fr, col0 = u.pn * BM + wc * 32 + 4 * fq;
#pragma unroll
        for (int ai = 0; ai < 2; ++ai)
#pragma unroll
            for (int m = 0; m < 4; ++m) { float* rowp = out + (size_t)(row0 + ai * HALF + m * 16) * 2048 + col0;
#pragma unroll
                for (int bj = 0; bj < 2; ++bj)
#pragma unroll
                    for (int n = 0; n < 2; ++n) { f32x4* p = (f32x4*)(rowp + bj * HALF + n * 16); *p = *p + acc[ai][bj][m][n]; } }
    }
};

template <class Epi, class Sched, bool ALIGN_EPI = false, bool SP2 = false>
__device__ __forceinline__ void gemm_phase(PG8_LAS unsigned char* lds, const Gemm g, const Sched& S, const Epi& E) {
    const int tid = threadIdx.x, wid = __builtin_amdgcn_readfirstlane(tid >> 6), lane = tid & 63, wr = wid >> 2, wc = wid & 3, fr = lane & 15, fq = lane >> 4;
    const int K = g.K, nt = K / BK;
    unsigned voffA[2], voffB[2];
#pragma unroll
    for (int i = 0; i < 2; ++i) { int R, C; stage_rc(tid * 16 + i * 8192, R, C); const int Rb = Epi::PERM ? ((R & ~31) + perm32(R & 31)) : R;
        voffA[i] = (unsigned)(R * K + C) * 2u; voffB[i] = (unsigned)(Rb * K + C) * 2u; }
    const size_t kstep = (size_t)(BK * 2);
    const size_t hstep = (size_t)HALF * K * 2;
    const size_t tstep = 2 * hstep;
    const unsigned ldsw = (unsigned)wid * 1024u;
    const int aoff = lds_byte(wr * 64 + fr, fq * 8), boff = lds_byte(wc * 32 + fr, fq * 8);
#define PG8_SA(b, h) (((b) * 2 + (h)) * HTB)
#define PG8_SB(b, h) ((4 + (b) * 2 + (h)) * HTB)
#define PG8_STAGE(bufoff, gbase, voff) do { _Pragma("unroll") for (int _i = 0; _i < 2; ++_i) \
        __builtin_amdgcn_global_load_lds((const unsigned*)((const char*)(gbase) + (voff)[_i]), (PG8_LAS unsigned*)(lds + (bufoff) + ldsw + _i * 8192), 16, 0, 0); } while (0)
#define PG8_LDA(dst, b, h) do { _Pragma("unroll") for (int m = 0; m < 4; ++m) _Pragma("unroll") for (int k = 0; k < 2; ++k) dst[m][k] = *(const PG8_LAS bf16x8*)(lds + PG8_SA(b, h) + aoff + m * 2048 + k * 1024); } while (0)
#define PG8_LDB(dst, b, h) do { _Pragma("unroll") for (int n = 0; n < 2; ++n) _Pragma("unroll") for (int k = 0; k < 2; ++k) dst[n][k] = *(const PG8_LAS bf16x8*)(lds + PG8_SB(b, h) + boff + n * 2048 + k * 1024); } while (0)
#define PG8_MMA(ai, bj, At, Bt) do { __builtin_amdgcn_s_setprio(1); _Pragma("unroll") for (int m = 0; m < 4; ++m) _Pragma("unroll") for (int n = 0; n < 2; ++n) _Pragma("unroll") for (int k = 0; k < 2; ++k) \
        acc[ai][bj][m][n] = __builtin_amdgcn_mfma_f32_16x16x32_bf16(Bt[n][k], At[m][k], acc[ai][bj][m][n], 0, 0, 0); __builtin_amdgcn_s_setprio(0); } while (0)
#define PG8_WAIT_V(n) asm volatile("s_waitcnt vmcnt(" #n ")" ::: "memory")
#define PG8_WAIT_L(n) asm volatile("s_waitcnt lgkmcnt(" #n ")" ::: "memory")
#define PG8_BAR __builtin_amdgcn_s_barrier()
#define PG8_SCHED __builtin_amdgcn_sched_barrier(0)
    Unit cur, nxt; int ui = 0;
    if (!S.next(0, cur)) return;
    f32x4 acc[2][2][4][2];
#pragma unroll
    for (int a = 0; a < 2; ++a)
#pragma unroll
        for (int b = 0; b < 2; ++b)
#pragma unroll
            for (int m = 0; m < 4; ++m)
#pragma unroll
                for (int n = 0; n < 2; ++n) acc[a][b][m][n] = (f32x4){0.f, 0.f, 0.f, 0.f};
    bf16x8 At[4][2], B0[2][2], B1[2][2];
    const char* cA = (const char*)g.A + (size_t)cur.pm * tstep; const char* cB = (const char*)g.Bt + (size_t)cur.pn * tstep;
    S.a_ready(cur);
    if constexpr (SP2) {
        PG8_STAGE(PG8_SB(0, 0), cB, voffB); PG8_STAGE(PG8_SB(0, 1), cB + hstep, voffB); PG8_STAGE(PG8_SA(0, 0), cA, voffA); PG8_STAGE(PG8_SA(0, 1), cA + hstep, voffA);
        if (wr == 1) PG8_BAR;
        PG8_WAIT_V(2); PG8_BAR;
        PG8_STAGE(PG8_SB(1, 0), cB + kstep, voffB); PG8_STAGE(PG8_SA(1, 0), cA + kstep, voffA); PG8_STAGE(PG8_SB(1, 1), cB + hstep + kstep, voffB);
        PG8_WAIT_V(6); PG8_BAR;
    } else {
        PG8_STAGE(PG8_SB(0, 0), cB, voffB); PG8_STAGE(PG8_SA(0, 0), cA, voffA); PG8_STAGE(PG8_SB(0, 1), cB + hstep, voffB); PG8_STAGE(PG8_SA(0, 1), cA + hstep, voffA);
        if (wr == 1) PG8_BAR;
        PG8_WAIT_V(4); PG8_BAR;
        PG8_STAGE(PG8_SB(1, 0), cB + kstep, voffB); PG8_STAGE(PG8_SA(1, 0), cA + kstep, voffA); PG8_STAGE(PG8_SB(1, 1), cB + hstep + kstep, voffB);
        PG8_WAIT_V(6); PG8_BAR;
    }
    for (;;) {
        const bool has_next = S.next(ui + 1, nxt);
        const char* nA = has_next ? (const char*)g.A + (size_t)nxt.pm * tstep : cA; const char* nB = has_next ? (const char*)g.Bt + (size_t)nxt.pn * tstep : cB;
        for (int t = 0; t < nt; t += 2) {
            const bool last = (t == nt - 2);
            const char* a1 = cA + (size_t)(t + 1) * kstep;
            const char* a2 = last ? nA : cA + (size_t)(t + 2) * kstep; const char* b2 = last ? nB : cB + (size_t)(t + 2) * kstep;
            const char* a3 = a2 + kstep; const char* b3 = b2 + kstep;
            if (last && has_next) S.a_ready(nxt);
            if constexpr (SP2) {
            PG8_LDB(B0, 0, 0); PG8_LDB(B1, 0, 1); PG8_SCHED; PG8_LDA(At, 0, 0); PG8_STAGE(PG8_SA(1, 1), a1 + hstep, voffA);
            PG8_WAIT_V(8); PG8_WAIT_L(0); PG8_BAR; PG8_MMA(0, 0, At, B0); PG8_MMA(0, 1, At, B1); PG8_BAR; PG8_SCHED;
            PG8_LDA(At, 0, 1); PG8_STAGE(PG8_SB(0, 0), b2, voffB); PG8_STAGE(PG8_SB(0, 1), b2 + hstep, voffB); PG8_STAGE(PG8_SA(0, 0), a2, voffA);
            PG8_WAIT_V(8); PG8_WAIT_L(0); PG8_BAR; PG8_MMA(1, 0, At, B0); PG8_MMA(1, 1, At, B1); PG8_BAR; PG8_SCHED;
            PG8_LDB(B0, 1, 0); PG8_LDB(B1, 1, 1); PG8_SCHED; PG8_LDA(At, 1, 0); PG8_STAGE(PG8_SA(0, 1), a2 + hstep, voffA);
            PG8_WAIT_V(8); PG8_WAIT_L(0); PG8_BAR; PG8_MMA(0, 0, At, B0); PG8_MMA(0, 1, At, B1); PG8_BAR; PG8_SCHED;
            PG8_LDA(At, 1, 1); PG8_STAGE(PG8_SB(1, 0), b3, voffB); PG8_STAGE(PG8_SB(1, 1), b3 + hstep, voffB); PG8_STAGE(PG8_SA(1, 0), a3, voffA);
            PG8_WAIT_V(8); PG8_WAIT_L(0); PG8_BAR; PG8_MMA(1, 0, At, B0); PG8_MMA(1, 1, At, B1); PG8_BAR; PG8_SCHED;
            } else {
            PG8_LDB(B0, 0, 0); PG8_SCHED; PG8_LDA(At, 0, 0); PG8_STAGE(PG8_SA(1, 1), a1 + hstep, voffA);
            PG8_WAIT_L(8); PG8_BAR; PG8_WAIT_L(0); PG8_MMA(0, 0, At, B0); PG8_BAR; PG8_SCHED;
            PG8_LDB(B1, 0, 1); PG8_STAGE(PG8_SB(0, 0), b2, voffB);
            PG8_BAR; PG8_WAIT_L(0); PG8_MMA(0, 1, At, B1); PG8_BAR;
            PG8_LDA(At, 0, 1); PG8_STAGE(PG8_SA(0, 0), a2, voffA);
            PG8_BAR; PG8_WAIT_L(0); PG8_MMA(1, 0, At, B0); PG8_BAR; PG8_SCHED;
            PG8_STAGE(PG8_SB(0, 1), b2 + hstep, voffB);
            PG8_WAIT_V(6); PG8_BAR; PG8_MMA(1, 1, At, B1); PG8_BAR;
            PG8_LDB(B0, 1, 0); PG8_SCHED; PG8_LDA(At, 1, 0); PG8_STAGE(PG8_SA(0, 1), a2 + hstep, voffA);
            PG8_WAIT_L(8); PG8_BAR; PG8_WAIT_L(0); PG8_MMA(0, 0, At, B0); PG8_BAR; PG8_SCHED;
            PG8_LDB(B1, 1, 1); PG8_STAGE(PG8_SB(1, 0), b3, voffB);
            PG8_BAR; PG8_WAIT_L(0); PG8_MMA(0, 1, At, B1); PG8_BAR;
            PG8_LDA(At, 1, 1); PG8_STAGE(PG8_SA(1, 0), a3, voffA);
            PG8_BAR; PG8_WAIT_L(0); PG8_MMA(1, 0, At, B0); PG8_BAR; PG8_SCHED;
            PG8_STAGE(PG8_SB(1, 1), b3 + hstep, voffB);
            PG8_WAIT_V(6); PG8_BAR; PG8_MMA(1, 1, At, B1); PG8_BAR;
            }
        }
        if constexpr (ALIGN_EPI) { if (wr == 0) PG8_BAR; }
        if constexpr (!Epi::AFTER_DRAIN) { E(acc, cur, wr, wc, fr, fq); S.done(cur); }
        if (!has_next) break;
#pragma unroll
        for (int a = 0; a < 2; ++a)
#pragma unroll
            for (int b = 0; b < 2; ++b)
#pragma unroll
                for (int m = 0; m < 4; ++m)
#pragma unroll
                    for (int n = 0; n < 2; ++n) acc[a][b][m][n] = (f32x4){0.f, 0.f, 0.f, 0.f};
        cur = nxt; cA = nA; cB = nB; ++ui;
        if constexpr (ALIGN_EPI) { if (wr == 1) PG8_BAR; }
    }
    PG8_WAIT_V(0);
    if constexpr (!ALIGN_EPI) { if (wr == 0) PG8_BAR; }
    PG8_BAR;
    if constexpr (Epi::AFTER_DRAIN) { E.fused(acc, cur, wr, wc, fr, fq, lds, wid, lane); S.done(cur); }
#undef PG8_SA
#undef PG8_SB
#undef PG8_STAGE
#undef PG8_LDA
#undef PG8_LDB
#undef PG8_MMA
#undef PG8_WAIT_V
#undef PG8_WAIT_L
#undef PG8_BAR
#undef PG8_SCHED
}
}

#ifndef PG8_SP2
#define PG8_SP2 true
#endif
#ifndef PG8_ALIGN
#define PG8_ALIGN true
#endif
constexpr int RING_OFF = 0, RING_BYTES = 131072;
constexpr int LDSCTL_OFF = RING_BYTES, MISC_OFF = LDSCTL_OFF + 320;
constexpr int RTAB_OFF = RING_BYTES + 1024;
constexpr int LDS_BYTES = 147456;
constexpr int NWAVES = 8;
constexpr int CW_BAR = 4096;

#define GAS __attribute__((address_space(1)))
#define LAS __attribute__((address_space(3)))
typedef unsigned v4u __attribute__((ext_vector_type(4)));
typedef float f32x4 __attribute__((ext_vector_type(4)));
typedef GAS unsigned gu32;
#define LDS_WAIT() asm volatile("s_waitcnt lgkmcnt(0)" ::: "memory")
#define VM_WAIT() asm volatile("s_waitcnt vmcnt(0)" ::: "memory")
__device__ __forceinline__ unsigned f2bf_u(float f) { unsigned u = __builtin_bit_cast(unsigned, f); return (u + 0x7fffu + ((u >> 16) & 1u)) >> 16; }
__device__ __forceinline__ unsigned pk2(float lo, float hi) { return f2bf_u(lo) | (f2bf_u(hi) << 16); }
__device__ __forceinline__ float wave_sum(float v) {
#pragma unroll
    for (int o = 1; o < 64; o <<= 1) v += __shfl_xor(v, o);
    return v;
}

#define XB_TMO      128
#define XB_XCNT(j)  (256  + 64 * (j))
#define XB_XSUB(j)  (1280 + 64 * (j))
#define XB_XGEN(j)  (2304 + 64 * (j))
#define XB_TOP      3328
#define XB_TOPGEN   3392
#define XCD_BAR_WORDS 3456
#define XB_SPIN_CAP (1u << 18)

__device__ __forceinline__ unsigned xb_ld(unsigned* p)              { return __hip_atomic_load(p, __ATOMIC_RELAXED, __HIP_MEMORY_SCOPE_AGENT); }
__device__ __forceinline__ unsigned xb_add(unsigned* p, unsigned v) { return __hip_atomic_fetch_add(p, v, __ATOMIC_RELAXED, __HIP_MEMORY_SCOPE_AGENT); }
__device__ __forceinline__ unsigned xb_xcc_id() { return (unsigned)__builtin_amdgcn_s_getreg((3 << 11) | 20) & 0xFu; }
#define XB_SPIN(cond, bar) do { unsigned _sp = 0; while (cond) { __builtin_amdgcn_s_sleep(1); \
    if ((++_sp & 255u) == 0u) { if (xb_ld(&(bar)[XB_TMO])) break; if (_sp > XB_SPIN_CAP) { atomicAdd(&(bar)[XB_TMO], 1u); break; } } } } while (0)

struct XcdBarrier {
    unsigned* bar; unsigned x;
    volatile LAS unsigned* st;
};

__device__ __forceinline__ XcdBarrier xcd_barrier_post(unsigned* bar, volatile LAS unsigned* st) {
    XcdBarrier b; b.bar = bar; b.x = xb_xcc_id(); b.st = st;
    if (threadIdx.x == 0) (void)xb_add(&bar[XB_XCNT(b.x)], 1u);
    return b;
}
__device__ __forceinline__ void xcd_barrier_complete(unsigned* bar, unsigned x, unsigned& nloc, unsigned& nx) {
    const unsigned G = gridDim.x * gridDim.y * gridDim.z;
    unsigned sum, cnt, mine, sp = 0u;
    for (;;) {
        sum = 0u; cnt = 0u; mine = 0u;
#pragma unroll
        for (unsigned j = 0; j < 16; ++j) { const unsigned c = xb_ld(&bar[XB_XCNT(j)]); sum += c; cnt += (c > 0u) ? 1u : 0u; mine = (j == x) ? c : mine; }
        if (sum == G) break;
        __builtin_amdgcn_s_sleep(1);
        if ((++sp & 255u) == 0u) { if (xb_ld(&bar[XB_TMO])) break; if (sp > XB_SPIN_CAP) { atomicAdd(&bar[XB_TMO], 1u); break; } }
    }
    nloc = mine > 0u ? mine : 1u; nx = cnt > 0u ? cnt : 1u;
}

__device__ __forceinline__ void xcd_barrier(const XcdBarrier& b) {
    asm volatile("s_waitcnt vmcnt(0)" ::: "memory");
    __syncthreads();
    if (threadIdx.x == 0) {
        unsigned* bar = b.bar;
        __builtin_amdgcn_s_waitcnt(0);
        unsigned nloc = b.st[0], nx = b.st[1];
        if (nloc == 0u) { xcd_barrier_complete(bar, b.x, nloc, nx); b.st[0] = nloc; b.st[1] = nx; }
        const unsigned old = xb_add(&bar[XB_XSUB(b.x)], 1u);
        const unsigned gen = old / nloc;
        if (old + 1u == (gen + 1u) * nloc) {
            __builtin_amdgcn_fence(__ATOMIC_RELEASE, "agent");
            asm volatile("s_waitcnt vmcnt(0)" ::: "memory");
            const unsigned og = xb_add(&bar[XB_TOP], 1u);
            const unsigned tg = og / nx;
            if (og + 1u == (tg + 1u) * nx) xb_add(&bar[XB_TOPGEN], 1u);
            else XB_SPIN(xb_ld(&bar[XB_TOPGEN]) == tg, bar);
            __builtin_amdgcn_fence(__ATOMIC_ACQUIRE, "agent");
            xb_add(&bar[XB_XGEN(b.x)], 1u);
            asm volatile("s_waitcnt vmcnt(0)" ::: "memory");
        } else {
            XB_SPIN(xb_ld(&bar[XB_XGEN(b.x)]) == gen, bar);
            __builtin_amdgcn_fence(__ATOMIC_ACQUIRE, "agent");
            asm volatile("s_waitcnt vmcnt(0)" ::: "memory");
        }
    }
    __syncthreads();
}

namespace hg {
typedef short bf16x8 __attribute__((ext_vector_type(8)));
typedef short s16x4 __attribute__((ext_vector_type(4)));
typedef short v4i16_t __attribute__((ext_vector_type(4)));
typedef float f32x16 __attribute__((ext_vector_type(16)));
typedef float f32x4 __attribute__((ext_vector_type(4)));
typedef float f32x2 __attribute__((ext_vector_type(2)));
typedef unsigned u32x4 __attribute__((ext_vector_type(4)));
typedef unsigned u32x2 __attribute__((ext_vector_type(2)));
#define HG_LAS __attribute__((address_space(3)))
constexpr int L_QS = 0, L_KS = 16384, L_QD = 32768, L_KD = 49152, L_V = 65536, L_TOT = 73728, L_DL = 77824, L_SLAB = 78848, L_END = L_SLAB + 16384;
constexpr float L2E = 1.4426950408889634f;
__device__ __forceinline__ unsigned cvtpk(float lo, float hi) { unsigned r; asm volatile("v_cvt_pk_bf16_f32 %0, %1, %2" : "=v"(r) : "v"(lo), "v"(hi)); return r; }
__device__ __forceinline__ float bf_lo(unsigned u) { return __uint_as_float(u << 16); }
__device__ __forceinline__ float bf_hi(unsigned u) { return __uint_as_float(u & 0xffff0000u); }
__device__ __forceinline__ float h_lo(unsigned u) { return (float)__builtin_bit_cast(_Float16, (unsigned short)(u & 0xffffu)); }
__device__ __forceinline__ float h_hi(unsigned u) { return (float)__builtin_bit_cast(_Float16, (unsigned short)(u >> 16)); }
__device__ __forceinline__ s16x4 vtr(const HG_LAS unsigned char* p) { return __builtin_bit_cast(s16x4, __builtin_amdgcn_ds_read_tr16_b64_v4i16((HG_LAS v4i16_t*)p)); }
__device__ __forceinline__ bf16x8 pk8(const f32x16& x, int b) {
    u32x4 w; w.x = cvtpk(x[b], x[b + 1]); w.y = cvtpk(x[b + 2], x[b + 3]); w.z = cvtpk(x[b + 4], x[b + 5]); w.w = cvtpk(x[b + 6], x[b + 7]); return __builtin_bit_cast(bf16x8, w); }
__device__ __forceinline__ bf16x8 cat8(s16x4 lo, s16x4 hi) { return (bf16x8){lo[0], lo[1], lo[2], lo[3], hi[0], hi[1], hi[2], hi[3]}; }

__device__ __forceinline__ void hgrn_item(HG_LAS unsigned char* lds, const u16* __restrict__ PROJ, u16* __restrict__ ODIR, int item, int tid) {
    const int lane = tid & 63, w = __builtin_amdgcn_readfirstlane(tid >> 6), hi = lane >> 5, c32 = lane & 31;
    const int vh = item & 1, dir = (item >> 1) & 1, h = (item >> 2) & 7, b = item >> 5;
    const int ib = w & 1, jb = (w >> 1) & 1, kh = w >> 2;
    const size_t rowbase = (size_t)b * SEQ;
    const int cq = h * 128 + 2 * lane, cf = 2048 + dir * 1024 + h * 128 + 2 * lane, cv = 1024 + h * 128 + vh * 64 + (tid & 7) * 8;
    const int vs = tid >> 3, vc8 = tid & 7;
    f32x16 S0, S1;
#pragma unroll
    for (int r = 0; r < 16; ++r) { S0[r] = 0.f; S1[r] = 0.f; }
    unsigned q2[8], l2[8]; u32x4 vreg;
#define HG_TOK(c, i) (dir ? (SEQ - 1 - (64 * (c) + (i))) : (64 * (c) + (i)))
#define HG_LOAD(c) do { _Pragma("unroll") for (int r = 0; r < 8; ++r) { const u16* rp = PROJ + (rowbase + HG_TOK(c, 8 * w + r)) * 8192; q2[r] = *(const unsigned*)(rp + cq); l2[r] = *(const unsigned*)(rp + cf); } \
        vreg = *(const u32x4*)(PROJ + (rowbase + HG_TOK(c, vs)) * 8192 + cv); } while (0)
    HG_LOAD(0);
    const int trb = (4 * hi + ((lane & 15) >> 2)) * 64 + ((lane >> 4) & 1) * 32 + (lane & 3) * 8;
    HG_LAS float* tot = (HG_LAS float*)(lds + L_TOT);
    HG_LAS float* dl = (HG_LAS float*)(lds + L_DL);
    for (int c = 0; c < SEQ / 64; ++c) {
        float c0[8], c1[8]; float a0 = 0.f, a1 = 0.f;
#pragma unroll
        for (int r = 0; r < 8; ++r) { a0 += h_lo(l2[r]); a1 += h_hi(l2[r]); c0[r] = a0; c1[r] = a1; }
        *(HG_LAS f32x2*)(tot + w * 128 + 2 * lane) = (f32x2){a0, a1};
        __syncthreads();
        float p0 = 0.f, p1 = 0.f, m0 = 0.f, m1 = 0.f, t0 = 0.f, t1 = 0.f;
#pragma unroll
        for (int ww = 0; ww < 8; ++ww) { const f32x2 x = *(const HG_LAS f32x2*)(tot + ww * 128 + 2 * lane);
            if (ww < w) { p0 += x.x; p1 += x.y; } if (ww < 4) { m0 += x.x; m1 += x.y; } t0 += x.x; t1 += x.y; }
        const float Em0 = __builtin_amdgcn_exp2f(m0 * L2E), Em1 = __builtin_amdgcn_exp2f(m1 * L2E);
        const float El0 = __builtin_amdgcn_exp2f((t0 - m0) * L2E), El1 = __builtin_amdgcn_exp2f((t1 - m1) * L2E);
        if (w == 0) *(HG_LAS f32x2*)(dl + 2 * lane) = (f32x2){__builtin_amdgcn_exp2f(t0 * L2E), __builtin_amdgcn_exp2f(t1 * L2E)};
#pragma unroll
        for (int r = 0; r < 8; ++r) {
            const int i = 8 * w + r;
            float x0 = (p0 + c0[r] - m0) * L2E, x1 = (p1 + c1[r] - m1) * L2E;
            x0 = __builtin_fminf(__builtin_fmaxf(x0, -115.f), 115.f); x1 = __builtin_fminf(__builtin_fmaxf(x1, -115.f), 115.f);
            const float e0 = __builtin_amdgcn_exp2f(x0), e1 = __builtin_amdgcn_exp2f(x1), g0 = __builtin_amdgcn_exp2f(-x0), g1 = __builtin_amdgcn_exp2f(-x1);
            const float kk0 = 1.0f - __builtin_amdgcn_exp2f(h_lo(l2[r]) * L2E), kk1 = 1.0f - __builtin_amdgcn_exp2f(h_hi(l2[r]) * L2E);
            const float qs0 = bf_lo(q2[r]) * e0, qs1 = bf_hi(q2[r]) * e1, ks0 = kk0 * g0, ks1 = kk1 * g1;
            const int sw = i * 256 + ((((lane >> 2) ^ (i & 15))) << 4) + (lane & 3) * 4;
            *(HG_LAS unsigned*)(lds + L_QS + sw) = cvtpk(qs0, qs1);
            *(HG_LAS unsigned*)(lds + L_KS + sw) = cvtpk(ks0, ks1);
            *(HG_LAS unsigned*)(lds + L_QD + sw) = cvtpk(qs0 * Em0, qs1 * Em1);
            *(HG_LAS unsigned*)(lds + L_KD + (((lane >> 4) * 4 + (i >> 4)) * 1024) + (i & 15) * 64 + (lane & 15) * 4) = cvtpk(ks0 * El0, ks1 * El1);
        }
        *(HG_LAS u32x4*)(lds + L_V + (((vc8 >> 2) * 4 + (vs >> 4)) * 1024) + (vs & 15) * 64 + (vc8 & 3) * 16) = vreg;
        if (c + 1 < SEQ / 64) HG_LOAD(c + 1);
        __syncthreads();
        f32x16 o;
#pragma unroll
        for (int r = 0; r < 16; ++r) o[r] = 0.f;
        { const int row = ib * 32 + c32; const HG_LAS unsigned char* qd = lds + L_QD + row * 256 + 8 * hi;
#pragma unroll
          for (int t2 = 0; t2 < 2; ++t2)
#pragma unroll
            for (int sp = 0; sp < 2; ++sp) { const int ch = (2 * kh + t2) * 4 + 2 * sp;
                const u32x2 lo = *(const HG_LAS u32x2*)(qd + ((ch ^ (row & 15)) << 4)), hh = *(const HG_LAS u32x2*)(qd + (((ch + 1) ^ (row & 15)) << 4));
                const bf16x8 a = __builtin_bit_cast(bf16x8, (u32x4){lo.x, lo.y, hh.x, hh.y});
                o = __builtin_amdgcn_mfma_f32_32x32x16_bf16(a, pk8(t2 ? S1 : S0, 8 * sp), o, 0, 0, 0); } }
        if (kh <= ib) {
            f32x16 X;
#pragma unroll
            for (int r = 0; r < 16; ++r) X[r] = 0.f;
            const int rs = kh * 32 + c32, ri = ib * 32 + c32;
            const HG_LAS unsigned char* ksp = lds + L_KS + rs * 256; const HG_LAS unsigned char* qsp = lds + L_QS + ri * 256;
#pragma unroll
            for (int st = 0; st < 8; ++st) { const int ch = 2 * st + hi;
                const bf16x8 a = *(const HG_LAS bf16x8*)(ksp + ((ch ^ (rs & 15)) << 4)), bq = *(const HG_LAS bf16x8*)(qsp + ((ch ^ (ri & 15)) << 4));
                X = __builtin_amdgcn_mfma_f32_32x32x16_bf16(a, bq, X, 0, 0, 0); }
            if (kh == ib) {
#pragma unroll
                for (int r = 0; r < 16; ++r) { const int sl = (r & 3) + 8 * (r >> 2) + 4 * hi; X[r] = (sl <= c32) ? X[r] : 0.f; }
            }
#pragma unroll
            for (int sp = 0; sp < 2; ++sp) { const HG_LAS unsigned char* vp = lds + L_V + (jb * 4 + 2 * kh + sp) * 1024 + trb;
                const bf16x8 vb = cat8(vtr(vp), vtr(vp + 512));
                o = __builtin_amdgcn_mfma_f32_32x32x16_bf16(pk8(X, 8 * sp), vb, o, 0, 0, 0); }
        }
#pragma unroll
        for (int t2 = 0; t2 < 2; ++t2) {
            const int kt = 2 * kh + t2; f32x16 S = t2 ? S1 : S0;
#pragma unroll
            for (int g = 0; g < 4; ++g) { const f32x4 d = *(const HG_LAS f32x4*)(dl + kt * 32 + 8 * g + 4 * hi); S[4 * g] *= d[0]; S[4 * g + 1] *= d[1]; S[4 * g + 2] *= d[2]; S[4 * g + 3] *= d[3]; }
#pragma unroll
            for (int ks = 0; ks < 4; ++ks) { const HG_LAS unsigned char* kp = lds + L_KD + (kt * 4 + ks) * 1024 + trb; const HG_LAS unsigned char* vp = lds + L_V + (jb * 4 + ks) * 1024 + trb;
                const bf16x8 a = cat8(vtr(kp), vtr(kp + 512)), vb = cat8(vtr(vp), vtr(vp + 512));
                S = __builtin_amdgcn_mfma_f32_32x32x16_bf16(a, vb, S, 0, 0, 0); }
            if (t2) S1 = S; else S0 = S;
        }
        HG_LAS float* slab = (HG_LAS float*)(lds + L_SLAB) + (ib * 2 + jb) * 1024 + lane;
        if (kh == 1) {
#pragma unroll
            for (int r = 0; r < 16; ++r) slab[r * 64] = o[r];
        }
        __syncthreads();
        if (kh == 0) {
            u16* op = ODIR + ((size_t)dir * M + rowbase) * 1024 + h * 128 + vh * 64 + jb * 32 + c32;
#pragma unroll
            for (int r = 0; r < 16; ++r) { const int i = ib * 32 + (r & 3) + 8 * (r >> 2) + 4 * hi; const float v = o[r] + slab[r * 64];
                op[(size_t)HG_TOK(c, i) * 1024] = (u16)(cvtpk(v, v) & 0xffffu); }
        }
    }
#undef HG_TOK
#undef HG_LOAD
}
}

namespace at {
typedef short bf16x8 __attribute__((ext_vector_type(8)));
typedef short s16x4 __attribute__((ext_vector_type(4)));
typedef short v4i16_t __attribute__((ext_vector_type(4)));
typedef float f32x16 __attribute__((ext_vector_type(16)));
typedef float f32x4 __attribute__((ext_vector_type(4)));
typedef unsigned u32x4 __attribute__((ext_vector_type(4)));
#define AT_LAS __attribute__((address_space(3)))
constexpr int L_K = 0, L_V = 16384, L_WS = 49152, L_LUT = 50176, L_END = 51200;
constexpr float THR = 8.0f;
__device__ __forceinline__ unsigned cvtpk(float lo, float hi) { unsigned r; asm volatile("v_cvt_pk_bf16_f32 %0, %1, %2" : "=v"(r) : "v"(lo), "v"(hi)); return r; }
__device__ __forceinline__ s16x4 vtr(const AT_LAS unsigned char* p) { return __builtin_bit_cast(s16x4, __builtin_amdgcn_ds_read_tr16_b64_v4i16((AT_LAS v4i16_t*)p)); }
__device__ __forceinline__ bf16x8 pk8(const f32x16& x, int b) {
    u32x4 w; w.x = cvtpk(x[b], x[b + 1]); w.y = cvtpk(x[b + 2], x[b + 3]); w.z = cvtpk(x[b + 4], x[b + 5]); w.w = cvtpk(x[b + 6], x[b + 7]); return __builtin_bit_cast(bf16x8, w); }
__device__ __forceinline__ bf16x8 cat8(s16x4 lo, s16x4 hi) { return (bf16x8){lo[0], lo[1], lo[2], lo[3], hi[0], hi[1], hi[2], hi[3]}; }
__device__ __forceinline__ int rel_bucket(int rel) {
    const int n = rel < 0 ? -rel : rel; int bk;
    if (n < 8) bk = n; else if (n < 12) bk = 8; else if (n < 16) bk = 9; else if (n < 23) bk = 10; else if (n < 32) bk = 11;
    else if (n < 46) bk = 12; else if (n < 64) bk = 13; else if (n < 91) bk = 14; else bk = 15;
    return bk + (rel > 0 ? 16 : 0);
}

__device__ __forceinline__ void attn_unit(AT_LAS unsigned char* lds, const u16* __restrict__ PROJ, const float* __restrict__ relb, float* O1, u16* __restrict__ CAT, const float* __restrict__ subw,
                                          float lam, int b, int h, int qb, int mp, int tid) {
    const int lane = tid & 63, w = __builtin_amdgcn_readfirstlane(tid >> 6), hi = lane >> 5, c32 = lane & 31;
    const size_t rowbase = (size_t)b * SEQ;
    const int q0w = qb * 256 + w * 32;
    AT_LAS float* wsf = (AT_LAS float*)(lds + L_WS) + w * 32;
    AT_LAS float* lut = (AT_LAS float*)(lds + L_LUT);
    if (tid < 183) lut[tid] = relb[rel_bucket(tid - 91) * 8 + h] * 1.4426950408889634f;
    const float bias_neg = relb[15 * 8 + h] * 1.4426950408889634f, bias_pos = relb[31 * 8 + h] * 1.4426950408889634f;
    bf16x8 qf[4];
    { const unsigned qo = (unsigned)((rowbase + q0w + c32) * 8192 + 5120 + h * 128 + mp * 64 + 8 * hi);
#pragma unroll
      for (int st = 0; st < 4; ++st) qf[st] = *(const bf16x8*)(PROJ + (qo + 16 * st)); }
    f32x16 o[4];
#pragma unroll
    for (int d = 0; d < 4; ++d)
#pragma unroll
        for (int r = 0; r < 16; ++r) o[d][r] = 0.f;
    float mhat = 0.f, l = 0.f;
    const int srow = tid >> 3, sch = tid & 7;
    const unsigned kgo = (unsigned)((rowbase + srow) * 8192 + 6144 + h * 128 + mp * 64 + 8 * sch);
    const unsigned vgo = (unsigned)((rowbase + srow) * 8192 + 7168 + h * 128 + 16 * sch);
    const int kw = srow * 128 + ((sch ^ ((srow >> 1) & 7)) << 4);
    const int vw = (((2 * sch) >> 2) * 4 + (srow >> 4)) * 1024 + (srow & 15) * 64 + ((2 * sch) & 3) * 16;
    const int trb = (4 * hi + ((lane & 15) >> 2)) * 64 + ((lane >> 4) & 1) * 32 + (lane & 3) * 8;
    u32x4 kr, vr0, vr1;
    kr = *(const u32x4*)(PROJ + kgo); vr0 = *(const u32x4*)(PROJ + vgo); vr1 = *(const u32x4*)(PROJ + vgo + 8);
    *(AT_LAS u32x4*)(lds + L_K + kw) = kr; *(AT_LAS u32x4*)(lds + L_V + vw) = vr0; *(AT_LAS u32x4*)(lds + L_V + vw + 16) = vr1;
    __syncthreads();
    constexpr int NT = SEQ / 64;
    for (int t = 0; t < NT; ++t) {
        if (t + 1 < NT) { const unsigned go = (unsigned)(t + 1) * 64u * 8192u; kr = *(const u32x4*)(PROJ + (kgo + go)); vr0 = *(const u32x4*)(PROJ + (vgo + go)); vr1 = *(const u32x4*)(PROJ + (vgo + go + 8)); }
        const AT_LAS unsigned char* Kb = lds + L_K + (t & 1) * 8192; const AT_LAS unsigned char* Vb = lds + L_V + (t & 1) * 16384;
        const int kv0 = 64 * t, rel_min = kv0 - (q0w + 31), rel_max = kv0 + 63 - q0w;
        const int far = (rel_min >= 91) ? 1 : ((rel_max <= -91) ? -1 : 0);
        const float ini = (far > 0 ? bias_pos : (far < 0 ? bias_neg : 0.f)) - mhat;
        f32x16 p0, p1;
#pragma unroll
        for (int r = 0; r < 16; ++r) { p0[r] = ini; p1[r] = ini; }
        { const int r0 = c32, r1 = 32 + c32;
#pragma unroll
          for (int st = 0; st < 4; ++st) { const int ch = 2 * st + hi;
              const bf16x8 a0 = *(const AT_LAS bf16x8*)(Kb + r0 * 128 + ((ch ^ ((r0 >> 1) & 7)) << 4)), a1 = *(const AT_LAS bf16x8*)(Kb + r1 * 128 + ((ch ^ ((r1 >> 1) & 7)) << 4));
              p0 = __builtin_amdgcn_mfma_f32_32x32x16_bf16(a0, qf[st], p0, 0, 0, 0); p1 = __builtin_amdgcn_mfma_f32_32x32x16_bf16(a1, qf[st], p1, 0, 0, 0); } }
        if (far == 0) {
            const int rb = kv0 + 4 * hi - (q0w + c32) + 91;
#pragma unroll
            for (int r = 0; r < 16; ++r) { const int i0 = rb + (r & 3) + 8 * (r >> 2), i1 = i0 + 32;
                p0[r] += lut[i0 < 0 ? 0 : (i0 > 182 ? 182 : i0)]; p1[r] += lut[i1 < 0 ? 0 : (i1 > 182 ? 182 : i1)]; }
        }
        float rm = __builtin_fmaxf(p0[0], p1[0]);
#pragma unroll
        for (int r = 1; r < 16; ++r) rm = __builtin_fmaxf(rm, __builtin_fmaxf(p0[r], p1[r]));
        rm = __builtin_fmaxf(rm, __shfl_xor(rm, 32));
        if (t == 0 || __any(rm > THR)) {
            const float dl = (t == 0) ? rm : __builtin_fmaxf(rm, 0.f);
            mhat += dl;
#pragma unroll
            for (int r = 0; r < 16; ++r) { p0[r] -= dl; p1[r] -= dl; }
            if (t > 0) { const float f = __builtin_amdgcn_exp2f(-dl); l *= f;
                if (hi == 0) wsf[c32] = f;
                asm volatile("s_waitcnt lgkmcnt(0)" ::: "memory");
#pragma unroll
                for (int g = 0; g < 4; ++g) { const f32x4 fv = *(const AT_LAS f32x4*)(wsf + 8 * g + 4 * hi);
#pragma unroll
                    for (int d = 0; d < 4; ++d) { o[d][4 * g] *= fv[0]; o[d][4 * g + 1] *= fv[1]; o[d][4 * g + 2] *= fv[2]; o[d][4 * g + 3] *= fv[3]; } }
            }
        }
        float ls = 0.f;
#pragma unroll
        for (int r = 0; r < 16; ++r) { p0[r] = __builtin_amdgcn_exp2f(p0[r]); p1[r] = __builtin_amdgcn_exp2f(p1[r]); ls += p0[r] + p1[r]; }
        l += ls;
        const bf16x8 pa0 = pk8(p0, 0), pa1 = pk8(p0, 8), pa2 = pk8(p1, 0), pa3 = pk8(p1, 8);
#pragma unroll
        for (int d = 0; d < 4; ++d) { const AT_LAS unsigned char* vp = Vb + d * 4096 + trb;
            o[d] = __builtin_amdgcn_mfma_f32_32x32x16_bf16(pa0, cat8(vtr(vp), vtr(vp + 512)), o[d], 0, 0, 0);
            o[d] = __builtin_amdgcn_mfma_f32_32x32x16_bf16(pa1, cat8(vtr(vp + 1024), vtr(vp + 1024 + 512)), o[d], 0, 0, 0);
            o[d] = __builtin_amdgcn_mfma_f32_32x32x16_bf16(pa2, cat8(vtr(vp + 2048), vtr(vp + 2048 + 512)), o[d], 0, 0, 0);
            o[d] = __builtin_amdgcn_mfma_f32_32x32x16_bf16(pa3, cat8(vtr(vp + 3072), vtr(vp + 3072 + 512)), o[d], 0, 0, 0); }
        if (t + 1 < NT) { const int nb = (t + 1) & 1;
            *(AT_LAS u32x4*)(lds + L_K + nb * 8192 + kw) = kr; *(AT_LAS u32x4*)(lds + L_V + nb * 16384 + vw) = vr0; *(AT_LAS u32x4*)(lds + L_V + nb * 16384 + vw + 16) = vr1; }
        __syncthreads();
    }
    l += __shfl_xor(l, 32);
    if (hi == 0) wsf[c32] = __builtin_amdgcn_rcpf(l);
    asm volatile("s_waitcnt lgkmcnt(0)" ::: "memory");
    float rl[16];
#pragma unroll
    for (int g = 0; g < 4; ++g) { const f32x4 fv = *(const AT_LAS f32x4*)(wsf + 8 * g + 4 * hi); rl[4 * g] = fv[0]; rl[4 * g + 1] = fv[1]; rl[4 * g + 2] = fv[2]; rl[4 * g + 3] = fv[3]; }
    unsigned oo = (unsigned)((rowbase + q0w + 4 * hi) * 1024 + h * 128 + c32);
    if (mp == 0) {
#pragma unroll
        for (int r = 0; r < 16; ++r) { unsigned ro = oo + (unsigned)(((r & 3) + 8 * (r >> 2)) * 1024); asm volatile("" : "+v"(ro));
#pragma unroll
            for (int d = 0; d < 4; ++d) O1[ro + d * 32] = o[d][r] * rl[r]; }
    } else {
        float sw[4];
#pragma unroll
        for (int d = 0; d < 4; ++d) sw[d] = subw[d * 32 + c32] * 0.8f;
        const unsigned co = (unsigned)((rowbase + q0w + 4 * hi) * 2048 + 1024 + h * 128 + c32);
#pragma unroll
        for (int r = 0; r < 16; ++r) { unsigned ro = oo + (unsigned)(((r & 3) + 8 * (r >> 2)) * 1024), rc = co + (unsigned)(((r & 3) + 8 * (r >> 2)) * 2048); asm volatile("" : "+v"(ro), "+v"(rc));
            float x[4]; float ss = 0.f;
#pragma unroll
            for (int d = 0; d < 4; ++d) { x[d] = O1[ro + d * 32] - lam * (o[d][r] * rl[r]); ss += x[d] * x[d]; }
            ss += __shfl_xor(ss, 1); ss += __shfl_xor(ss, 2); ss += __shfl_xor(ss, 4); ss += __shfl_xor(ss, 8); ss += __shfl_xor(ss, 16);
            const float rr = __builtin_amdgcn_rsqf(ss * (1.0f / 128.0f) + 1e-6f);
#pragma unroll
            for (int d = 0; d < 4; ++d) CAT[rc + d * 32] = (u16)(cvtpk(x[d] * rr * sw[d], 0.f) & 0xffffu); }
    }
}
}

__device__ __forceinline__ void p0_item(const float* W, int K, int N, const float* ksc, u16* WT, LAS float* scr, int k0, int n0, int drow0, int lane) {
#pragma unroll 8
    for (int i = 0; i < 32; ++i) { const int kk = 2 * i + (lane >> 5); float w = W[(size_t)(k0 + kk) * N + n0 + (lane & 31)]; if (ksc) w *= ksc[k0 + kk]; scr[kk * 33 + (lane & 31)] = w; }
    LDS_WAIT(); asm volatile("" ::: "memory");
    const int c = lane & 7;
#pragma unroll
    for (int j = 0; j < 4; ++j) { const int n = (lane >> 3) + 8 * j; const LAS float* s = scr + (8 * c) * 33 + n;
        v4u o; o.x = pk2(s[0 * 33], s[1 * 33]); o.y = pk2(s[2 * 33], s[3 * 33]); o.z = pk2(s[4 * 33], s[5 * 33]); o.w = pk2(s[6 * 33], s[7 * 33]);
        *(GAS v4u*)(WT + (size_t)(drow0 + n) * K + k0 + 8 * c) = o; }
    LDS_WAIT(); asm volatile("" ::: "memory");
}
__device__ __forceinline__ void rms_row_to_bf16(const float* xrow, const float* w, u16* orow, int lane) {
    const f32x4* xr = (const f32x4*)xrow + lane;
    f32x4 v[8]; float s = 0.f;
#pragma unroll
    for (int j = 0; j < 8; ++j) { v[j] = xr[64 * j]; s += (v[j].x * v[j].x + v[j].y * v[j].y) + (v[j].z * v[j].z + v[j].w * v[j].w); }
    const float r = __builtin_amdgcn_rsqf(wave_sum(s) * (1.0f / DM) + EPS);
    const f32x4* wr = (const f32x4*)w + lane;
    uint2* o = (uint2*)orow + lane;
#pragma unroll
    for (int j = 0; j < 8; ++j) { const f32x4 ww = wr[64 * j]; uint2 p; p.x = pk2(v[j].x * r * ww.x, v[j].y * r * ww.y); p.y = pk2(v[j].z * r * ww.z, v[j].w * r * ww.w); o[64 * j] = p; }
}
__device__ __forceinline__ void rms_row_inplace(float* xrow, const float* w, int lane) {
    f32x4* xr = (f32x4*)xrow + lane;
    f32x4 v[8]; float s = 0.f;
#pragma unroll
    for (int j = 0; j < 8; ++j) { v[j] = xr[64 * j]; s += (v[j].x * v[j].x + v[j].y * v[j].y) + (v[j].z * v[j].z + v[j].w * v[j].w); }
    const float r = __builtin_amdgcn_rsqf(wave_sum(s) * (1.0f / DM) + EPS);
    const f32x4* wr = (const f32x4*)w + lane;
#pragma unroll
    for (int j = 0; j < 8; ++j) { const f32x4 ww = wr[64 * j]; xr[64 * j] = v[j] * r * ww; }
}

struct Args { const float* in[17]; float* out; unsigned char* ws; int ph_lo, ph_hi, li, pad; };
enum { PH_PRO = 0, PH_INPROJ = 1, PH_MIX = 2, PH_HGFIN = 3, PH_OUTPROJ = 4, PH_GATEUP = 5, PH_DOWN = 6, PH_FINAL = 7, PH_N = 8 };

__global__ void __launch_bounds__(NWAVES * 64, 2) mk_fwd(Args args) {
    extern __shared__ __attribute__((aligned(16))) unsigned char lds_raw[];
    LAS unsigned char* lds = (LAS unsigned char*)lds_raw;
    volatile LAS unsigned* MISC = (volatile LAS unsigned*)(lds + MISC_OFF);
    const int tid = threadIdx.x, lane = tid & 63, wave = __builtin_amdgcn_readfirstlane(tid >> 6);
    const int G = gridDim.x; const int bx = blockIdx.x; const int vcu = (G % 8 == 0) ? (bx % 8) * (G / 8) + bx / 8 : bx;
    unsigned char* ws = args.ws;
    gu32* ctl = (gu32*)(ws + WS_CTL);
    float* part = (float*)(ws + WS_PART);
    u16* WinT = (u16*)(ws + WS_WIN); u16* WoT = (u16*)(ws + WS_WO); u16* WguT = (u16*)(ws + WS_WGU); u16* WdT = (u16*)(ws + WS_WD);
    u16* XN = (u16*)(ws + WS_XN); u16* BB = (u16*)(ws + WS_B); u16* PROJ = (u16*)(ws + WS_PROJ);
    for (int u = tid; u < (LDS_BYTES - LDSCTL_OFF) / 4; u += NWAVES * 64) ((LAS unsigned*)(lds + LDSCTL_OFF))[u] = 0u;
    __syncthreads();
    XcdBarrier bar = xcd_barrier_post((unsigned*)(ctl + CW_BAR) + args.li * XCD_BAR_WORDS, MISC + 8);
    const int lo = args.ph_lo, hi = args.ph_hi;
#define IN(k) (lo <= (k) && (k) < hi)
#define SEAM(k) do { if (IN(k) && (k) + 1 < hi) xcd_barrier(bar); } while (0)
    const int gw = vcu * NWAVES + wave, NGW = G * NWAVES;

    if (IN(PH_PRO)) {
        LAS float* scr = (LAS float*)(lds + RING_OFF + wave * 16384);
        constexpr int I_IN = (DM / 64) * (INC / 32), I_O = (DM / 64) * (DM / 32), I_G = (DM / 64) * (DFF / 32), I_D = (DFF / 64) * (DM / 32);
        constexpr int NITEMS = I_IN + I_O + 2 * I_G + I_D;
        for (int it = gw; it < NITEMS; it += NGW) {
            int r = it;
            if (r < I_IN) { const int nblk = INC / 32, k0 = 64 * (r / nblk), n0 = 32 * (r % nblk); p0_item(args.in[2], DM, INC, nullptr, WinT, scr, k0, n0, n0, lane); continue; } r -= I_IN;
            if (r < I_O) { const int nblk = DM / 32, k0 = 64 * (r / nblk), n0 = 32 * (r % nblk); p0_item(args.in[11], DM, DM, nullptr, WoT, scr, k0, n0, n0, lane); continue; } r -= I_O;
            if (r < 2 * I_G) { const int up = r >= I_G ? 1 : 0; if (up) r -= I_G; const int nblk = DFF / 32, k0 = 64 * (r / nblk), n0 = 32 * (r % nblk);
                p0_item(args.in[up ? 14 : 13], DM, DFF, args.in[12], WguT, scr, k0, n0, 256 * (n0 >> 7) + 128 * up + (n0 & 127), lane); continue; } r -= 2 * I_G;
            { const int nblk = DM / 32, k0 = 64 * (r / nblk), n0 = 32 * (r % nblk); p0_item(args.in[15], DFF, DM, nullptr, WdT, scr, k0, n0, n0, lane); }
        }
        for (int m = gw; m < M; m += NGW) rms_row_to_bf16(args.in[0] + (size_t)m * DM, args.in[1], XN + (size_t)m * DM, lane);
    }
    SEAM(PH_PRO);
    if (IN(PH_INPROJ)) {
        pg8::Gemm g{XN, WinT, M, INC, DM}; pg8::StaticOrder S; S.init(M, INC, G, bx);
        pg8::EpiInProj E{PROJ, args.in[3]};
        pg8::gemm_phase<pg8::EpiInProj, pg8::StaticOrder, PG8_ALIGN, PG8_SP2>(lds + RING_OFF, g, S, E);
    }
    SEAM(PH_INPROJ);
    if (IN(PH_MIX)) {
        for (int item = vcu; item < 256; item += G) { hg::hgrn_item(lds + RING_OFF, PROJ, BB, item, tid); __syncthreads(); }
        { const float lam = __expf(wave_sum(args.in[5][lane] * args.in[6][lane])) - __expf(wave_sum(args.in[7][lane] * args.in[8][lane])) + 0.2f;
          for (int p = vcu; p < 512; p += G) { const int b = p >> 6, h = (p >> 3) & 7, qb = p & 7;
              at::attn_unit(lds + RING_OFF, PROJ, args.in[10], args.out, XN, args.in[9], lam, b, h, qb, 0, tid);
              at::attn_unit(lds + RING_OFF, PROJ, args.in[10], args.out, XN, args.in[9], lam, b, h, qb, 1, tid); } }
    }
    SEAM(PH_MIX);
    if (IN(PH_HGFIN)) {
        const float w0 = args.in[4][lane * 2], w1 = args.in[4][lane * 2 + 1];
        for (int p = gw; p < M * 8; p += NGW) { const int m = p >> 3, c = (p & 7) * 128 + lane * 2;
            const unsigned a = *(const unsigned*)(BB + (size_t)m * HGW + c), bb = *(const unsigned*)(BB + ((size_t)M + m) * HGW + c);
            const float o0 = __uint_as_float(a << 16) + __uint_as_float(bb << 16), o1 = __uint_as_float(a & 0xffff0000u) + __uint_as_float(bb & 0xffff0000u);
            const float r = __builtin_amdgcn_rsqf(wave_sum(o0 * o0 + o1 * o1) * (1.0f / 128.0f) + EPS);
            const unsigned g = *(const unsigned*)(PROJ + (size_t)m * INC + 4096 + c);
            *(unsigned*)(XN + (size_t)m * DM + c) = pk2(o0 * r * w0 * __uint_as_float(g << 16), o1 * r * w1 * __uint_as_float(g & 0xffff0000u)); }
    }
    SEAM(PH_HGFIN);
    if (IN(PH_OUTPROJ)) {
        pg8::Gemm g{XN, WoT, M, DM, DM}; pg8::StaticOrder S; S.init(M, DM, G, bx);
        pg8::EpiOutProj E{args.in[0], args.out, BB, part};
        pg8::gemm_phase<pg8::EpiOutProj, pg8::StaticOrder, PG8_ALIGN, PG8_SP2>(lds + RING_OFF, g, S, E);
    }
    SEAM(PH_OUTPROJ);
    if (IN(PH_GATEUP)) {
        pg8::Gemm g{BB, WguT, M, NGU, DM}; pg8::StaticOrder S; S.init(M, NGU, G, bx);
        pg8::Unit u0; u0.pm = 0; u0.pn = 0; (void)S.next(0, u0);
        LAS float* rtab = (LAS float*)(lds + RTAB_OFF);
        if (tid < 256) { const GAS f32x4* p = (const GAS f32x4*)(part + (size_t)(u0.pm * 256 + tid) * 32); float s = 0.f;
#pragma unroll
            for (int j = 0; j < 8; ++j) { const f32x4 q = p[j]; s += (q[0] + q[1]) + (q[2] + q[3]); }
            rtab[tid] = __builtin_amdgcn_rsqf(s * (1.0f / DM) + EPS); }
        __syncthreads();
        pg8::EpiSwiGLU E{PROJ, (const LAS float*)rtab, u0.pm, part};
        pg8::gemm_phase<pg8::EpiSwiGLU, pg8::StaticOrder, PG8_ALIGN, PG8_SP2>(lds + RING_OFF, g, S, E);
    }
    SEAM(PH_GATEUP);
    if (IN(PH_DOWN)) {
        pg8::Gemm g{PROJ, WdT, M, DM, DFF}; pg8::StaticOrder S; S.init(M, DM, G, bx);
        pg8::EpiDown E{args.out};
        pg8::gemm_phase<pg8::EpiDown, pg8::StaticOrder, PG8_ALIGN, PG8_SP2>(lds + RING_OFF, g, S, E);
    }
    SEAM(PH_DOWN);
    if (IN(PH_FINAL)) {
        for (int m = gw; m < M; m += NGW) rms_row_inplace(args.out + (size_t)m * DM, args.in[16], lane);
    }
#undef IN
#undef SEAM
}

extern "C" void kernel_launch(void* const* d_in, const int* in_sizes, int n_in, void* d_out, int out_size, void* d_ws, size_t ws_size, hipStream_t stream) {
    static int grid = 0;
    if (grid == 0) {
        if (n_in != 17 || ws_size < WS_NEED || out_size != M * DM) { fprintf(stderr, "kernel_launch: unexpected shapes (n_in %d, ws %zu, out %d)\n", n_in, ws_size, out_size); grid = -1; return; }
        int dev = 0, cus = 0;
        if (hipGetDevice(&dev) != hipSuccess || hipDeviceGetAttribute(&cus, hipDeviceAttributeMultiprocessorCount, dev) != hipSuccess) { grid = -1; return; }
        if (hipFuncSetAttribute((const void*)mk_fwd, hipFuncAttributeMaxDynamicSharedMemorySize, LDS_BYTES) != hipSuccess) { fprintf(stderr, "kernel_launch: hipFuncSetAttribute failed\n"); grid = -1; return; }
        (void)hipGetLastError();
        grid = cus;
    }
    if (grid < 0) return;
    unsigned char* ws = (unsigned char*)d_ws;
    (void)hipMemsetAsync(ws + WS_CTL, 0, CTL_ZERO_BYTES, stream);
    Args a{};
    for (int i = 0; i < 17; ++i) a.in[i] = (const float*)d_in[i];
    a.out = (float*)d_out; a.ws = ws;
    a.ph_lo = PH_PRO; a.ph_hi = PH_N; a.li = 0;
    hipLaunchKernelGGL(mk_fwd, dim3(grid), dim3(NWAVES * 64), LDS_BYTES, stream, a);
}
```

```cpp
#include <hip/hip_runtime.h>
#include <stdint.h>
#include <cstdio>

typedef unsigned short u16;
constexpr int BATCH = 8, SEQ = 2048, DM = 2048, M = BATCH * SEQ;
constexpr int HGW = 1024, DAW = 1024, INC = 8192, DFF = 5632, NGU = 2 * DFF;
constexpr float EPS = 1e-6f;
constexpr float LOG2E = 1.4426950408889634f;
constexpr float C2 = 0.125f * LOG2E;
constexpr size_t MiB = 1u << 20;
constexpr size_t WS_CTL = 0, CTL_ZERO_BYTES = 65536, KMAX2_OFF = 49152  , CMAX_GU_OFF = 65536  , CMAX_IN_OFF = 114688  , WS_PART = 2 * MiB, WS_WIN = 4 * MiB, WS_WO = 36 * MiB, WS_WGU = 44 * MiB, WS_WD = 88 * MiB,
                 WS_XN = 112 * MiB, WS_B = 176 * MiB, WS_PROJ = 240 * MiB, WS_NEED = 496 * MiB;
namespace pg8 {
#define PG8_LAS __attribute__((address_space(3)))
typedef unsigned short bf16_t;
typedef short bf16x8 __attribute__((ext_vector_type(8)));
typedef float f32x4 __attribute__((ext_vector_type(4)));
typedef unsigned u32x4 __attribute__((ext_vector_type(4)));
constexpr int BM = 256, BK = 64, HALF = 128, HTB = HALF * BK * 2  , STAGE_BYTES = 8 * HTB, NXCD = 8, WGM = 8;

__host__ __device__ __forceinline__ int lds_byte(int r, int c) { const int st = (r >> 4) * 2 + (c >> 5), rr = r & 15, cc = c & 31, ob = rr * 64 + cc * 2; return st * 1024 + (ob ^ (((ob >> 9) & 1) << 5)); }
__host__ __device__ __forceinline__ void stage_rc(int b, int& R, int& C) { const int st = b / 1024, sb = b % 1024, swz = sb ^ (((sb >> 9) & 1) << 5); R = (st >> 1) * 16 + swz / 64; C = (st & 1) * 32 + (swz % 64) / 2; }
__host__ __device__ __forceinline__ int perm32(int rho) { const int n = rho >> 4, i = rho & 15; return 8 * (i >> 2) + 4 * n + (i & 3); }

struct Unit { int pm, pn; };
struct Gemm { const bf16_t* A; const bf16_t* Bt; int M, N, K; unsigned sw = 0x7f7f7f7fu, sa = 0x7f7f7f7fu; };
typedef int i32x4 __attribute__((ext_vector_type(4)));
typedef int i32x8 __attribute__((ext_vector_type(8)));
__device__ __forceinline__ i32x8 cat_frag(bf16x8 lo, bf16x8 hi) { return __builtin_shufflevector(__builtin_bit_cast(i32x4, lo), __builtin_bit_cast(i32x4, hi), 0, 1, 2, 3, 4, 5, 6, 7); }

struct StaticOrder {
    int nM, nN, nwg, G, c;
    __host__ __device__ void init(int M, int N, int G_, int c_) { nM = M / BM; nN = N / BM; nwg = nM * nN; G = G_; c = c_; }
    __host__ __device__ bool next(int i, Unit& u) const {
        const long L = (long)i * G + c; if (L >= nwg) return false;
        int wgid = (int)L; { const int q = nwg / NXCD, r = nwg % NXCD, xcd = wgid % NXCD, off = wgid / NXCD; wgid = (xcd < r ? xcd * (q + 1) : r * (q + 1) + (xcd - r) * q) + off; }
        const int nig = WGM * nN, gid = wgid / nig, fm = gid * WGM, gsz = (nM - fm) < WGM ? (nM - fm) : WGM;
        u.pm = fm + ((wgid % nig) % gsz); u.pn = (wgid % nig) / gsz; return true;
    }
    __device__ __forceinline__ void a_ready(const Unit&) const {}
    __device__ __forceinline__ void done(const Unit&) const {}
};
__device__ __forceinline__ unsigned cvt_pk_bf16(float lo, float hi) { typedef float f2_ __attribute__((ext_vector_type(2))); typedef __bf16 b2_ __attribute__((ext_vector_type(2))); const f2_ v = {lo, hi}; return __builtin_bit_cast(unsigned, __builtin_convertvector(v, b2_)); }
typedef float f32x2 __attribute__((ext_vector_type(2)));
__device__ __forceinline__ unsigned pk_h2(float lo, float hi) { return (unsigned)__builtin_bit_cast(unsigned short, (_Float16)lo) | ((unsigned)__builtin_bit_cast(unsigned short, (_Float16)hi) << 16); }
__device__ __forceinline__ float fsig(float x) { return __builtin_amdgcn_rcpf(1.0f + __builtin_amdgcn_exp2f(-1.4426950408889634f * x)); }
__device__ __forceinline__ float fsilu(float x) { return x * fsig(x); }
struct EpiInProj {
    static constexpr bool PERM = true, AFTER_DRAIN = false;
    bf16_t* proj; const float* lbl; const float* sa; const float* cmax;
    __device__ __forceinline__ void operator()(const f32x4 (&acc)[2][2][4][2], const Unit& u, int wr, int wc, int fr, int fq) const {
        const int row0 = u.pm * BM + wr * 64 + fr, t = u.pn >> 2, col0 = u.pn * BM + wc * 32 + 8 * fq;
        bf16_t* base = proj + (size_t)row0 * 8192 + col0;
        float rs[2][4];
#pragma unroll
        for (int ai = 0; ai < 2; ++ai)
#pragma unroll
            for (int m = 0; m < 4; ++m) rs[ai][m] = sa[row0 + ai * HALF + m * 16];
        if (t == 2 || t == 3) {
#pragma unroll
            for (int bj = 0; bj < 2; ++bj) {
                float lb[8], cs[8];
                { const float* l0 = lbl + (t - 2) * 2048 + (col0 & 1023) + bj * HALF;
                  const f32x4 a0 = *(const f32x4*)(l0), a1 = *(const f32x4*)(l0 + 4), b0 = *(const f32x4*)(l0 + 1024), b1 = *(const f32x4*)(l0 + 1028);
                  const f32x4 c0 = *(const f32x4*)(cmax + col0 + bj * HALF), c1 = *(const f32x4*)(cmax + col0 + bj * HALF + 4);
#pragma unroll
                  for (int j = 0; j < 4; ++j) { lb[j] = fsig(a0[j] - b0[j]); lb[4 + j] = fsig(a1[j] - b1[j]); cs[j] = c0[j] * (1.0f / 127.0f); cs[4 + j] = c1[j] * (1.0f / 127.0f); } }
#pragma unroll
                for (int ai = 0; ai < 2; ++ai)
#pragma unroll
                    for (int m = 0; m < 4; ++m) { float y[8];
#pragma unroll
                        for (int j = 0; j < 8; ++j) { const float a = acc[ai][bj][m][j >> 2][j & 3] * rs[ai][m] * cs[j]; const float f = lb[j] + (1.0f - lb[j]) * fsig(a); y[j] = __builtin_amdgcn_logf(f); }
                        u32x4 w; w.x = pk_h2(y[0], y[1]); w.y = pk_h2(y[2], y[3]); w.z = pk_h2(y[4], y[5]); w.w = pk_h2(y[6], y[7]);
                        *(u32x4*)(base + (size_t)(ai * HALF + m * 16) * 8192 + bj * HALF) = w; }
            }
        } else {
            const float sc = (t == 5) ? 0.18033688011112042f * (1.0f / 127.0f) : (1.0f / 127.0f);
            const bool act = (t == 0 || t == 4);
#pragma unroll
            for (int bj = 0; bj < 2; ++bj) {
                float cs[8];
                { const f32x4 c0 = *(const f32x4*)(cmax + col0 + bj * HALF), c1 = *(const f32x4*)(cmax + col0 + bj * HALF + 4);
#pragma unroll
                  for (int j = 0; j < 4; ++j) { cs[j] = c0[j] * sc; cs[4 + j] = c1[j] * sc; } }
                if (act) {
#pragma unroll
                    for (int ai = 0; ai < 2; ++ai)
#pragma unroll
                        for (int m = 0; m < 4; ++m) { float y[8];
#pragma unroll
                            for (int j = 0; j < 8; ++j) y[j] = fsilu(acc[ai][bj][m][j >> 2][j & 3] * rs[ai][m] * cs[j]);
                            u32x4 w; w.x = cvt_pk_bf16(y[0], y[1]); w.y = cvt_pk_bf16(y[2], y[3]); w.z = cvt_pk_bf16(y[4], y[5]); w.w = cvt_pk_bf16(y[6], y[7]);
                            *(u32x4*)(base + (size_t)(ai * HALF + m * 16) * 8192 + bj * HALF) = w; }
                } else {
#pragma unroll
                    for (int ai = 0; ai < 2; ++ai)
#pragma unroll
                        for (int m = 0; m < 4; ++m) { float y[8];
#pragma unroll
                            for (int j = 0; j < 8; ++j) y[j] = acc[ai][bj][m][j >> 2][j & 3] * rs[ai][m] * cs[j];
                            u32x4 w; w.x = cvt_pk_bf16(y[0], y[1]); w.y = cvt_pk_bf16(y[2], y[3]); w.z = cvt_pk_bf16(y[4], y[5]); w.w = cvt_pk_bf16(y[6], y[7]);
                            *(u32x4*)(base + (size_t)(ai * HALF + m * 16) * 8192 + bj * HALF) = w; }
                }
            }
        }
    }
};
struct EpiOutProj {
    static constexpr bool PERM = true, AFTER_DRAIN = false;
    const float* x; bf16_t* h1b;
    __device__ __forceinline__ void operator()(const f32x4 (&acc)[2][2][4][2], const Unit& u, int wr, int wc, int fr, int fq) const {
        const int row0 = u.pm * BM + wr * 64 + fr, col0 = u.pn * BM + wc * 32 + 8 * fq;
#pragma unroll
        for (int ai = 0; ai < 2; ++ai) {
            f32x4 xv[4][2][2];
#pragma unroll
            for (int m = 0; m < 4; ++m)
#pragma unroll
                for (int bj = 0; bj < 2; ++bj) { const float* p = x + (size_t)(row0 + ai * HALF + m * 16) * 2048 + col0 + bj * HALF; xv[m][bj][0] = __builtin_nontemporal_load((const f32x4*)p); xv[m][bj][1] = __builtin_nontemporal_load((const f32x4*)(p + 4)); }
#pragma unroll
            for (int m = 0; m < 4; ++m) { const int row = row0 + ai * HALF + m * 16; const size_t off = (size_t)row * 2048 + col0;
#pragma unroll
                for (int bj = 0; bj < 2; ++bj) { const f32x4 h0 = xv[m][bj][0] + acc[ai][bj][m][0], h1 = xv[m][bj][1] + acc[ai][bj][m][1];
                    u32x4 w; w.x = cvt_pk_bf16(h0[0], h0[1]); w.y = cvt_pk_bf16(h0[2], h0[3]); w.z = cvt_pk_bf16(h1[0], h1[1]); w.w = cvt_pk_bf16(h1[2], h1[3]); *(u32x4*)(h1b + off + bj * HALF) = w; } }
        }
    }
};
constexpr float HID_SCALE = 4.0f;
struct EpiSwiGLU8 {
    static constexpr bool PERM = true, AFTER_DRAIN = false;
    unsigned char* hid; const PG8_LAS float* rtab; int pm_tab; const float* rsg; const float* cmax;
    __device__ __forceinline__ void operator()(const f32x4 (&acc)[2][2][4][2], const Unit& u, int wr, int wc, int fr, int fq) const {
        const int rt0 = wr * 64 + fr, col0 = u.pn * HALF + wc * 32 + 8 * fq;
        float sg[8], su[8];
        { const float* c0 = cmax + u.pn * BM + wc * 32 + 8 * fq; const f32x4 g0 = *(const f32x4*)c0, g1 = *(const f32x4*)(c0 + 4), u0 = *(const f32x4*)(c0 + HALF), u1 = *(const f32x4*)(c0 + HALF + 4);
#pragma unroll
          for (int j = 0; j < 4; ++j) { sg[j] = g0[j] * (1.0f / 127.0f); sg[4 + j] = g1[j] * (1.0f / 127.0f); su[j] = u0[j] * (HID_SCALE / 127.0f); su[4 + j] = u1[j] * (HID_SCALE / 127.0f); } }
#pragma unroll
        for (int ai = 0; ai < 2; ++ai)
#pragma unroll
            for (int m = 0; m < 4; ++m) { const int rt = rt0 + ai * HALF + m * 16;
                const float r = (u.pm == pm_tab) ? rtab[rt] : rsg[u.pm * BM + rt];
                float y[8];
#pragma unroll
                for (int j = 0; j < 8; ++j) { const float g = acc[ai][0][m][j >> 2][j & 3] * r * sg[j], up = acc[ai][1][m][j >> 2][j & 3] * r * su[j]; y[j] = fsilu(g) * up; }
                uint2 w; int t = 0;
                t = __builtin_amdgcn_cvt_pk_fp8_f32(y[0], y[1], t, false); t = __builtin_amdgcn_cvt_pk_fp8_f32(y[2], y[3], t, true); w.x = (unsigned)t;
                t = __builtin_amdgcn_cvt_pk_fp8_f32(y[4], y[5], t, false); t = __builtin_amdgcn_cvt_pk_fp8_f32(y[6], y[7], t, true); w.y = (unsigned)t;
                *(uint2*)(hid + (size_t)(u.pm * BM + rt) * 5632 + col0) = w; }
    }
};
struct EpiDown {
    static constexpr bool PERM = true, AFTER_DRAIN = false;
    bf16_t* hb;
    __device__ __forceinline__ void operator()(const f32x4 (&acc)[2][2][4][2], const Unit& u, int wr, int wc, int fr, int fq) const {
        unsigned off0 = (unsigned)((u.pm * BM + wr * 64 + fr) * 2048 + u.pn * BM + wc * 32 + 8 * fq);
#pragma unroll
        for (int ai = 0; ai < 2; ++ai)
#pragma unroll
            for (int mp = 0; mp < 2; ++mp) {
                unsigned ob = off0 + (unsigned)((ai * HALF + mp * 32) * 2048); asm volatile("" : "+v"(ob));
                u32x4 hv[2][2];
#pragma unroll
                for (int m2 = 0; m2 < 2; ++m2)
#pragma unroll
                    for (int bj = 0; bj < 2; ++bj) hv[m2][bj] = __builtin_nontemporal_load((const u32x4*)(hb + (ob + m2 * 16 * 2048 + bj * HALF)));
#pragma unroll
                for (int m2 = 0; m2 < 2; ++m2) { const int m = 2 * mp + m2;
#pragma unroll
                    for (int bj = 0; bj < 2; ++bj) { const u32x4 h = hv[m2][bj]; const f32x4 a0 = acc[ai][bj][m][0], a1 = acc[ai][bj][m][1]; u32x4 w;
                        w.x = cvt_pk_bf16(__uint_as_float(h.x << 16) + a0[0], __uint_as_float(h.x & 0xffff0000u) + a0[1]); w.y = cvt_pk_bf16(__uint_as_float(h.y << 16) + a0[2], __uint_as_float(h.y & 0xffff0000u) + a0[3]);
                        w.z = cvt_pk_bf16(__uint_as_float(h.z << 16) + a1[0], __uint_as_float(h.z & 0xffff0000u) + a1[1]); w.w = cvt_pk_bf16(__uint_as_float(h.w << 16) + a1[2], __uint_as_float(h.w & 0xffff0000u) + a1[3]);
                        *(u32x4*)(hb + (ob + m2 * 16 * 2048 + bj * HALF)) = w; } }
            }
    }
};

template <class Epi, class Sched, bool ALIGN_EPI = false, bool SP2 = false, int MODE = 0>
__device__ __forceinline__ void gemm_phase(PG8_LAS unsigned char* lds, const Gemm g, const Sched& S, const Epi& E) {
    const int tid = threadIdx.x, wid = __builtin_amdgcn_readfirstlane(tid >> 6), lane = tid & 63, wr = wid >> 2, wc = wid & 3, fr = lane & 15, fq = lane >> 4;
    const int K = g.K, nt = K / BK;
    unsigned voffA[2], voffB[2];
#pragma unroll
    for (int i = 0; i < 2; ++i) { int R, C; stage_rc(tid * 16 + i * 8192, R, C); const int Rb = Epi::PERM ? ((R & ~31) + perm32(R & 31)) : R;
        voffA[i] = (unsigned)(R * K + C) * 2u; voffB[i] = (unsigned)(Rb * K + C) * 2u; }
    const size_t kstep = (size_t)(BK * 2);
    const size_t hstep = (size_t)HALF * K * 2;
    const size_t tstep = 2 * hstep;
    const unsigned ldsw = (unsigned)wid * 1024u;
    const int aoff = lds_byte(wr * 64 + fr, fq * 8), boff = lds_byte(wc * 32 + fr, fq * 8);
#define PG8_SA(b, h) (((b) * 2 + (h)) * HTB)
#define PG8_SB(b, h) ((4 + (b) * 2 + (h)) * HTB)
#define PG8_STAGE(bufoff, gbase, voff) do { _Pragma("unroll") for (int _i = 0; _i < 2; ++_i) \
        __builtin_amdgcn_global_load_lds((const unsigned*)((const char*)(gbase) + (voff)[_i]), (PG8_LAS unsigned*)(lds + (bufoff) + ldsw + _i * 8192), 16, 0, 0); } while (0)
#define PG8_LDA(dst, b, h) do { _Pragma("unroll") for (int m = 0; m < 4; ++m) _Pragma("unroll") for (int k = 0; k < 2; ++k) dst[m][k] = *(const PG8_LAS bf16x8*)(lds + PG8_SA(b, h) + aoff + m * 2048 + k * 1024); } while (0)
#define PG8_LDB(dst, b, h) do { _Pragma("unroll") for (int n = 0; n < 2; ++n) _Pragma("unroll") for (int k = 0; k < 2; ++k) dst[n][k] = *(const PG8_LAS bf16x8*)(lds + PG8_SB(b, h) + boff + n * 2048 + k * 1024); } while (0)
#define PG8_MMA(ai, bj, At, Bt) do { __builtin_amdgcn_s_setprio(1); _Pragma("unroll") for (int m = 0; m < 4; ++m) _Pragma("unroll") for (int n = 0; n < 2; ++n) { \
        if constexpr (MODE == 1) { const i32x8 b8_ = cat_frag(Bt[n][0], Bt[n][1]), a8_ = cat_frag(At[m][0], At[m][1]); \
            asm volatile("v_mfma_scale_f32_16x16x128_f8f6f4 %0, %1, %2, %0, %3, %4 op_sel_hi:[0,0,0]" : "+v"(acc[ai][bj][m][n]) : "v"(b8_), "v"(a8_), "v"(g.sw), "v"(g.sa)); } \
        else if constexpr (MODE == 2) { _Pragma("unroll") for (int k = 0; k < 2; ++k) acc[ai][bj][m][n] = __builtin_bit_cast(f32x4, __builtin_amdgcn_mfma_i32_16x16x64_i8(__builtin_bit_cast(i32x4, Bt[n][k]), __builtin_bit_cast(i32x4, At[m][k]), __builtin_bit_cast(i32x4, acc[ai][bj][m][n]), 0, 0, 0)); } \
        else { _Pragma("unroll") for (int k = 0; k < 2; ++k) acc[ai][bj][m][n] = __builtin_amdgcn_mfma_f32_16x16x32_bf16(Bt[n][k], At[m][k], acc[ai][bj][m][n], 0, 0, 0); } } \
        __builtin_amdgcn_s_setprio(0); } while (0)
#define PG8_WAIT_V(n) asm volatile("s_waitcnt vmcnt(" #n ")" ::: "memory")
#define PG8_WAIT_L(n) asm volatile("s_waitcnt lgkmcnt(" #n ")" ::: "memory")
#define PG8_BAR __builtin_amdgcn_s_barrier()
#define PG8_SCHED __builtin_amdgcn_sched_barrier(0)
    Unit cur, nxt; int ui = 0;
    if (!S.next(0, cur)) return;
    f32x4 acc[2][2][4][2];
#pragma unroll
    for (int a = 0; a < 2; ++a)
#pragma unroll
        for (int b = 0; b < 2; ++b)
#pragma unroll
            for (int m = 0; m < 4; ++m)
#pragma unroll
                for (int n = 0; n < 2; ++n) acc[a][b][m][n] = (f32x4){0.f, 0.f, 0.f, 0.f};
    bf16x8 At[4][2], B0[2][2], B1[2][2];
    const char* cA = (const char*)g.A + (size_t)cur.pm * tstep; const char* cB = (const char*)g.Bt + (size_t)cur.pn * tstep;
    S.a_ready(cur);
    if constexpr (SP2) {
        PG8_STAGE(PG8_SB(0, 0), cB, voffB); PG8_STAGE(PG8_SB(0, 1), cB + hstep, voffB); PG8_STAGE(PG8_SA(0, 0), cA, voffA); PG8_STAGE(PG8_SA(0, 1), cA + hstep, voffA);
        if (wr == 1) PG8_BAR;
        PG8_WAIT_V(2); PG8_BAR;
        PG8_STAGE(PG8_SB(1, 0), cB + kstep, voffB); PG8_STAGE(PG8_SA(1, 0), cA + kstep, voffA); PG8_STAGE(PG8_SB(1, 1), cB + hstep + kstep, voffB);
        PG8_WAIT_V(6); PG8_BAR;
    } else {
        PG8_STAGE(PG8_SB(0, 0), cB, voffB); PG8_STAGE(PG8_SA(0, 0), cA, voffA); PG8_STAGE(PG8_SB(0, 1), cB + hstep, voffB); PG8_STAGE(PG8_SA(0, 1), cA + hstep, voffA);
        if (wr == 1) PG8_BAR;
        PG8_WAIT_V(4); PG8_BAR;
        PG8_STAGE(PG8_SB(1, 0), cB + kstep, voffB); PG8_STAGE(PG8_SA(1, 0), cA + kstep, voffA); PG8_STAGE(PG8_SB(1, 1), cB + hstep + kstep, voffB);
        PG8_WAIT_V(6); PG8_BAR;
    }
    for (;;) {
        const bool has_next = S.next(ui + 1, nxt);
        const char* nA = has_next ? (const char*)g.A + (size_t)nxt.pm * tstep : cA; const char* nB = has_next ? (const char*)g.Bt + (size_t)nxt.pn * tstep : cB;
        for (int t = 0; t < nt; t += 2) {
            const bool last = (t == nt - 2);
            const char* a1 = cA + (size_t)(t + 1) * kstep;
            const char* a2 = last ? nA : cA + (size_t)(t + 2) * kstep; const char* b2 = last ? nB : cB + (size_t)(t + 2) * kstep;
            const char* a3 = a2 + kstep; const char* b3 = b2 + kstep;
            if (last && has_next) S.a_ready(nxt);
            if constexpr (SP2) {
            PG8_LDB(B0, 0, 0); PG8_LDB(B1, 0, 1); PG8_SCHED; PG8_LDA(At, 0, 0); PG8_STAGE(PG8_SA(1, 1), a1 + hstep, voffA);
            PG8_WAIT_V(8); PG8_WAIT_L(0); PG8_BAR; PG8_MMA(0, 0, At, B0); PG8_MMA(0, 1, At, B1); PG8_BAR; PG8_SCHED;
            PG8_LDA(At, 0, 1); PG8_STAGE(PG8_SB(0, 0), b2, voffB); PG8_STAGE(PG8_SB(0, 1), b2 + hstep, voffB); PG8_STAGE(PG8_SA(0, 0), a2, voffA);
            PG8_WAIT_V(8); PG8_WAIT_L(0); PG8_BAR; PG8_MMA(1, 0, At, B0); PG8_MMA(1, 1, At, B1); PG8_BAR; PG8_SCHED;
            PG8_LDB(B0, 1, 0); PG8_LDB(B1, 1, 1); PG8_SCHED; PG8_LDA(At, 1, 0); PG8_STAGE(PG8_SA(0, 1), a2 + hstep, voffA);
            PG8_WAIT_V(8); PG8_WAIT_L(0); PG8_BAR; PG8_MMA(0, 0, At, B0); PG8_MMA(0, 1, At, B1); PG8_BAR; PG8_SCHED;
            PG8_LDA(At, 1, 1); PG8_STAGE(PG8_SB(1, 0), b3, voffB); PG8_STAGE(PG8_SB(1, 1), b3 + hstep, voffB); PG8_STAGE(PG8_SA(1, 0), a3, voffA);
            PG8_WAIT_V(8); PG8_WAIT_L(0); PG8_BAR; PG8_MMA(1, 0, At, B0); PG8_MMA(1, 1, At, B1); PG8_BAR; PG8_SCHED;
            } else {
            PG8_LDB(B0, 0, 0); PG8_SCHED; PG8_LDA(At, 0, 0); PG8_STAGE(PG8_SA(1, 1), a1 + hstep, voffA);
            PG8_WAIT_L(8); PG8_BAR; PG8_WAIT_L(0); PG8_MMA(0, 0, At, B0); PG8_BAR; PG8_SCHED;
            PG8_LDB(B1, 0, 1); PG8_STAGE(PG8_SB(0, 0), b2, voffB);
            PG8_BAR; PG8_WAIT_L(0); PG8_MMA(0, 1, At, B1); PG8_BAR;
            PG8_LDA(At, 0, 1); PG8_STAGE(PG8_SA(0, 0), a2, voffA);
            PG8_BAR; PG8_WAIT_L(0); PG8_MMA(1, 0, At, B0); PG8_BAR; PG8_SCHED;
            PG8_STAGE(PG8_SB(0, 1), b2 + hstep, voffB);
            PG8_WAIT_V(6); PG8_BAR; PG8_MMA(1, 1, At, B1); PG8_BAR;
            PG8_LDB(B0, 1, 0); PG8_SCHED; PG8_LDA(At, 1, 0); PG8_STAGE(PG8_SA(0, 1), a2 + hstep, voffA);
            PG8_WAIT_L(8); PG8_BAR; PG8_WAIT_L(0); PG8_MMA(0, 0, At, B0); PG8_BAR; PG8_SCHED;
            PG8_LDB(B1, 1, 1); PG8_STAGE(PG8_SB(1, 0), b3, voffB);
            PG8_BAR; PG8_WAIT_L(0); PG8_MMA(0, 1, At, B1); PG8_BAR;
            PG8_LDA(At, 1, 1); PG8_STAGE(PG8_SA(1, 0), a3, voffA);
            PG8_BAR; PG8_WAIT_L(0); PG8_MMA(1, 0, At, B0); PG8_BAR; PG8_SCHED;
            PG8_STAGE(PG8_SB(1, 1), b3 + hstep, voffB);
            PG8_WAIT_V(6); PG8_BAR; PG8_MMA(1, 1, At, B1); PG8_BAR;
            }
        }
        if constexpr (MODE == 1) asm volatile("s_nop 15\n\ts_nop 15" ::: "memory");
        if constexpr (ALIGN_EPI) { if (wr == 0) PG8_BAR; }
        if constexpr (MODE == 2) {
#pragma unroll
            for (int a = 0; a < 2; ++a)
#pragma unroll
                for (int b = 0; b < 2; ++b)
#pragma unroll
                    for (int m = 0; m < 4; ++m)
#pragma unroll
                        for (int n = 0; n < 2; ++n) acc[a][b][m][n] = __builtin_convertvector(__builtin_bit_cast(i32x4, acc[a][b][m][n]), f32x4);
        }
        if constexpr (!Epi::AFTER_DRAIN) { E(acc, cur, wr, wc, fr, fq); S.done(cur); }
        if (!has_next) break;
#pragma unroll
        for (int a = 0; a < 2; ++a)
#pragma unroll
            for (int b = 0; b < 2; ++b)
#pragma unroll
                for (int m = 0; m < 4; ++m)
#pragma unroll
                    for (int n = 0; n < 2; ++n) acc[a][b][m][n] = (f32x4){0.f, 0.f, 0.f, 0.f};
        cur = nxt; cA = nA; cB = nB; ++ui;
        if constexpr (ALIGN_EPI) { if (wr == 1) PG8_BAR; }
    }
    PG8_WAIT_V(0);
    if constexpr (!ALIGN_EPI) { if (wr == 0) PG8_BAR; }
    PG8_BAR;
    if constexpr (Epi::AFTER_DRAIN) { E.fused(acc, cur, wr, wc, fr, fq, lds, wid, lane); S.done(cur); }
#undef PG8_SA
#undef PG8_SB
#undef PG8_STAGE
#undef PG8_LDA
#undef PG8_LDB
#undef PG8_MMA
#undef PG8_WAIT_V
#undef PG8_WAIT_L
#undef PG8_BAR
#undef PG8_SCHED
}
}

#ifndef PG8_SP2
#define PG8_SP2 true
#endif
#ifndef PG8_ALIGN
#define PG8_ALIGN true
#endif
constexpr int RING_OFF = 0, RING_BYTES = 131072;
constexpr int LDS_BYTES = 163840;
constexpr int LDSCTL_OFF = LDS_BYTES - 2048, MISC_OFF = LDSCTL_OFF + 320;
constexpr int RTAB_OFF = LDSCTL_OFF + 1024;
constexpr int NWAVES = 8;
constexpr int CW_BAR = 4096;

#define GAS __attribute__((address_space(1)))
#define LAS __attribute__((address_space(3)))
typedef unsigned v4u __attribute__((ext_vector_type(4)));
typedef float f32x4 __attribute__((ext_vector_type(4)));
typedef GAS unsigned gu32;
#define LDS_WAIT() asm volatile("s_waitcnt lgkmcnt(0)" ::: "memory")
#define VM_WAIT() asm volatile("s_waitcnt vmcnt(0)" ::: "memory")
__device__ __forceinline__ unsigned f2bf_u(float f) { unsigned u = __builtin_bit_cast(unsigned, f); return (u + 0x7fffu + ((u >> 16) & 1u)) >> 16; }
__device__ __forceinline__ unsigned pk2(float lo, float hi) { return f2bf_u(lo) | (f2bf_u(hi) << 16); }
__device__ __forceinline__ float wave_sum(float v) {
#pragma unroll
    for (int o = 1; o < 64; o <<= 1) v += __shfl_xor(v, o);
    return v;
}
__device__ __forceinline__ float wave_max(float v) {
#pragma unroll
    for (int o = 1; o < 64; o <<= 1) v = fmaxf(v, __shfl_xor(v, o));
    return v;
}
__device__ __forceinline__ unsigned pack4_i8(float a, float b, float c, float d, float inv) {
    const unsigned t0 = __float_as_uint(__builtin_fmaf(a, inv, 12582912.0f)), t1 = __float_as_uint(__builtin_fmaf(b, inv, 12582912.0f)),
                   t2 = __float_as_uint(__builtin_fmaf(c, inv, 12582912.0f)), t3 = __float_as_uint(__builtin_fmaf(d, inv, 12582912.0f));
    const unsigned lo = __builtin_amdgcn_perm(t1, t0, 0x0c0c0400u), hi = __builtin_amdgcn_perm(t3, t2, 0x0c0c0400u);
    return __builtin_amdgcn_perm(hi, lo, 0x05040100u);
}
__device__ __forceinline__ float inv127(float amax) { return 127.0f / fmaxf(amax, 1e-30f); }

#define XB_TMO      128
#define XB_XCNT(j)  (256  + 64 * (j))
#define XB_XSUB(j)  (1280 + 64 * (j))
#define XB_XGEN(j)  (2304 + 64 * (j))
#define XB_TOP      3328
#define XB_TOPGEN   3392
#define XCD_BAR_WORDS 3456
#define XB_SPIN_CAP (1u << 18)

__device__ __forceinline__ unsigned xb_ld(unsigned* p)              { return __hip_atomic_load(p, __ATOMIC_RELAXED, __HIP_MEMORY_SCOPE_AGENT); }
__device__ __forceinline__ unsigned xb_add(unsigned* p, unsigned v) { return __hip_atomic_fetch_add(p, v, __ATOMIC_RELAXED, __HIP_MEMORY_SCOPE_AGENT); }
__device__ __forceinline__ unsigned xb_xcc_id() { return (unsigned)__builtin_amdgcn_s_getreg((3 << 11) | 20) & 0xFu; }
#define XB_SPIN(cond, bar) do { unsigned _sp = 0; while (cond) { __builtin_amdgcn_s_sleep(1); \
    if ((++_sp & 255u) == 0u) { if (xb_ld(&(bar)[XB_TMO])) break; if (_sp > XB_SPIN_CAP) { atomicAdd(&(bar)[XB_TMO], 1u); break; } } } } while (0)

struct XcdBarrier {
    unsigned* bar; unsigned x;
    volatile LAS unsigned* st;
};

__device__ __forceinline__ XcdBarrier xcd_barrier_post(unsigned* bar, volatile LAS unsigned* st) {
    XcdBarrier b; b.bar = bar; b.x = xb_xcc_id(); b.st = st;
    if (threadIdx.x == 0) (void)xb_add(&bar[XB_XCNT(b.x)], 1u);
    return b;
}
__device__ __forceinline__ void xcd_barrier_complete(unsigned* bar, unsigned x, unsigned& nloc, unsigned& nx) {
    const unsigned G = gridDim.x * gridDim.y * gridDim.z;
    unsigned sum, cnt, mine, sp = 0u;
    for (;;) {
        sum = 0u; cnt = 0u; mine = 0u;
#pragma unroll
        for (unsigned j = 0; j < 16; ++j) { const unsigned c = xb_ld(&bar[XB_XCNT(j)]); sum += c; cnt += (c > 0u) ? 1u : 0u; mine = (j == x) ? c : mine; }
        if (sum == G) break;
        __builtin_amdgcn_s_sleep(1);
        if ((++sp & 255u) == 0u) { if (xb_ld(&bar[XB_TMO])) break; if (sp > XB_SPIN_CAP) { atomicAdd(&bar[XB_TMO], 1u); break; } }
    }
    nloc = mine > 0u ? mine : 1u; nx = cnt > 0u ? cnt : 1u;
}

__device__ __forceinline__ void xcd_barrier(const XcdBarrier& b) {
    asm volatile("s_waitcnt vmcnt(0)" ::: "memory");
    __syncthreads();
    if (threadIdx.x == 0) {
        unsigned* bar = b.bar;
        __builtin_amdgcn_s_waitcnt(0);
        unsigned nloc = b.st[0], nx = b.st[1];
        if (nloc == 0u) { xcd_barrier_complete(bar, b.x, nloc, nx); b.st[0] = nloc; b.st[1] = nx; }
        const unsigned old = xb_add(&bar[XB_XSUB(b.x)], 1u);
        const unsigned gen = old / nloc;
        if (old + 1u == (gen + 1u) * nloc) {
            __builtin_amdgcn_fence(__ATOMIC_RELEASE, "agent");
            asm volatile("s_waitcnt vmcnt(0)" ::: "memory");
            const unsigned og = xb_add(&bar[XB_TOP], 1u);
            const unsigned tg = og / nx;
            if (og + 1u == (tg + 1u) * nx) xb_add(&bar[XB_TOPGEN], 1u);
            else XB_SPIN(xb_ld(&bar[XB_TOPGEN]) == tg, bar);
            __builtin_amdgcn_fence(__ATOMIC_ACQUIRE, "agent");
            xb_add(&bar[XB_XGEN(b.x)], 1u);
            asm volatile("s_waitcnt vmcnt(0)" ::: "memory");
        } else {
            XB_SPIN(xb_ld(&bar[XB_XGEN(b.x)]) == gen, bar);
            __builtin_amdgcn_fence(__ATOMIC_ACQUIRE, "agent");
            asm volatile("s_waitcnt vmcnt(0)" ::: "memory");
        }
    }
    __syncthreads();
}

namespace bg {
typedef float f32x4 __attribute__((ext_vector_type(4)));
typedef unsigned u32x4 __attribute__((ext_vector_type(4)));
constexpr int I_O = (DM / 32) * (DM / 64), I_G = 0  , I_D = (DFF / 32) * (DM / 64), NBG = I_O + 2 * I_G + I_D;
struct Ptrs { const float* w_out; const float* w_gate; const float* w_up; const float* w_down; const float* norm2_w; u16* WoT; u16* WguT; u16* WdT; const float* cmax_gu; };
constexpr float WD_SCALE = 256.0f;
struct Dec { const float* W; u16* WT; const float* ksc; int K, N, k0, n0, drow0, f8; };
__device__ __forceinline__ Dec decode(const Ptrs& P, int q) {
    Dec d;
    if (q < I_O) { d.f8 = 0; d.W = P.w_out; d.WT = P.WoT; d.ksc = nullptr; d.K = DM; d.N = DM; d.k0 = 32 * (q / (DM / 64)); d.n0 = 64 * (q % (DM / 64)); d.drow0 = d.n0; return d; }
    q -= I_O;
    if (q < 2 * I_G) { const int up = q >= I_G ? 1 : 0; if (up) q -= I_G; d.f8 = 2; d.W = up ? P.w_up : P.w_gate; d.WT = P.WguT; d.ksc = P.norm2_w; d.K = DM; d.N = DFF;
        d.k0 = 32 * (q / (DFF / 64)); d.n0 = 64 * (q % (DFF / 64)); d.drow0 = 256 * (d.n0 >> 7) + 128 * up + (d.n0 & 127); return d; }
    q -= 2 * I_G;
    d.f8 = 1; d.W = P.w_down; d.WT = P.WdT; d.ksc = nullptr; d.K = DFF; d.N = DM; d.k0 = 32 * (q / (DM / 64)); d.n0 = 64 * (q % (DM / 64)); d.drow0 = d.n0; return d;
}
__device__ __forceinline__ void load(const Ptrs& P, int q, int lane, f32x4 (&v)[8]) {
    const Dec d = decode(P, q); const int kg = lane >> 4, n4 = (lane & 15) * 4;
    const float* src = d.W + (size_t)(d.k0 + 8 * kg) * d.N + d.n0 + n4;
#pragma unroll
    for (int i = 0; i < 8; ++i) v[i] = __builtin_nontemporal_load((const f32x4*)(src + (size_t)i * d.N));
}
__device__ __forceinline__ void store(const Ptrs& P, int q, int lane, f32x4 (&v)[8]) {
    const Dec d = decode(P, q); const int kg = lane >> 4, n4 = (lane & 15) * 4;
    if (d.ksc) { const f32x4 s0 = *(const f32x4*)(d.ksc + d.k0 + 8 * kg), s1 = *(const f32x4*)(d.ksc + d.k0 + 8 * kg + 4);
#pragma unroll
        for (int i = 0; i < 4; ++i) { v[i] = v[i] * s0[i]; v[4 + i] = v[4 + i] * s1[i]; } }
    if (d.f8 == 2) {
        const f32x4 cm = *(const f32x4*)(P.cmax_gu + d.drow0 + n4);
#pragma unroll
        for (int jn = 0; jn < 4; ++jn) { const float inv = inv127(cm[jn]); uint2 o; o.x = pack4_i8(v[0][jn], v[1][jn], v[2][jn], v[3][jn], inv); o.y = pack4_i8(v[4][jn], v[5][jn], v[6][jn], v[7][jn], inv);
            *(uint2*)((unsigned char*)d.WT + (size_t)(d.drow0 + n4 + jn) * d.K + d.k0 + 8 * kg) = o; }
        return; }
    if (d.f8) {
#pragma unroll
        for (int jn = 0; jn < 4; ++jn) { uint2 o; int t = 0;
            t = __builtin_amdgcn_cvt_pk_fp8_f32(v[0][jn] * WD_SCALE, v[1][jn] * WD_SCALE, t, false); t = __builtin_amdgcn_cvt_pk_fp8_f32(v[2][jn] * WD_SCALE, v[3][jn] * WD_SCALE, t, true); o.x = (unsigned)t;
            t = __builtin_amdgcn_cvt_pk_fp8_f32(v[4][jn] * WD_SCALE, v[5][jn] * WD_SCALE, t, false); t = __builtin_amdgcn_cvt_pk_fp8_f32(v[6][jn] * WD_SCALE, v[7][jn] * WD_SCALE, t, true); o.y = (unsigned)t;
            *(uint2*)((unsigned char*)d.WT + (size_t)(d.drow0 + n4 + jn) * d.K + d.k0 + 8 * kg) = o; }
        return; }
#pragma unroll
    for (int jn = 0; jn < 4; ++jn) { u32x4 o; o.x = pk2(v[0][jn], v[1][jn]); o.y = pk2(v[2][jn], v[3][jn]); o.z = pk2(v[4][jn], v[5][jn]); o.w = pk2(v[6][jn], v[7][jn]);
        *(u32x4*)(d.WT + (size_t)(d.drow0 + n4 + jn) * d.K + d.k0 + 8 * kg) = o; }
}
}

namespace hg {
typedef short bf16x8 __attribute__((ext_vector_type(8)));
typedef short s16x4 __attribute__((ext_vector_type(4)));
typedef short v4i16_t __attribute__((ext_vector_type(4)));
typedef float f32x16 __attribute__((ext_vector_type(16)));
typedef float f32x4 __attribute__((ext_vector_type(4)));
typedef float f32x2 __attribute__((ext_vector_type(2)));
typedef unsigned u32x4 __attribute__((ext_vector_type(4)));
typedef unsigned u32x2 __attribute__((ext_vector_type(2)));
#define HG_LAS __attribute__((address_space(3)))
constexpr int SET = 58368, O_QS = 0, O_KS = 16384, O_KD = 32768, O_V = 49152, O_EM = 57344, O_DL = 57856;
constexpr int L_TOT = 2 * SET, L_SLAB = L_TOT + 2048, L_END = L_SLAB + 16384;
__device__ __forceinline__ unsigned cvtpk(float lo, float hi) { typedef float f2_ __attribute__((ext_vector_type(2))); typedef __bf16 b2_ __attribute__((ext_vector_type(2))); const f2_ v = {lo, hi}; return __builtin_bit_cast(unsigned, __builtin_convertvector(v, b2_)); }
__device__ __forceinline__ float bf_lo(unsigned u) { return __uint_as_float(u << 16); }
__device__ __forceinline__ float bf_hi(unsigned u) { return __uint_as_float(u & 0xffff0000u); }
__device__ __forceinline__ float h_lo(unsigned u) { return (float)__builtin_bit_cast(_Float16, (unsigned short)(u & 0xffffu)); }
__device__ __forceinline__ float h_hi(unsigned u) { return (float)__builtin_bit_cast(_Float16, (unsigned short)(u >> 16)); }
__device__ __forceinline__ s16x4 vtr(const HG_LAS unsigned char* p) { return __builtin_bit_cast(s16x4, __builtin_amdgcn_ds_read_tr16_b64_v4i16((HG_LAS v4i16_t*)p)); }
__device__ __forceinline__ bf16x8 pk8(const f32x16& x, int b) {
    u32x4 w; w.x = cvtpk(x[b], x[b + 1]); w.y = cvtpk(x[b + 2], x[b + 3]); w.z = cvtpk(x[b + 4], x[b + 5]); w.w = cvtpk(x[b + 6], x[b + 7]); return __builtin_bit_cast(bf16x8, w); }
__device__ __forceinline__ bf16x8 cat8(s16x4 lo, s16x4 hi) { return (bf16x8){lo[0], lo[1], lo[2], lo[3], hi[0], hi[1], hi[2], hi[3]}; }
__device__ __forceinline__ bf16x8 perm_frag(const HG_LAS unsigned char* mat, int row, int ch, int hi) {
    const HG_LAS unsigned char* p = mat + row * 256 + 8 * hi;
    const u32x2 lo = *(const HG_LAS u32x2*)(p + ((ch ^ (row & 15)) << 4)), hh = *(const HG_LAS u32x2*)(p + (((ch + 1) ^ (row & 15)) << 4));
    return __builtin_bit_cast(bf16x8, (u32x4){lo.x, lo.y, hh.x, hh.y});
}

__device__ __forceinline__ void hgrn_item(HG_LAS unsigned char* lds, const u16* __restrict__ PROJ, u16* __restrict__ ODIR, int item, int tid, const bg::Ptrs& BP, int& bgj, int gcw, int NCW) {
    const int lane = tid & 63, w = __builtin_amdgcn_readfirstlane(tid >> 6), hi = lane >> 5, c32 = lane & 31;
    const int vh = item & 1, dir = (item >> 1) & 1, h = (item >> 2) & 7, b = item >> 5;
    const bool prod = w < 4; const int pw = w & 3;
    const size_t rowbase = (size_t)b * SEQ;
    const int cq = h * 128 + 2 * lane, cf = 2048 + dir * 1024 + h * 128 + 2 * lane;
    const int pt = pw * 64 + lane, vs = pt >> 2, vc = (pt & 3) * 2, cv = 1024 + h * 128 + vh * 64 + vc * 8;
    const int jb = pw & 1, kh = pw >> 1;
    const int trb = (4 * hi + ((lane & 15) >> 2)) * 64 + ((lane >> 4) & 1) * 32 + (lane & 3) * 8;
    f32x16 R0, R1, R2, R3; bg::f32x4 bgv[4], bgx[8];
#pragma unroll
    for (int r = 0; r < 16; ++r) { R0[r] = 0.f; R1[r] = 0.f; }
#define S0 R0
#define S1 R1
#define oown R2
#define ooth R3
#define FU(x) __float_as_uint(x)
#define UF(x) __uint_as_float(x)
#define HG_TOK(c, i) (dir ? (SEQ - 1 - (64 * (c) + (i))) : (64 * (c) + (i)))
    const unsigned rb8 = (unsigned)(rowbase * 8192);
#define HG_LOAD(c) do { _Pragma("unroll") for (int r = 0; r < 16; ++r) { const unsigned ro = rb8 + (unsigned)HG_TOK(c, 16 * pw + r) * 8192u; R0[r] = *(const float*)(PROJ + (ro + cq)); R1[r] = *(const float*)(PROJ + (ro + cf)); } \
        { const unsigned vo_ = rb8 + (unsigned)HG_TOK(c, vs) * 8192u + cv; bgv[2] = *(const bg::f32x4*)(PROJ + vo_); bgv[3] = *(const bg::f32x4*)(PROJ + (vo_ + 8)); } } while (0)
    if (prod) HG_LOAD(0);
    HG_LAS float* tot = (HG_LAS float*)(lds + L_TOT);
    constexpr int NC = SEQ / 64;
    if (prod) {
        for (int c = 0; c <= NC + 1; ++c) {
            HG_LAS unsigned char* ps = lds + (c & 1) * SET;
            const int bgq = bgj * NCW + gcw; const bool bgdo = c < NC && bgq < bg::NBG && ((((c + 1) * 8) >> 5) != ((c * 8) >> 5));
            if (c < NC) {
                R2 = R0; R3 = R1; bgv[0] = bgv[2]; bgv[1] = bgv[3];
                if (c + 1 < NC) { int lq = lane; asm volatile("" : "+v"(lq));
                    const int cq = h * 128 + 2 * lq, cf = 2048 + dir * 1024 + h * 128 + 2 * lq, pt = pw * 64 + lq, vs = pt >> 2, cv = 1024 + h * 128 + vh * 64 + (pt & 3) * 16;
                    HG_LOAD(c + 1); }
                float a0 = 0.f, a1 = 0.f;
#pragma unroll
                for (int r = 0; r < 16; ++r) { a0 += h_lo(FU(R3[r])); a1 += h_hi(FU(R3[r])); }
                *(HG_LAS f32x2*)(tot + pw * 128 + 2 * lane) = (f32x2){a0, a1};
                if (bgdo) bg::load(BP, bgq, lane, bgx);
            }
            __syncthreads();
            if (c < NC) {
                float p0 = 0.f, p1 = 0.f, m0 = 0.f, m1 = 0.f, t0 = 0.f, t1 = 0.f;
#pragma unroll
                for (int ww = 0; ww < 4; ++ww) { const f32x2 x = *(const HG_LAS f32x2*)(tot + ww * 128 + 2 * lane);
                    if (ww < pw) { p0 += x.x; p1 += x.y; } if (ww < 2) { m0 += x.x; m1 += x.y; } t0 += x.x; t1 += x.y; }
                const float El0 = __builtin_amdgcn_exp2f(t0 - m0), El1 = __builtin_amdgcn_exp2f(t1 - m1);
                if (pw == 0) { *(HG_LAS f32x2*)(ps + O_EM + 8 * lane) = (f32x2){__builtin_amdgcn_exp2f(m0), __builtin_amdgcn_exp2f(m1)};
                               *(HG_LAS f32x2*)(ps + O_DL + 8 * lane) = (f32x2){__builtin_amdgcn_exp2f(t0), __builtin_amdgcn_exp2f(t1)}; }
                const float x0 = __builtin_fminf(__builtin_fmaxf(p0 - m0, -56.f), 56.f), x1 = __builtin_fminf(__builtin_fmaxf(p1 - m1, -56.f), 56.f);
                float e0 = __builtin_amdgcn_exp2f(x0), e1 = __builtin_amdgcn_exp2f(x1), g0 = __builtin_amdgcn_exp2f(-x0), g1 = __builtin_amdgcn_exp2f(-x1);
                int lno = lane; asm volatile("" : "+v"(lno));
#pragma unroll
                for (int r = 0; r < 16; ++r) {
                    const int i = 16 * pw + r;
                    const float lf0 = h_lo(FU(R3[r])), lf1 = h_hi(FU(R3[r]));
                    const float f0 = __builtin_amdgcn_exp2f(lf0), f1 = __builtin_amdgcn_exp2f(lf1), fi0 = __builtin_amdgcn_exp2f(-lf0), fi1 = __builtin_amdgcn_exp2f(-lf1);
                    e0 *= f0; e1 *= f1; g0 *= fi0; g1 *= fi1;
                    const float qs0 = bf_lo(FU(R2[r])) * e0, qs1 = bf_hi(FU(R2[r])) * e1, ks0 = (1.0f - f0) * g0, ks1 = (1.0f - f1) * g1;
                    const int sw = i * 256 + ((((lno >> 2) ^ (i & 15))) << 4) + (lno & 3) * 4;
                    *(HG_LAS unsigned*)(ps + O_QS + sw) = cvtpk(qs0, qs1);
                    *(HG_LAS unsigned*)(ps + O_KS + sw) = cvtpk(ks0, ks1);
                    *(HG_LAS unsigned*)(ps + O_KD + (((lno >> 4) * 4 + (i >> 4)) * 1024) + (i & 15) * 64 + (lno & 15) * 4) = cvtpk(ks0 * El0, ks1 * El1);
                }
                { const int pt = pw * 64 + lno, vs = pt >> 2, vc = (pt & 3) * 2;
                  HG_LAS unsigned char* vd = ps + O_V + (((vc >> 2) * 4 + (vs >> 4)) * 1024) + (vs & 15) * 64 + (vc & 3) * 16;
                  *(HG_LAS bg::f32x4*)vd = bgv[0]; *(HG_LAS bg::f32x4*)(vd + 16) = bgv[1]; }
                if (bgdo) { bg::store(BP, bgq, lane, bgx); ++bgj; }
            }
            __syncthreads();
        }
    } else {
        for (int c = 0; c <= NC + 1; ++c) {
            const HG_LAS unsigned char* cs = lds + ((c + 1) & 1) * SET;
            int lnc = lane; asm volatile("" : "+v"(lnc));
            const int hi = lnc >> 5, c32 = lnc & 31, trb = (4 * hi + ((lnc & 15) >> 2)) * 64 + ((lnc >> 4) & 1) * 32 + (lnc & 3) * 8;
            if (c >= 2) {
            const HG_LAS float* slab = (const HG_LAS float*)(lds + L_SLAB) + (jb * 2 + (kh ^ 1)) * 1024 + lnc;
            const unsigned oo = (unsigned)(((size_t)dir * M + rowbase) * 1024) + h * 128 + vh * 64 + jb * 32 + c32;
#pragma unroll
            for (int r = 0; r < 16; ++r) { const int i = kh * 32 + (r & 3) + 8 * (r >> 2) + 4 * hi; const float v = oown[r] + slab[r * 64];
                ODIR[oo + (unsigned)HG_TOK(c - 2, i) * 1024u] = (u16)(cvtpk(v, v) & 0xffffu); }
            }
            __syncthreads();
            if (c >= 1 && c <= NC) {
#pragma unroll
            for (int r = 0; r < 16; ++r) { oown[r] = 0.f; ooth[r] = 0.f; }
            const int rown = kh * 32 + c32, roth = (1 - kh) * 32 + c32, c32o = c32, trbo = trb;
#define HG_SB() __builtin_amdgcn_sched_barrier(0)
            bf16x8 qa[2][2][2], sbf[2][2];
            { f32x4 em[2][4];
#pragma unroll
              for (int t2 = 0; t2 < 2; ++t2) {
#pragma unroll
                for (int g = 0; g < 4; ++g) em[t2][g] = *(const HG_LAS f32x4*)(cs + O_EM + ((2 * kh + t2) * 32 + 8 * g + 4 * hi) * 4);
#pragma unroll
                for (int sp = 0; sp < 2; ++sp) { const int ch = (2 * kh + t2) * 4 + 2 * sp; qa[t2][sp][0] = perm_frag(cs + O_QS, rown, ch, hi); qa[t2][sp][1] = perm_frag(cs + O_QS, roth, ch, hi); } }
              HG_SB();
#pragma unroll
              for (int t2 = 0; t2 < 2; ++t2) { f32x16 Sx = t2 ? S1 : S0;
#pragma unroll
                for (int g = 0; g < 4; ++g) { Sx[4 * g] *= em[t2][g][0]; Sx[4 * g + 1] *= em[t2][g][1]; Sx[4 * g + 2] *= em[t2][g][2]; Sx[4 * g + 3] *= em[t2][g][3]; }
                sbf[t2][0] = pk8(Sx, 0); sbf[t2][1] = pk8(Sx, 8); } }
            HG_SB();
            bf16x8 dk[8], dq[8];
            const HG_LAS unsigned char* dksp = cs + O_KS + rown * 256; const HG_LAS unsigned char* dqsp = cs + O_QS + rown * 256;
#pragma unroll
            for (int st = 0; st < 4; ++st) { const int ch = 2 * st + hi; dk[st] = *(const HG_LAS bf16x8*)(dksp + ((ch ^ (rown & 15)) << 4)); dq[st] = *(const HG_LAS bf16x8*)(dqsp + ((ch ^ (rown & 15)) << 4)); }
            HG_SB();
#pragma unroll
            for (int t2 = 0; t2 < 2; ++t2)
#pragma unroll
                for (int sp = 0; sp < 2; ++sp) {
                    oown = __builtin_amdgcn_mfma_f32_32x32x16_bf16(qa[t2][sp][0], sbf[t2][sp], oown, 0, 0, 0);
                    ooth = __builtin_amdgcn_mfma_f32_32x32x16_bf16(qa[t2][sp][1], sbf[t2][sp], ooth, 0, 0, 0); }
            HG_SB();
#pragma unroll
            for (int st = 4; st < 8; ++st) { const int ch = 2 * st + hi; dk[st] = *(const HG_LAS bf16x8*)(dksp + ((ch ^ (rown & 15)) << 4)); dq[st] = *(const HG_LAS bf16x8*)(dqsp + ((ch ^ (rown & 15)) << 4)); }
            HG_SB();
            f32x16 X;
#pragma unroll
            for (int r = 0; r < 16; ++r) X[r] = 0.f;
#pragma unroll
            for (int st = 0; st < 4; ++st) X = __builtin_amdgcn_mfma_f32_32x32x16_bf16(dk[st], dq[st], X, 0, 0, 0);
            HG_SB();
            bf16x8 vf[4], ok[4], oq[4];
#pragma unroll
            for (int ks = 0; ks < 4; ++ks) { const HG_LAS unsigned char* vp = cs + O_V + (jb * 4 + ks) * 1024 + trbo; vf[ks] = cat8(vtr(vp), vtr(vp + 512)); }
            { const int rs = c32o, ri = 32 + c32o; const HG_LAS unsigned char* ksp = cs + O_KS + rs * 256; const HG_LAS unsigned char* qsp = cs + O_QS + ri * 256;
#pragma unroll
              for (int st = 0; st < 4; ++st) { const int ch = 2 * (4 * kh + st) + hi; ok[st] = *(const HG_LAS bf16x8*)(ksp + ((ch ^ (rs & 15)) << 4)); oq[st] = *(const HG_LAS bf16x8*)(qsp + ((ch ^ (ri & 15)) << 4)); } }
            HG_SB();
#pragma unroll
            for (int st = 4; st < 8; ++st) X = __builtin_amdgcn_mfma_f32_32x32x16_bf16(dk[st], dq[st], X, 0, 0, 0);
#pragma unroll
            for (int r = 0; r < 16; ++r) { const int sl = (r & 3) + 8 * (r >> 2) + 4 * hi; X[r] = (sl <= c32) ? X[r] : 0.f; }
            if (kh) { oown = __builtin_amdgcn_mfma_f32_32x32x16_bf16(pk8(X, 0), vf[2], oown, 0, 0, 0); oown = __builtin_amdgcn_mfma_f32_32x32x16_bf16(pk8(X, 8), vf[3], oown, 0, 0, 0); }
            else    { oown = __builtin_amdgcn_mfma_f32_32x32x16_bf16(pk8(X, 0), vf[0], oown, 0, 0, 0); oown = __builtin_amdgcn_mfma_f32_32x32x16_bf16(pk8(X, 8), vf[1], oown, 0, 0, 0); }
            HG_SB();
            f32x4 dl0[4]; bf16x8 kd0[4];
#pragma unroll
            for (int g = 0; g < 4; ++g) dl0[g] = *(const HG_LAS f32x4*)(cs + O_DL + ((2 * kh) * 32 + 8 * g + 4 * hi) * 4);
#pragma unroll
            for (int ks = 0; ks < 4; ++ks) { const HG_LAS unsigned char* kp = cs + O_KD + ((2 * kh) * 4 + ks) * 1024 + trbo; kd0[ks] = cat8(vtr(kp), vtr(kp + 512)); }
            HG_SB();
#pragma unroll
            for (int r = 0; r < 16; ++r) X[r] = 0.f;
#pragma unroll
            for (int st = 0; st < 4; ++st) X = __builtin_amdgcn_mfma_f32_32x32x16_bf16(ok[st], oq[st], X, 0, 0, 0);
            if (kh) { oown = __builtin_amdgcn_mfma_f32_32x32x16_bf16(pk8(X, 0), vf[0], oown, 0, 0, 0); oown = __builtin_amdgcn_mfma_f32_32x32x16_bf16(pk8(X, 8), vf[1], oown, 0, 0, 0); }
            else    { ooth = __builtin_amdgcn_mfma_f32_32x32x16_bf16(pk8(X, 0), vf[0], ooth, 0, 0, 0); ooth = __builtin_amdgcn_mfma_f32_32x32x16_bf16(pk8(X, 8), vf[1], ooth, 0, 0, 0); }
            HG_SB();
            f32x4 dl1[4]; bf16x8 kd1[4];
#pragma unroll
            for (int g = 0; g < 4; ++g) dl1[g] = *(const HG_LAS f32x4*)(cs + O_DL + ((2 * kh + 1) * 32 + 8 * g + 4 * hi) * 4);
#pragma unroll
            for (int ks = 0; ks < 4; ++ks) { const HG_LAS unsigned char* kp = cs + O_KD + ((2 * kh + 1) * 4 + ks) * 1024 + trbo; kd1[ks] = cat8(vtr(kp), vtr(kp + 512)); }
            HG_SB();
#pragma unroll
            for (int g = 0; g < 4; ++g) { S0[4 * g] *= dl0[g][0]; S0[4 * g + 1] *= dl0[g][1]; S0[4 * g + 2] *= dl0[g][2]; S0[4 * g + 3] *= dl0[g][3]; }
#pragma unroll
            for (int ks = 0; ks < 4; ++ks) S0 = __builtin_amdgcn_mfma_f32_32x32x16_bf16(kd0[ks], vf[ks], S0, 0, 0, 0);
#pragma unroll
            for (int g = 0; g < 4; ++g) { S1[4 * g] *= dl1[g][0]; S1[4 * g + 1] *= dl1[g][1]; S1[4 * g + 2] *= dl1[g][2]; S1[4 * g + 3] *= dl1[g][3]; }
#pragma unroll
            for (int ks = 0; ks < 4; ++ks) S1 = __builtin_amdgcn_mfma_f32_32x32x16_bf16(kd1[ks], vf[ks], S1, 0, 0, 0);
#undef HG_SB
            { HG_LAS float* slab = (HG_LAS float*)(lds + L_SLAB) + (jb * 2 + kh) * 1024 + lnc;
#pragma unroll
              for (int r = 0; r < 16; ++r) slab[r * 64] = ooth[r]; }
            }
            __syncthreads();
        }
    }
#undef HG_TOK
#undef HG_LOAD
#undef S0
#undef S1
#undef oown
#undef ooth
#undef FU
#undef UF
}
}

namespace at {
typedef short bf16x8 __attribute__((ext_vector_type(8)));
typedef short s16x4 __attribute__((ext_vector_type(4)));
typedef short v4i16_t __attribute__((ext_vector_type(4)));
typedef float f32x16 __attribute__((ext_vector_type(16)));
typedef float f32x4 __attribute__((ext_vector_type(4)));
typedef unsigned u32x4 __attribute__((ext_vector_type(4)));
#define AT_LAS __attribute__((address_space(3)))
constexpr int L_K = 0, L_V = 16384, L_WS = 65536, L_LUT = 66560, L_END = 67584;
constexpr float THR = 8.0f;
__device__ __forceinline__ unsigned cvtpk(float lo, float hi) { typedef float f2_ __attribute__((ext_vector_type(2))); typedef __bf16 b2_ __attribute__((ext_vector_type(2))); const f2_ v = {lo, hi}; return __builtin_bit_cast(unsigned, __builtin_convertvector(v, b2_)); }
__device__ __forceinline__ s16x4 vtr(const AT_LAS unsigned char* p) { return __builtin_bit_cast(s16x4, __builtin_amdgcn_ds_read_tr16_b64_v4i16((AT_LAS v4i16_t*)p)); }
__device__ __forceinline__ bf16x8 pk8(const f32x16& x, int b) {
    u32x4 w; w.x = cvtpk(x[b], x[b + 1]); w.y = cvtpk(x[b + 2], x[b + 3]); w.z = cvtpk(x[b + 4], x[b + 5]); w.w = cvtpk(x[b + 6], x[b + 7]); return __builtin_bit_cast(bf16x8, w); }
__device__ __forceinline__ bf16x8 cat8(s16x4 lo, s16x4 hi) { return (bf16x8){lo[0], lo[1], lo[2], lo[3], hi[0], hi[1], hi[2], hi[3]}; }
__device__ __forceinline__ float max3f(float a, float b, float c) { float r; asm("v_max3_f32 %0, %1, %2, %3" : "=v"(r) : "v"(a), "v"(b), "v"(c)); return r; }
__device__ __forceinline__ int rel_bucket(int rel) {
    const int n = rel < 0 ? -rel : rel; int bk;
    if (n < 8) bk = n; else if (n < 12) bk = 8; else if (n < 16) bk = 9; else if (n < 23) bk = 10; else if (n < 32) bk = 11;
    else if (n < 46) bk = 12; else if (n < 64) bk = 13; else if (n < 91) bk = 14; else bk = 15;
    return bk + (rel > 0 ? 16 : 0);
}

__device__ __forceinline__ void attn_unit(AT_LAS unsigned char* lds, const u16* __restrict__ PROJ, const float* __restrict__ relb, float* O1, u16* __restrict__ CAT, const float* __restrict__ subw,
                                          float lam, int b, int h, int qb, int mp, int tid, float kmax2) {
    const int lane = tid & 63, w = __builtin_amdgcn_readfirstlane(tid >> 6), hi = lane >> 5, c32 = lane & 31;
    const size_t rowbase = (size_t)b * SEQ;
    const int q0w = qb * 256 + w * 32;
    AT_LAS float* wsf = (AT_LAS float*)(lds + L_WS) + w * 32;
    AT_LAS float* lut = (AT_LAS float*)(lds + L_LUT);
    if (tid < 183) lut[tid] = relb[rel_bucket(tid - 91) * 8 + h] * 1.4426950408889634f;
    const float bias_neg = relb[15 * 8 + h] * 1.4426950408889634f, bias_pos = relb[31 * 8 + h] * 1.4426950408889634f;
    bf16x8 qf[4];
    { const unsigned qo = (unsigned)((rowbase + q0w + c32) * 8192 + 5120 + h * 128 + mp * 64 + 8 * hi);
#pragma unroll
      for (int st = 0; st < 4; ++st) qf[st] = *(const bf16x8*)(PROJ + (qo + 16 * st)); }
    bool nomax;
    { float q2 = 0.f;
#pragma unroll
      for (int st = 0; st < 4; ++st)
#pragma unroll
          for (int e = 0; e < 8; ++e) { const float a = __uint_as_float((unsigned)(unsigned short)qf[st][e] << 16); q2 += a * a; }
      { const auto rr = __builtin_amdgcn_permlane32_swap(__float_as_uint(q2), __float_as_uint(q2), false, false); q2 = __uint_as_float(rr[0]) + __uint_as_float(rr[1]); }
      float bm = fmaxf(fabsf(relb[(lane & 31) * 8 + h]) * 1.4426950408889634f, 0.f);
#pragma unroll
      for (int o_ = 1; o_ < 64; o_ <<= 1) { q2 = fmaxf(q2, __shfl_xor(q2, o_)); bm = fmaxf(bm, __shfl_xor(bm, o_)); }
      const float B = __builtin_sqrtf(q2 * kmax2) + bm;
      nomax = __builtin_amdgcn_readfirstlane((B <= 60.0f) ? 1 : 0) != 0; }
    f32x16 o[4];
#pragma unroll
    for (int d = 0; d < 4; ++d)
#pragma unroll
        for (int r = 0; r < 16; ++r) o[d][r] = 0.f;
    float mhat = 0.f, l = 0.f;
    const int krow = 8 * w + (lane >> 3), kch = (lane & 7) ^ ((krow >> 1) & 7);
    const unsigned kgo = (unsigned)((rowbase + krow) * 8192 + 6144 + h * 128 + mp * 64 + 8 * kch);
    const int vrow = ((2 * w) & 3) * 16 + (lane >> 2);
    const unsigned vgo = (unsigned)((rowbase + vrow) * 8192 + 7168 + h * 128 + (w >> 1) * 32 + (lane & 3) * 8);
    const int trb = (4 * hi + ((lane & 15) >> 2)) * 64 + ((lane >> 4) & 1) * 32 + (lane & 3) * 8;
#define AT_STAGE(t_, ks_, vs_) do { const unsigned go_ = (unsigned)(t_) * 64u * 8192u; \
        __builtin_amdgcn_global_load_lds((const unsigned*)(PROJ + (kgo + go_)), (AT_LAS unsigned*)(lds + L_K + (ks_) * 8192 + w * 1024), 16, 0, 0); \
        __builtin_amdgcn_global_load_lds((const unsigned*)(PROJ + (vgo + go_)), (AT_LAS unsigned*)(lds + L_V + (vs_) * 16384 + (2 * w) * 1024), 16, 0, 0); \
        __builtin_amdgcn_global_load_lds((const unsigned*)(PROJ + (vgo + go_ + 16u * 8192u)), (AT_LAS unsigned*)(lds + L_V + (vs_) * 16384 + (2 * w + 1) * 1024), 16, 0, 0); } while (0)
    AT_STAGE(0, 0, 0);
    asm volatile("s_waitcnt vmcnt(0)" ::: "memory");
    __syncthreads();
    constexpr int NT = SEQ / 64;
    const bool late = w >= 4;
    bf16x8 pa0, pa1, pa2, pa3, va_[4], vb_[4]; f32x16 p0, p1;
#define AT_VF(dst, VB, d) do { const AT_LAS unsigned char* vp_ = (VB) + (d) * 4096 + trb; \
        _Pragma("unroll") for (int k_ = 0; k_ < 4; ++k_) dst[k_] = cat8(vtr(vp_ + k_ * 1024), vtr(vp_ + k_ * 1024 + 512)); } while (0)
#define AT_MM(d, vf) do { o[d] = __builtin_amdgcn_mfma_f32_32x32x16_bf16(pa0, vf[0], o[d], 0, 0, 0); o[d] = __builtin_amdgcn_mfma_f32_32x32x16_bf16(pa1, vf[1], o[d], 0, 0, 0); \
        o[d] = __builtin_amdgcn_mfma_f32_32x32x16_bf16(pa2, vf[2], o[d], 0, 0, 0); o[d] = __builtin_amdgcn_mfma_f32_32x32x16_bf16(pa3, vf[3], o[d], 0, 0, 0); } while (0)
#define AT_SB() __builtin_amdgcn_sched_barrier(0)
#define AT_VPRE(VB) do { AT_SB(); AT_VF(va_, VB, 0); AT_VF(vb_, VB, 1); AT_SB(); } while (0)
#define AT_PV(VB) do { AT_SB(); AT_MM(0, va_); AT_SB(); AT_VF(va_, VB, 2); AT_SB(); AT_MM(1, vb_); AT_SB(); AT_VF(vb_, VB, 3); AT_SB(); AT_MM(2, va_); AT_SB(); AT_MM(3, vb_); AT_SB(); } while (0)
#define AT_QK(tt) do { const AT_LAS unsigned char* Kb = lds + L_K + ((tt) & 1) * 8192; \
        const int kv0_ = 64 * (tt), far_ = (kv0_ - (q0w + 31) >= 91) ? 1 : ((kv0_ + 63 - q0w <= -91) ? -1 : 0); \
        const float ini = (far_ > 0 ? bias_pos : (far_ < 0 ? bias_neg : 0.f)) - mhat; \
        _Pragma("unroll") for (int r = 0; r < 16; ++r) { p0[r] = ini; p1[r] = ini; } \
        const int r0 = c32, r1 = 32 + c32; bf16x8 ka[4], kb[4]; \
        _Pragma("unroll") for (int st = 0; st < 4; ++st) { const int ch = 2 * st + hi; \
            ka[st] = *(const AT_LAS bf16x8*)(Kb + r0 * 128 + ((ch ^ ((r0 >> 1) & 7)) << 4)); kb[st] = *(const AT_LAS bf16x8*)(Kb + r1 * 128 + ((ch ^ ((r1 >> 1) & 7)) << 4)); } \
        _Pragma("unroll") for (int st = 0; st < 4; ++st) { p0 = __builtin_amdgcn_mfma_f32_32x32x16_bf16(ka[st], qf[st], p0, 0, 0, 0); p1 = __builtin_amdgcn_mfma_f32_32x32x16_bf16(kb[st], qf[st], p1, 0, 0, 0); } } while (0)
#define AT_SM(tt) do { const int kv0_ = 64 * (tt); const bool band_ = !(kv0_ - (q0w + 31) >= 91) && !(kv0_ + 63 - q0w <= -91); \
        if (band_) { const int rb = kv0_ + 4 * hi - (q0w + c32) + 91; \
            _Pragma("unroll") for (int r = 0; r < 16; ++r) { const int i0 = rb + (r & 3) + 8 * (r >> 2), i1 = i0 + 32; \
                p0[r] += lut[i0 < 0 ? 0 : (i0 > 182 ? 182 : i0)]; p1[r] += lut[i1 < 0 ? 0 : (i1 > 182 ? 182 : i1)]; } } \
        float rm, rm2;                                             \
        rm = max3f(p0[0], p0[1], p1[0]); rm2 = max3f(p0[2], p0[3], p1[1]); rm = max3f(rm, p1[2], p1[3]); \
        _Pragma("unroll") for (int r = 4; r < 16; r += 4) { rm = max3f(rm, p0[r], p0[r + 1]); rm2 = max3f(rm2, p0[r + 2], p0[r + 3]); rm = max3f(rm, p1[r], p1[r + 1]); rm2 = max3f(rm2, p1[r + 2], p1[r + 3]); } \
        rm = __builtin_fmaxf(rm, rm2); \
        { const auto rr = __builtin_amdgcn_permlane32_swap(__float_as_uint(rm), __float_as_uint(rm), false, false); rm = __builtin_fmaxf(__uint_as_float(rr[0]), __uint_as_float(rr[1])); } \
        if ((tt) == 0 || __any(rm > THR)) { \
            const float dl = ((tt) == 0) ? rm : __builtin_fmaxf(rm, 0.f); \
            mhat += dl; \
            _Pragma("unroll") for (int r = 0; r < 16; ++r) { p0[r] -= dl; p1[r] -= dl; } \
            if ((tt) > 0) { const float f = __builtin_amdgcn_exp2f(-dl); l *= f; \
                if (hi == 0) wsf[c32] = f; \
                asm volatile("s_waitcnt lgkmcnt(0)" ::: "memory"); \
                _Pragma("unroll") for (int g = 0; g < 4; ++g) { const f32x4 fv = *(const AT_LAS f32x4*)(wsf + 8 * g + 4 * hi); \
                    _Pragma("unroll") for (int d = 0; d < 4; ++d) { o[d][4 * g] *= fv[0]; o[d][4 * g + 1] *= fv[1]; o[d][4 * g + 2] *= fv[2]; o[d][4 * g + 3] *= fv[3]; } } } } \
        float ls = 0.f; \
        _Pragma("unroll") for (int r = 0; r < 16; ++r) { p0[r] = __builtin_amdgcn_exp2f(p0[r]); p1[r] = __builtin_amdgcn_exp2f(p1[r]); ls += p0[r] + p1[r]; } \
        l += ls; \
        pa0 = pk8(p0, 0); pa1 = pk8(p0, 8); pa2 = pk8(p1, 0); pa3 = pk8(p1, 8); } while (0)
#define AT_SMF(tt) do { const int kv0_ = 64 * (tt); const bool band_ = !(kv0_ - (q0w + 31) >= 91) && !(kv0_ + 63 - q0w <= -91); \
        if (band_) { const int rb = kv0_ + 4 * hi - (q0w + c32) + 91; \
            _Pragma("unroll") for (int r = 0; r < 16; ++r) { const int i0 = rb + (r & 3) + 8 * (r >> 2), i1 = i0 + 32; \
                p0[r] += lut[i0 < 0 ? 0 : (i0 > 182 ? 182 : i0)]; p1[r] += lut[i1 < 0 ? 0 : (i1 > 182 ? 182 : i1)]; } } \
        float ls = 0.f; \
        _Pragma("unroll") for (int r = 0; r < 16; ++r) { p0[r] = __builtin_amdgcn_exp2f(p0[r]); p1[r] = __builtin_amdgcn_exp2f(p1[r]); ls += p0[r] + p1[r]; } \
        l += ls; \
        pa0 = pk8(p0, 0); pa1 = pk8(p0, 8); pa2 = pk8(p1, 0); pa3 = pk8(p1, 8); } while (0)
#define AT_END() do { vprev = vslot; vslot = (vslot == 2) ? 0 : vslot + 1; \
        asm volatile("s_waitcnt vmcnt(0)" ::: "memory");            \
        __syncthreads(); } while (0)
    int vslot = 0, vprev = 0;
    if (nomax && !late) {
        for (int t = 0; t < NT; ++t) {
            if (t + 1 < NT) { AT_STAGE(t + 1, (t + 1) & 1, (vslot == 2) ? 0 : vslot + 1); }
            AT_QK(t); AT_VPRE(lds + L_V + vslot * 16384); AT_SMF(t); AT_PV(lds + L_V + vslot * 16384);
            AT_END();
        }
    } else if (nomax) {
        for (int t = 0; t < NT; ++t) {
            if (t + 1 < NT) { AT_STAGE(t + 1, (t + 1) & 1, (vslot == 2) ? 0 : vslot + 1); }
            if (t > 0) { AT_PV(lds + L_V + vprev * 16384); }
            AT_QK(t); AT_SMF(t); AT_VPRE(lds + L_V + vslot * 16384);
            AT_END();
        }
        AT_PV(lds + L_V + vprev * 16384);
    } else if (!late) {
        for (int t = 0; t < NT; ++t) {
            if (t + 1 < NT) { AT_STAGE(t + 1, (t + 1) & 1, (vslot == 2) ? 0 : vslot + 1); }
            AT_QK(t); AT_VPRE(lds + L_V + vslot * 16384); AT_SM(t); AT_PV(lds + L_V + vslot * 16384);
            AT_END();
        }
    } else {
        for (int t = 0; t < NT; ++t) {
            if (t + 1 < NT) { AT_STAGE(t + 1, (t + 1) & 1, (vslot == 2) ? 0 : vslot + 1); }
            if (t > 0) { AT_PV(lds + L_V + vprev * 16384); }
            AT_QK(t); AT_SM(t); AT_VPRE(lds + L_V + vslot * 16384);
            AT_END();
        }
        AT_PV(lds + L_V + vprev * 16384);
    }
#undef AT_QK
#undef AT_SM
#undef AT_SMF
#undef AT_END
#undef AT_VPRE
#undef AT_PV
#undef AT_VPRE
#undef AT_VF
#undef AT_SB
#undef AT_MM
#undef AT_STAGE
    l += __shfl_xor(l, 32);
    if (hi == 0) wsf[c32] = __builtin_amdgcn_rcpf(l);
    asm volatile("s_waitcnt lgkmcnt(0)" ::: "memory");
    float rl[16];
#pragma unroll
    for (int g = 0; g < 4; ++g) { const f32x4 fv = *(const AT_LAS f32x4*)(wsf + 8 * g + 4 * hi); rl[4 * g] = fv[0]; rl[4 * g + 1] = fv[1]; rl[4 * g + 2] = fv[2]; rl[4 * g + 3] = fv[3]; }
    unsigned oo = (unsigned)((rowbase + q0w + 4 * hi) * 1024 + h * 128 + c32);
    if (mp == 0) {
#pragma unroll
        for (int r = 0; r < 16; ++r) { unsigned ro = oo + (unsigned)(((r & 3) + 8 * (r >> 2)) * 1024); asm volatile("" : "+v"(ro));
#pragma unroll
            for (int d = 0; d < 4; ++d) O1[ro + d * 32] = o[d][r] * rl[r]; }
    } else {
        float sw[4];
#pragma unroll
        for (int d = 0; d < 4; ++d) sw[d] = subw[d * 32 + c32] * 0.8f;
        const unsigned co = (unsigned)((rowbase + q0w + 4 * hi) * 2048 + 1024 + h * 128 + c32);
#pragma unroll
        for (int r = 0; r < 16; ++r) { unsigned ro = oo + (unsigned)(((r & 3) + 8 * (r >> 2)) * 1024), rc = co + (unsigned)(((r & 3) + 8 * (r >> 2)) * 2048); asm volatile("" : "+v"(ro), "+v"(rc));
            float x[4]; float ss = 0.f;
#pragma unroll
            for (int d = 0; d < 4; ++d) { x[d] = O1[ro + d * 32] - lam * (o[d][r] * rl[r]); ss += x[d] * x[d]; }
            ss += __shfl_xor(ss, 1); ss += __shfl_xor(ss, 2); ss += __shfl_xor(ss, 4); ss += __shfl_xor(ss, 8); ss += __shfl_xor(ss, 16);
            const float rr = __builtin_amdgcn_rsqf(ss * (1.0f / 128.0f) + 1e-6f);
#pragma unroll
            for (int d = 0; d < 4; ++d) CAT[rc + d * 32] = (u16)(cvtpk(x[d] * rr * sw[d], 0.f) & 0xffffu); }
    }
}
}

__device__ __forceinline__ void p0_item64(const float* W, int K, int N, const float* ksc, u16* WT, int k0, int n0, int drow0, int lane) {
    const int kg = lane >> 4, n4 = (lane & 15) * 4;
    const float* src = W + (size_t)(k0 + 8 * kg) * N + n0 + n4;
    f32x4 v[2][8];
#pragma unroll
    for (int r = 0; r < 2; ++r)
#pragma unroll
        for (int i = 0; i < 8; ++i) v[r][i] = __builtin_nontemporal_load((const f32x4*)(src + (size_t)(32 * r + i) * N));
    if (ksc) {
#pragma unroll
        for (int r = 0; r < 2; ++r) { const f32x4 s0 = *(const f32x4*)(ksc + k0 + 32 * r + 8 * kg), s1 = *(const f32x4*)(ksc + k0 + 32 * r + 8 * kg + 4);
#pragma unroll
            for (int i = 0; i < 4; ++i) { v[r][i] = v[r][i] * s0[i]; v[r][4 + i] = v[r][4 + i] * s1[i]; } }
    }
#pragma unroll
    for (int jn = 0; jn < 4; ++jn) { u16* dst = WT + (size_t)(drow0 + n4 + jn) * K + k0 + 8 * kg;
#pragma unroll
        for (int r = 0; r < 2; ++r) { v4u o; o.x = pk2(v[r][0][jn], v[r][1][jn]); o.y = pk2(v[r][2][jn], v[r][3][jn]); o.z = pk2(v[r][4][jn], v[r][5][jn]); o.w = pk2(v[r][6][jn], v[r][7][jn]);
            *(v4u*)(dst + 32 * r) = o; } }
}
__device__ __forceinline__ void p0_strip(LAS float* smax, const float* W, int N, const float* ksc, float* cmax, unsigned char* WT, int n0, int drow0, int tid) {
    const int lane = tid & 63, w = tid >> 6, g = lane & 7, kk = lane >> 3, kb = 256 * w + 32 * kk;
    const float* src = W + (size_t)kb * N + n0 + 4 * g;
    f32x4 v[32];
#pragma unroll
    for (int i = 0; i < 32; ++i) v[i] = __builtin_nontemporal_load((const f32x4*)(src + (size_t)i * N));
    if (ksc) {
#pragma unroll
        for (int i4 = 0; i4 < 8; ++i4) { const f32x4 sc = *(const f32x4*)(ksc + kb + 4 * i4);
#pragma unroll
            for (int e = 0; e < 4; ++e) v[4 * i4 + e] = v[4 * i4 + e] * sc[e]; } }
    f32x4 am = {0.f, 0.f, 0.f, 0.f};
#pragma unroll
    for (int i = 0; i < 32; ++i)
#pragma unroll
        for (int jn = 0; jn < 4; ++jn) am[jn] = fmaxf(am[jn], fabsf(v[i][jn]));
#pragma unroll
    for (int jn = 0; jn < 4; ++jn) { float a = am[jn]; a = fmaxf(a, __shfl_xor(a, 8)); a = fmaxf(a, __shfl_xor(a, 16)); a = fmaxf(a, __shfl_xor(a, 32)); am[jn] = a; }
    if (kk == 0) *(LAS f32x4*)(smax + w * 32 + 4 * g) = am;
    __syncthreads();
#pragma unroll
    for (int ww = 0; ww < 8; ++ww) { const f32x4 o = *(const LAS f32x4*)(smax + ww * 32 + 4 * g);
#pragma unroll
        for (int jn = 0; jn < 4; ++jn) am[jn] = fmaxf(am[jn], o[jn]); }
    if (w == 0 && kk == 0) *(f32x4*)(cmax + drow0 + 4 * g) = am;
#pragma unroll
    for (int jn = 0; jn < 4; ++jn) { const float inv = inv127(am[jn]); unsigned char* dst = WT + (size_t)(drow0 + 4 * g + jn) * 2048 + kb;
#pragma unroll
        for (int h = 0; h < 2; ++h) { v4u o;
            o.x = pack4_i8(v[16 * h + 0][jn], v[16 * h + 1][jn], v[16 * h + 2][jn], v[16 * h + 3][jn], inv); o.y = pack4_i8(v[16 * h + 4][jn], v[16 * h + 5][jn], v[16 * h + 6][jn], v[16 * h + 7][jn], inv);
            o.z = pack4_i8(v[16 * h + 8][jn], v[16 * h + 9][jn], v[16 * h + 10][jn], v[16 * h + 11][jn], inv); o.w = pack4_i8(v[16 * h + 12][jn], v[16 * h + 13][jn], v[16 * h + 14][jn], v[16 * h + 15][jn], inv);
            *(v4u*)(dst + 16 * h) = o; } }
}
__device__ __forceinline__ void p0_absmax64(const float* W, int N, const float* ksc, float* cmax, int k0, int n0, int drow0, int lane) {
    const int kg = lane >> 4, n4 = (lane & 15) * 4;
    const float* src = W + (size_t)(k0 + 8 * kg) * N + n0 + n4;
    f32x4 v[2][8];
#pragma unroll
    for (int r = 0; r < 2; ++r)
#pragma unroll
        for (int i = 0; i < 8; ++i) v[r][i] = *(const f32x4*)(src + (size_t)(32 * r + i) * N);
    if (ksc) {
#pragma unroll
        for (int r = 0; r < 2; ++r) { const f32x4 s0 = *(const f32x4*)(ksc + k0 + 32 * r + 8 * kg), s1 = *(const f32x4*)(ksc + k0 + 32 * r + 8 * kg + 4);
#pragma unroll
            for (int i = 0; i < 4; ++i) { v[r][i] = v[r][i] * s0[i]; v[r][4 + i] = v[r][4 + i] * s1[i]; } }
    }
#pragma unroll
    for (int jn = 0; jn < 4; ++jn) { float a = 0.f;
#pragma unroll
        for (int r = 0; r < 2; ++r)
#pragma unroll
            for (int i = 0; i < 8; ++i) a = fmaxf(a, fabsf(v[r][i][jn]));
        a = fmaxf(a, __shfl_xor(a, 16)); a = fmaxf(a, __shfl_xor(a, 32));
        if (kg == 0) atomicMax((unsigned*)(cmax + drow0 + n4 + jn), __float_as_uint(a)); }
}
__device__ __forceinline__ void p0_quant64(const float* W, int K, int N, const float* cmax, unsigned char* WT, int k0, int n0, int drow0, int lane) {
    const int kg = lane >> 4, n4 = (lane & 15) * 4;
    const float* src = W + (size_t)(k0 + 16 * kg) * N + n0 + n4;
    f32x4 v[16];
#pragma unroll
    for (int i = 0; i < 16; ++i) v[i] = __builtin_nontemporal_load((const f32x4*)(src + (size_t)i * N));
    const f32x4 cm = *(const f32x4*)(cmax + drow0 + n4);
#pragma unroll
    for (int jn = 0; jn < 4; ++jn) { const float inv = inv127(cm[jn]); v4u o;
        o.x = pack4_i8(v[0][jn], v[1][jn], v[2][jn], v[3][jn], inv); o.y = pack4_i8(v[4][jn], v[5][jn], v[6][jn], v[7][jn], inv);
        o.z = pack4_i8(v[8][jn], v[9][jn], v[10][jn], v[11][jn], inv); o.w = pack4_i8(v[12][jn], v[13][jn], v[14][jn], v[15][jn], inv);
        *(v4u*)(WT + (size_t)(drow0 + n4 + jn) * K + k0 + 16 * kg) = o; }
}
__device__ __forceinline__ void rms_row_to_bf16(const float* xrow, const float* w, u16* orow, int lane) {
    const f32x4* xr = (const f32x4*)xrow + lane;
    f32x4 v[8]; float s = 0.f;
#pragma unroll
    for (int j = 0; j < 8; ++j) { v[j] = xr[64 * j]; s += (v[j].x * v[j].x + v[j].y * v[j].y) + (v[j].z * v[j].z + v[j].w * v[j].w); }
    const float r = __builtin_amdgcn_rsqf(wave_sum(s) * (1.0f / DM) + EPS);
    const f32x4* wr = (const f32x4*)w + lane;
    uint2* o = (uint2*)orow + lane;
#pragma unroll
    for (int j = 0; j < 8; ++j) { const f32x4 ww = wr[64 * j]; uint2 p; p.x = pk2(v[j].x * r * ww.x, v[j].y * r * ww.y); p.y = pk2(v[j].z * r * ww.z, v[j].w * r * ww.w); o[64 * j] = p; }
}
__device__ __forceinline__ void rms_row_from_bf16(const u16* xrow, const float* w, float* orow, int lane) {
    const v4u* xr = (const v4u*)xrow + lane;
    v4u v[4]; float s = 0.f;
#pragma unroll
    for (int j = 0; j < 4; ++j) { v[j] = __builtin_nontemporal_load(xr + 64 * j);
#pragma unroll
        for (int e = 0; e < 4; ++e) { const float a = __uint_as_float(v[j][e] << 16), b = __uint_as_float(v[j][e] & 0xffff0000u); s += a * a + b * b; } }
    const float r = __builtin_amdgcn_rsqf(wave_sum(s) * (1.0f / DM) + EPS);
#pragma unroll
    for (int j = 0; j < 4; ++j) { const int c = (64 * j + lane) * 8; const f32x4 w0 = *(const f32x4*)(w + c), w1 = *(const f32x4*)(w + c + 4);
        f32x4 o0, o1;
        o0[0] = __uint_as_float(v[j][0] << 16) * r * w0[0]; o0[1] = __uint_as_float(v[j][0] & 0xffff0000u) * r * w0[1]; o0[2] = __uint_as_float(v[j][1] << 16) * r * w0[2]; o0[3] = __uint_as_float(v[j][1] & 0xffff0000u) * r * w0[3];
        o1[0] = __uint_as_float(v[j][2] << 16) * r * w1[0]; o1[1] = __uint_as_float(v[j][2] & 0xffff0000u) * r * w1[1]; o1[2] = __uint_as_float(v[j][3] << 16) * r * w1[2]; o1[3] = __uint_as_float(v[j][3] & 0xffff0000u) * r * w1[3];
        *(f32x4*)(orow + c) = o0; *(f32x4*)(orow + c + 4) = o1; }
}

static_assert(hg::L_END <= LDSCTL_OFF && at::L_END <= LDSCTL_OFF, "phase scratch below the LDS control words");
struct Args { const float* in[17]; float* out; unsigned char* ws; int ph_lo, ph_hi, li, pad; };
enum { PH_PRO = 0, PH_INPROJ = 1, PH_MIX = 2, PH_HGFIN = 3, PH_OUTPROJ = 4, PH_QUANT = 5, PH_GATEUP = 6, PH_DOWN = 7, PH_FINAL = 8, PH_N = 9 };

__global__ void __launch_bounds__(NWAVES * 64, 2) mk_fwd(Args args) {
    extern __shared__ __attribute__((aligned(16))) unsigned char lds_raw[];
    LAS unsigned char* lds = (LAS unsigned char*)lds_raw;
    volatile LAS unsigned* MISC = (volatile LAS unsigned*)(lds + MISC_OFF);
    const int tid = threadIdx.x, lane = tid & 63, wave = __builtin_amdgcn_readfirstlane(tid >> 6);
    const int G = gridDim.x; const int bx = blockIdx.x; const int vcu = (G % 8 == 0) ? (bx % 8) * (G / 8) + bx / 8 : bx;
    unsigned char* ws = args.ws;
    gu32* ctl = (gu32*)(ws + WS_CTL);
    float* rs2 = (float*)(ws + WS_PART); float* sa1 = (float*)(ws + WS_PART + 65536);
    float* cmax_gu = (float*)(ws + WS_CTL + CMAX_GU_OFF); float* cmax_in = (float*)(ws + WS_CTL + CMAX_IN_OFF);
    unsigned char* H1Q = ws + WS_WIN;
    u16* WinT = (u16*)(ws + WS_WIN); u16* WoT = (u16*)(ws + WS_WO); u16* WguT = (u16*)(ws + WS_WGU); u16* WdT = (u16*)(ws + WS_WD);
    u16* XN = (u16*)(ws + WS_XN); u16* BB = (u16*)(ws + WS_B); u16* PROJ = (u16*)(ws + WS_PROJ);
    for (int u = tid; u < (LDS_BYTES - LDSCTL_OFF) / 4; u += NWAVES * 64) ((LAS unsigned*)(lds + LDSCTL_OFF))[u] = 0u;
    __syncthreads();
    XcdBarrier bar = xcd_barrier_post((unsigned*)(ctl + CW_BAR) + args.li * XCD_BAR_WORDS, MISC + 8);
    const int lo = args.ph_lo, hi = args.ph_hi;
#define IN(k) (lo <= (k) && (k) < hi)
#define SEAM(k) do { if (IN(k) && (k) + 1 < hi) xcd_barrier(bar); } while (0)
    const int gw = vcu * NWAVES + wave, NGW = G * NWAVES;
    constexpr int PROBE_PH = -1, PROBE_BX = 0;
    unsigned long long pr_t0 = 0, pr_dt = 0, pr_c0 = 0;
#define PROBE_BEGIN(k) do { if (PROBE_PH == (k) && bx == PROBE_BX && tid == 0) pr_t0 = __builtin_amdgcn_s_memrealtime(); if (PROBE_PH == 100 + (k) && bx == PROBE_BX && tid == 0) pr_c0 = __builtin_amdgcn_s_memtime(); } while (0)
#define PROBE_END(k) do { if (PROBE_PH == (k) && bx == PROBE_BX && tid == 0) pr_dt = __builtin_amdgcn_s_memrealtime() - pr_t0; if (PROBE_PH == 100 + (k) && bx == PROBE_BX && tid == 0) pr_dt = (__builtin_amdgcn_s_memtime() - pr_c0) / 24; } while (0)

    PROBE_BEGIN(99);
    PROBE_BEGIN(PH_PRO);
    if (IN(PH_PRO)) {
        constexpr int NS_IN = INC / 32, NS_G = DFF / 32, NS = NS_IN + 2 * NS_G;
        { int par = 0;
          for (int st = vcu; st < NS; st += G, par ^= 1) { LAS float* smax = (LAS float*)(lds + RING_OFF) + par * 256;
              if (st < NS_IN) p0_strip(smax, args.in[2], INC, nullptr, cmax_in, (unsigned char*)WinT, 32 * st, 32 * st, tid);
              else { const int up = (st - NS_IN) >= NS_G ? 1 : 0, n0 = 32 * (st - NS_IN - up * NS_G);
                  p0_strip(smax, up ? args.in[14] : args.in[13], DFF, args.in[12], cmax_gu, (unsigned char*)WguT, n0, 256 * (n0 >> 7) + 128 * up + (n0 & 127), tid); } } }
        { int r0, cnt, rstep;
          { const int q = NS / G, rem = NS % G, B = (32 * NS + M + G - 1) / G;
            if (B - 32 * (q + 1) >= 0) { r0 = vcu * (B - 32 * q) - 32 * (vcu < rem ? vcu : rem); cnt = B - 32 * (q + (vcu < rem ? 1 : 0)); if (r0 > M) r0 = M; if (r0 + cnt > M || vcu == G - 1) cnt = M - r0; r0 += wave; rstep = NWAVES; cnt = r0 - wave + cnt; }
            else { r0 = gw; rstep = NGW; cnt = M; } }
          f32x4 wv[8];
#pragma unroll
          for (int j = 0; j < 8; ++j) wv[j] = *((const f32x4*)args.in[1] + lane + 64 * j);
          f32x4 cur[8], nxt[8];
          if (r0 < cnt) {
#pragma unroll
              for (int j = 0; j < 8; ++j) nxt[j] = __builtin_nontemporal_load((const f32x4*)(args.in[0] + (size_t)r0 * DM) + lane + 64 * j); }
          for (int m = r0; m < cnt; m += rstep) {
#pragma unroll
              for (int j = 0; j < 8; ++j) cur[j] = nxt[j];
              if (m + rstep < cnt) {
#pragma unroll
                  for (int j = 0; j < 8; ++j) nxt[j] = __builtin_nontemporal_load((const f32x4*)(args.in[0] + (size_t)(m + rstep) * DM) + lane + 64 * j); }
              float s = 0.f;
#pragma unroll
              for (int j = 0; j < 8; ++j) s += (cur[j].x * cur[j].x + cur[j].y * cur[j].y) + (cur[j].z * cur[j].z + cur[j].w * cur[j].w);
              const float r = __builtin_amdgcn_rsqf(wave_sum(s) * (1.0f / DM) + EPS);
              float am = 0.f;
#pragma unroll
              for (int j = 0; j < 8; ++j) { cur[j] = cur[j] * r * wv[j]; am = fmaxf(fmaxf(am, fmaxf(fabsf(cur[j].x), fabsf(cur[j].y))), fmaxf(fabsf(cur[j].z), fabsf(cur[j].w))); }
              am = wave_max(am); const float inv = inv127(am);
              unsigned* o = (unsigned*)((unsigned char*)XN + (size_t)m * DM) + lane;
#pragma unroll
              for (int j = 0; j < 8; ++j) o[64 * j] = pack4_i8(cur[j].x, cur[j].y, cur[j].z, cur[j].w, inv);
              if (lane == 0) sa1[m] = am * (1.0f / 127.0f); } }
    }
    SEAM(PH_PRO);
    PROBE_END(PH_PRO);
    PROBE_BEGIN(PH_INPROJ);
    if (IN(PH_INPROJ)) {
        pg8::Gemm g{XN, WinT, M, INC, DM / 2}; pg8::StaticOrder S; S.init(M, INC, G, bx);
        pg8::EpiInProj E{PROJ, args.in[3], sa1, cmax_in};
        pg8::gemm_phase<pg8::EpiInProj, pg8::StaticOrder, PG8_ALIGN, PG8_SP2, 2>(lds + RING_OFF, g, S, E);
    }
    PROBE_BEGIN(53);
    SEAM(PH_INPROJ);
    PROBE_END(53);
    PROBE_END(PH_INPROJ);
    PROBE_BEGIN(PH_MIX);
    if (IN(PH_MIX)) {
        { float* kmx = (float*)(ws + WS_CTL + KMAX2_OFF); unsigned* rdy = (unsigned*)(ws + WS_CTL + KMAX2_OFF + 1024);
          LAS float* sm = (LAS float*)(lds + RING_OFF);
          for (int blk = vcu; blk < M / 64; blk += G) { const int m0 = blk * 64 + wave * 8; float mx = 0.f;
              v4u kv[8][2];
#pragma unroll
              for (int i = 0; i < 8; ++i) { const v4u* p = (const v4u*)(PROJ + (size_t)(m0 + i) * INC + 6144 + lane * 16); kv[i][0] = p[0]; kv[i][1] = p[1]; }
#pragma unroll
              for (int i = 0; i < 8; ++i) { float ss = 0.f;
#pragma unroll
                  for (int hh = 0; hh < 2; ++hh)
#pragma unroll
                      for (int e = 0; e < 4; ++e) { const float a = __uint_as_float(kv[i][hh][e] << 16), c = __uint_as_float(kv[i][hh][e] & 0xffff0000u); ss += a * a + c * c; }
                  ss += __shfl_xor(ss, 1); ss += __shfl_xor(ss, 2); mx = fmaxf(mx, ss); }
              if ((lane & 3) == 0) sm[wave * 16 + (lane >> 2)] = mx;
              __syncthreads();
              if (tid < 16) { float a = sm[tid];
#pragma unroll
                  for (int ww = 1; ww < 8; ++ww) a = fmaxf(a, sm[ww * 16 + tid]);
                  atomicMax((unsigned*)(kmx + (blk >> 5) * 16 + tid), __float_as_uint(a)); }
              __syncthreads(); }
          if (tid == 0) { __threadfence(); atomicAdd(rdy, 1u); } }
        PROBE_BEGIN(20);
        const bg::Ptrs BP{args.in[11], args.in[13], args.in[14], args.in[15], args.in[12], WoT, WguT, WdT, cmax_gu}; int bgj = 0;
        const int gcw = vcu * 4 + (wave & 3), NCW = G * 4;
        for (int item = vcu; item < 256; item += G) { hg::hgrn_item(lds + RING_OFF, PROJ, BB, item, tid, BP, bgj, gcw, NCW); __syncthreads(); }
        if (wave < 4) for (; bgj * NCW + gcw < bg::NBG; ++bgj) { bg::f32x4 v[8]; bg::load(BP, bgj * NCW + gcw, lane, v); bg::store(BP, bgj * NCW + gcw, lane, v); }
        PROBE_END(20);
        PROBE_BEGIN(21);
        { const float lam = __expf(wave_sum(args.in[5][lane] * args.in[6][lane])) - __expf(wave_sum(args.in[7][lane] * args.in[8][lane])) + 0.2f;
          const float* kmx = (const float*)(ws + WS_CTL + KMAX2_OFF); unsigned* rdy = (unsigned*)(ws + WS_CTL + KMAX2_OFF + 1024);
          if (tid == 0) { while (__hip_atomic_load(rdy, __ATOMIC_ACQUIRE, __HIP_MEMORY_SCOPE_AGENT) < (unsigned)G) __builtin_amdgcn_s_sleep(8); }
          __syncthreads();
          for (int p = vcu; p < 512; p += G) { const int b = p >> 6, h = (p >> 3) & 7, qb = p & 7;
              const float km0 = __hip_atomic_load(kmx + b * 16 + h * 2, __ATOMIC_RELAXED, __HIP_MEMORY_SCOPE_AGENT), km1 = __hip_atomic_load(kmx + b * 16 + h * 2 + 1, __ATOMIC_RELAXED, __HIP_MEMORY_SCOPE_AGENT);
              at::attn_unit(lds + RING_OFF, PROJ, args.in[10], args.out, XN, args.in[9], lam, b, h, qb, 0, tid, km0);
              at::attn_unit(lds + RING_OFF, PROJ, args.in[10], args.out, XN, args.in[9], lam, b, h, qb, 1, tid, km1); } }
        PROBE_END(21);
    }
    PROBE_BEGIN(54);
    SEAM(PH_MIX);
    PROBE_END(54);
    PROBE_END(PH_MIX);
    PROBE_BEGIN(PH_HGFIN);
    if (IN(PH_HGFIN)) {
        const int l16 = lane & 15; f32x4 wa = *(const f32x4*)(args.in[4] + l16 * 8), wb = *(const f32x4*)(args.in[4] + l16 * 8 + 4);
        for (int p4 = gw; p4 < M * 2; p4 += NGW) { const int p = p4 * 4 + (lane >> 4), m = p >> 3, c = (p & 7) * 128 + l16 * 8;
            const v4u a = __builtin_nontemporal_load((const v4u*)(BB + (size_t)m * HGW + c)), bb = __builtin_nontemporal_load((const v4u*)(BB + ((size_t)M + m) * HGW + c)), g = __builtin_nontemporal_load((const v4u*)(PROJ + (size_t)m * INC + 4096 + c));
            float o[8]; float ss = 0.f;
#pragma unroll
            for (int e = 0; e < 4; ++e) { o[2 * e] = __uint_as_float(a[e] << 16) + __uint_as_float(bb[e] << 16); o[2 * e + 1] = __uint_as_float(a[e] & 0xffff0000u) + __uint_as_float(bb[e] & 0xffff0000u);
                ss += o[2 * e] * o[2 * e] + o[2 * e + 1] * o[2 * e + 1]; }
            ss += __shfl_xor(ss, 1); ss += __shfl_xor(ss, 2); ss += __shfl_xor(ss, 4); ss += __shfl_xor(ss, 8);
            const float r = __builtin_amdgcn_rsqf(ss * (1.0f / 128.0f) + EPS);
            v4u y;
#pragma unroll
            for (int e = 0; e < 4; ++e) { const float w0 = e < 2 ? wa[2 * e] : wb[2 * e - 4], w1 = e < 2 ? wa[2 * e + 1] : wb[2 * e - 3];
                y[e] = pk2(o[2 * e] * r * w0 * __uint_as_float(g[e] << 16), o[2 * e + 1] * r * w1 * __uint_as_float(g[e] & 0xffff0000u)); }
            *(v4u*)(XN + (size_t)m * DM + c) = y; }
    }
    PROBE_BEGIN(57);
    SEAM(PH_HGFIN);
    PROBE_END(57);
    PROBE_END(PH_HGFIN);
    PROBE_BEGIN(PH_OUTPROJ);
    if (IN(PH_OUTPROJ)) {
        pg8::Gemm g{XN, WoT, M, DM, DM}; pg8::StaticOrder S; S.init(M, DM, G, bx);
        pg8::EpiOutProj E{args.in[0], BB};
        pg8::gemm_phase<pg8::EpiOutProj, pg8::StaticOrder, PG8_ALIGN, PG8_SP2>(lds + RING_OFF, g, S, E);
    }
    PROBE_BEGIN(58);
    SEAM(PH_OUTPROJ);
    PROBE_END(58);
    PROBE_END(PH_OUTPROJ);
    PROBE_BEGIN(PH_QUANT);
    if (IN(PH_QUANT)) {
        v4u cur[4], nxt[4];
        if (gw < M) {
#pragma unroll
            for (int j = 0; j < 4; ++j) nxt[j] = *((const v4u*)(BB + (size_t)gw * DM) + lane + 64 * j); }
        for (int m = gw; m < M; m += NGW) {
#pragma unroll
            for (int j = 0; j < 4; ++j) cur[j] = nxt[j];
            if (m + NGW < M) {
#pragma unroll
                for (int j = 0; j < 4; ++j) nxt[j] = *((const v4u*)(BB + (size_t)(m + NGW) * DM) + lane + 64 * j); }
            float s = 0.f, am = 0.f;
#pragma unroll
            for (int j = 0; j < 4; ++j)
#pragma unroll
                for (int e = 0; e < 4; ++e) { const float a = __uint_as_float(cur[j][e] << 16), b = __uint_as_float(cur[j][e] & 0xffff0000u); s += a * a + b * b; am = fmaxf(am, fmaxf(fabsf(a), fabsf(b))); }
            s = wave_sum(s); am = wave_max(am);
            const float inv = inv127(am);
            uint2* o = (uint2*)(H1Q + (size_t)m * DM) + lane;
#pragma unroll
            for (int j = 0; j < 4; ++j) { uint2 w;
                w.x = pack4_i8(__uint_as_float(cur[j][0] << 16), __uint_as_float(cur[j][0] & 0xffff0000u), __uint_as_float(cur[j][1] << 16), __uint_as_float(cur[j][1] & 0xffff0000u), inv);
                w.y = pack4_i8(__uint_as_float(cur[j][2] << 16), __uint_as_float(cur[j][2] & 0xffff0000u), __uint_as_float(cur[j][3] << 16), __uint_as_float(cur[j][3] & 0xffff0000u), inv);
                o[64 * j] = w; }
            if (lane == 0) rs2[m] = __builtin_amdgcn_rsqf(s * (1.0f / DM) + EPS) * am * (1.0f / 127.0f); }
    }
    SEAM(PH_QUANT);
    PROBE_END(PH_QUANT);
    PROBE_BEGIN(PH_GATEUP);
    if (IN(PH_GATEUP)) {
        pg8::Gemm g{(const u16*)H1Q, WguT, M, NGU, DM / 2}; pg8::StaticOrder S; S.init(M, NGU, G, bx);
        pg8::Unit u0; u0.pm = 0; u0.pn = 0; (void)S.next(0, u0);
        LAS float* rtab = (LAS float*)(lds + RTAB_OFF);
        if (tid < 256) rtab[tid] = rs2[u0.pm * 256 + tid];
        __syncthreads();
        pg8::EpiSwiGLU8 E{(unsigned char*)PROJ, (const LAS float*)rtab, u0.pm, rs2, cmax_gu};
        pg8::gemm_phase<pg8::EpiSwiGLU8, pg8::StaticOrder, PG8_ALIGN, PG8_SP2, 2>(lds + RING_OFF, g, S, E);
    }
    PROBE_BEGIN(55);
    SEAM(PH_GATEUP);
    PROBE_END(55);
    PROBE_END(PH_GATEUP);
    PROBE_BEGIN(PH_DOWN);
    if (IN(PH_DOWN)) {
        pg8::Gemm g{PROJ, WdT, M, DM, DFF / 2, 0x77777777u  , 0x7d7d7d7du  }; pg8::StaticOrder S; S.init(M, DM, G, bx);
        pg8::EpiDown E{BB};
        pg8::gemm_phase<pg8::EpiDown, pg8::StaticOrder, PG8_ALIGN, PG8_SP2, 1>(lds + RING_OFF, g, S, E);
    }
    PROBE_BEGIN(56);
    SEAM(PH_DOWN);
    PROBE_END(56);
    PROBE_END(PH_DOWN);
    PROBE_BEGIN(PH_FINAL);
    if (IN(PH_FINAL)) {
        for (int m = gw; m < M; m += NGW) rms_row_from_bf16(BB + (size_t)m * DM, args.in[16], args.out + (size_t)m * DM, lane);
    }
    PROBE_END(PH_FINAL);
    PROBE_END(99);
    if (PROBE_PH >= 0 && bx == PROBE_BX && tid == 0) { const unsigned long long t1 = __builtin_amdgcn_s_memrealtime(); while (__builtin_amdgcn_s_memrealtime() - t1 < 4 * pr_dt) __builtin_amdgcn_s_sleep(8); }
#undef IN
#undef SEAM
}

extern "C" void kernel_launch(void* const* d_in, const int* in_sizes, int n_in, void* d_out, int out_size, void* d_ws, size_t ws_size, hipStream_t stream) {
    static int grid = 0;
    if (grid == 0) {
        if (n_in != 17 || ws_size < WS_NEED || out_size != M * DM) { fprintf(stderr, "kernel_launch: unexpected shapes (n_in %d, ws %zu, out %d)\n", n_in, ws_size, out_size); grid = -1; return; }
        int dev = 0, cus = 0;
        if (hipGetDevice(&dev) != hipSuccess || hipDeviceGetAttribute(&cus, hipDeviceAttributeMultiprocessorCount, dev) != hipSuccess) { grid = -1; return; }
        if (hipFuncSetAttribute((const void*)mk_fwd, hipFuncAttributeMaxDynamicSharedMemorySize, LDS_BYTES) != hipSuccess) { fprintf(stderr, "kernel_launch: hipFuncSetAttribute failed\n"); grid = -1; return; }
        (void)hipGetLastError();
        grid = cus;
    }
    if (grid < 0) return;
    unsigned char* ws = (unsigned char*)d_ws;
    (void)hipMemsetAsync(ws + WS_CTL, 0, CTL_ZERO_BYTES, stream);
    Args a{};
    for (int i = 0; i < 17; ++i) a.in[i] = (const float*)d_in[i];
    a.out = (float*)d_out; a.ws = ws;
    a.ph_lo = PH_PRO; a.ph_hi = PH_N; a.li = 0;
    hipLaunchKernelGGL(mk_fwd, dim3(grid), dim3(NWAVES * 64), LDS_BYTES, stream, a);
}
```

```cpp
#include <hip/hip_runtime.h>
#include <stdint.h>
#include <cstdio>

typedef unsigned short u16;
constexpr int BATCH = 8, SEQ = 2048, DM = 2048, M = BATCH * SEQ;
constexpr int HGW = 1024, DAW = 1024, INC = 8192, DFF = 5632, NGU = 2 * DFF;
constexpr float EPS = 1e-6f;
constexpr float LOG2E = 1.4426950408889634f;
constexpr float C2 = 0.125f * LOG2E;
constexpr size_t MiB = 1u << 20;
constexpr size_t WS_CTL = 0, CTL_ZERO_BYTES = 65536, CMAX_GU_OFF = 65536  , CMAX_IN_OFF = 114688  , WS_PART = 2 * MiB, WS_WIN = 4 * MiB, WS_WO = 36 * MiB, WS_WGU = 44 * MiB, WS_WD = 88 * MiB,
                 WS_XN = 112 * MiB, WS_B = 176 * MiB, WS_PROJ = 240 * MiB, WS_NEED = 496 * MiB;
namespace pg8 {
#define PG8_LAS __attribute__((address_space(3)))
typedef unsigned short bf16_t;
typedef short bf16x8 __attribute__((ext_vector_type(8)));
typedef float f32x4 __attribute__((ext_vector_type(4)));
typedef unsigned u32x4 __attribute__((ext_vector_type(4)));
constexpr int BM = 256, BK = 64, HALF = 128, HTB = HALF * BK * 2  , STAGE_BYTES = 8 * HTB, NXCD = 8, WGM = 8;

__host__ __device__ __forceinline__ int lds_byte(int r, int c) { const int st = (r >> 4) * 2 + (c >> 5), rr = r & 15, cc = c & 31, ob = rr * 64 + cc * 2; return st * 1024 + (ob ^ (((ob >> 9) & 1) << 5)); }
__host__ __device__ __forceinline__ void stage_rc(int b, int& R, int& C) { const int st = b / 1024, sb = b % 1024, swz = sb ^ (((sb >> 9) & 1) << 5); R = (st >> 1) * 16 + swz / 64; C = (st & 1) * 32 + (swz % 64) / 2; }
__host__ __device__ __forceinline__ int perm32(int rho) { const int n = rho >> 4, i = rho & 15; return 8 * (i >> 2) + 4 * n + (i & 3); }

struct Unit { int pm, pn; };
struct Gemm { const bf16_t* A; const bf16_t* Bt; int M, N, K; unsigned sw = 0x7f7f7f7fu, sa = 0x7f7f7f7fu; };
typedef int i32x4 __attribute__((ext_vector_type(4)));
typedef int i32x8 __attribute__((ext_vector_type(8)));
__device__ __forceinline__ i32x8 cat_frag(bf16x8 lo, bf16x8 hi) { return __builtin_shufflevector(__builtin_bit_cast(i32x4, lo), __builtin_bit_cast(i32x4, hi), 0, 1, 2, 3, 4, 5, 6, 7); }

struct StaticOrder {
    int nM, nN, nwg, G, c;
    __host__ __device__ void init(int M, int N, int G_, int c_) { nM = M / BM; nN = N / BM; nwg = nM * nN; G = G_; c = c_; }
    __host__ __device__ bool next(int i, Unit& u) const {
        const long L = (long)i * G + c; if (L >= nwg) return false;
        int wgid = (int)L; { const int q = nwg / NXCD, r = nwg % NXCD, xcd = wgid % NXCD, off = wgid / NXCD; wgid = (xcd < r ? xcd * (q + 1) : r * (q + 1) + (xcd - r) * q) + off; }
        const int nig = WGM * nN, gid = wgid / nig, fm = gid * WGM, gsz = (nM - fm) < WGM ? (nM - fm) : WGM;
        u.pm = fm + ((wgid % nig) % gsz); u.pn = (wgid % nig) / gsz; return true;
    }
    __device__ __forceinline__ void a_ready(const Unit&) const {}
    __device__ __forceinline__ void done(const Unit&) const {}
};
__device__ __forceinline__ unsigned cvt_pk_bf16(float lo, float hi) { typedef float f2_ __attribute__((ext_vector_type(2))); typedef __bf16 b2_ __attribute__((ext_vector_type(2))); const f2_ v = {lo, hi}; return __builtin_bit_cast(unsigned, __builtin_convertvector(v, b2_)); }
typedef float f32x2 __attribute__((ext_vector_type(2)));
__device__ __forceinline__ unsigned pk_h2(float lo, float hi) { return (unsigned)__builtin_bit_cast(unsigned short, (_Float16)lo) | ((unsigned)__builtin_bit_cast(unsigned short, (_Float16)hi) << 16); }
__device__ __forceinline__ float fsig(float x) { return __builtin_amdgcn_rcpf(1.0f + __builtin_amdgcn_exp2f(-1.4426950408889634f * x)); }
__device__ __forceinline__ float fsilu(float x) { return x * fsig(x); }
struct EpiInProj {
    static constexpr bool PERM = true, AFTER_DRAIN = false;
    bf16_t* proj; const float* lbl; const float* sa; const float* cmax;
    __device__ __forceinline__ void operator()(const f32x4 (&acc)[2][2][4][2], const Unit& u, int wr, int wc, int fr, int fq) const {
        const int row0 = u.pm * BM + wr * 64 + fr, t = u.pn >> 2, col0 = u.pn * BM + wc * 32 + 8 * fq;
        bf16_t* base = proj + (size_t)row0 * 8192 + col0;
        float rs[2][4];
#pragma unroll
        for (int ai = 0; ai < 2; ++ai)
#pragma unroll
            for (int m = 0; m < 4; ++m) rs[ai][m] = sa[row0 + ai * HALF + m * 16];
        if (t == 2 || t == 3) {
#pragma unroll
            for (int bj = 0; bj < 2; ++bj) {
                float lb[8], cs[8];
                { const float* l0 = lbl + (t - 2) * 2048 + (col0 & 1023) + bj * HALF;
                  const f32x4 a0 = *(const f32x4*)(l0), a1 = *(const f32x4*)(l0 + 4), b0 = *(const f32x4*)(l0 + 1024), b1 = *(const f32x4*)(l0 + 1028);
                  const f32x4 c0 = *(const f32x4*)(cmax + col0 + bj * HALF), c1 = *(const f32x4*)(cmax + col0 + bj * HALF + 4);
#pragma unroll
                  for (int j = 0; j < 4; ++j) { lb[j] = fsig(a0[j] - b0[j]); lb[4 + j] = fsig(a1[j] - b1[j]); cs[j] = c0[j] * (1.0f / 127.0f); cs[4 + j] = c1[j] * (1.0f / 127.0f); } }
#pragma unroll
                for (int ai = 0; ai < 2; ++ai)
#pragma unroll
                    for (int m = 0; m < 4; ++m) { float y[8];
#pragma unroll
                        for (int j = 0; j < 8; ++j) { const float a = acc[ai][bj][m][j >> 2][j & 3] * rs[ai][m] * cs[j]; const float f = lb[j] + (1.0f - lb[j]) * fsig(a); y[j] = __builtin_amdgcn_logf(f); }
                        u32x4 w; w.x = pk_h2(y[0], y[1]); w.y = pk_h2(y[2], y[3]); w.z = pk_h2(y[4], y[5]); w.w = pk_h2(y[6], y[7]);
                        *(u32x4*)(base + (size_t)(ai * HALF + m * 16) * 8192 + bj * HALF) = w; }
            }
        } else {
            const float sc = (t == 5) ? 0.18033688011112042f * (1.0f / 127.0f) : (1.0f / 127.0f);
            const bool act = (t == 0 || t == 4);
#pragma unroll
            for (int bj = 0; bj < 2; ++bj) {
                float cs[8];
                { const f32x4 c0 = *(const f32x4*)(cmax + col0 + bj * HALF), c1 = *(const f32x4*)(cmax + col0 + bj * HALF + 4);
#pragma unroll
                  for (int j = 0; j < 4; ++j) { cs[j] = c0[j] * sc; cs[4 + j] = c1[j] * sc; } }
                if (act) {
#pragma unroll
                    for (int ai = 0; ai < 2; ++ai)
#pragma unroll
                        for (int m = 0; m < 4; ++m) { float y[8];
#pragma unroll
                            for (int j = 0; j < 8; ++j) y[j] = fsilu(acc[ai][bj][m][j >> 2][j & 3] * rs[ai][m] * cs[j]);
                            u32x4 w; w.x = cvt_pk_bf16(y[0], y[1]); w.y = cvt_pk_bf16(y[2], y[3]); w.z = cvt_pk_bf16(y[4], y[5]); w.w = cvt_pk_bf16(y[6], y[7]);
                            *(u32x4*)(base + (size_t)(ai * HALF + m * 16) * 8192 + bj * HALF) = w; }
                } else {
#pragma unroll
                    for (int ai = 0; ai < 2; ++ai)
#pragma unroll
                        for (int m = 0; m < 4; ++m) { float y[8];
#pragma unroll
                            for (int j = 0; j < 8; ++j) y[j] = acc[ai][bj][m][j >> 2][j & 3] * rs[ai][m] * cs[j];
                            u32x4 w; w.x = cvt_pk_bf16(y[0], y[1]); w.y = cvt_pk_bf16(y[2], y[3]); w.z = cvt_pk_bf16(y[4], y[5]); w.w = cvt_pk_bf16(y[6], y[7]);
                            *(u32x4*)(base + (size_t)(ai * HALF + m * 16) * 8192 + bj * HALF) = w; }
                }
            }
        }
    }
};
struct EpiOutProj {
    static constexpr bool PERM = true, AFTER_DRAIN = false;
    const float* x; bf16_t* h1b;
    __device__ __forceinline__ void operator()(const f32x4 (&acc)[2][2][4][2], const Unit& u, int wr, int wc, int fr, int fq) const {
        const int row0 = u.pm * BM + wr * 64 + fr, col0 = u.pn * BM + wc * 32 + 8 * fq;
#pragma unroll
        for (int ai = 0; ai < 2; ++ai) {
            f32x4 xv[4][2][2];
#pragma unroll
            for (int m = 0; m < 4; ++m)
#pragma unroll
                for (int bj = 0; bj < 2; ++bj) { const float* p = x + (size_t)(row0 + ai * HALF + m * 16) * 2048 + col0 + bj * HALF; xv[m][bj][0] = __builtin_nontemporal_load((const f32x4*)p); xv[m][bj][1] = __builtin_nontemporal_load((const f32x4*)(p + 4)); }
#pragma unroll
            for (int m = 0; m < 4; ++m) { const int row = row0 + ai * HALF + m * 16; const size_t off = (size_t)row * 2048 + col0;
#pragma unroll
                for (int bj = 0; bj < 2; ++bj) { const f32x4 h0 = xv[m][bj][0] + acc[ai][bj][m][0], h1 = xv[m][bj][1] + acc[ai][bj][m][1];
                    u32x4 w; w.x = cvt_pk_bf16(h0[0], h0[1]); w.y = cvt_pk_bf16(h0[2], h0[3]); w.z = cvt_pk_bf16(h1[0], h1[1]); w.w = cvt_pk_bf16(h1[2], h1[3]); *(u32x4*)(h1b + off + bj * HALF) = w; } }
        }
    }
};
constexpr float HID_SCALE = 4.0f;
struct EpiSwiGLU8 {
    static constexpr bool PERM = true, AFTER_DRAIN = false;
    unsigned char* hid; const PG8_LAS float* rtab; int pm_tab; const float* rsg; const float* cmax;
    __device__ __forceinline__ void operator()(const f32x4 (&acc)[2][2][4][2], const Unit& u, int wr, int wc, int fr, int fq) const {
        const int rt0 = wr * 64 + fr, col0 = u.pn * HALF + wc * 32 + 8 * fq;
        float sg[8], su[8];
        { const float* c0 = cmax + u.pn * BM + wc * 32 + 8 * fq; const f32x4 g0 = *(const f32x4*)c0, g1 = *(const f32x4*)(c0 + 4), u0 = *(const f32x4*)(c0 + HALF), u1 = *(const f32x4*)(c0 + HALF + 4);
#pragma unroll
          for (int j = 0; j < 4; ++j) { sg[j] = g0[j] * (1.0f / 127.0f); sg[4 + j] = g1[j] * (1.0f / 127.0f); su[j] = u0[j] * (HID_SCALE / 127.0f); su[4 + j] = u1[j] * (HID_SCALE / 127.0f); } }
#pragma unroll
        for (int ai = 0; ai < 2; ++ai)
#pragma unroll
            for (int m = 0; m < 4; ++m) { const int rt = rt0 + ai * HALF + m * 16;
                const float r = (u.pm == pm_tab) ? rtab[rt] : rsg[u.pm * BM + rt];
                float y[8];
#pragma unroll
                for (int j = 0; j < 8; ++j) { const float g = acc[ai][0][m][j >> 2][j & 3] * r * sg[j], up = acc[ai][1][m][j >> 2][j & 3] * r * su[j]; y[j] = fsilu(g) * up; }
                uint2 w; int t = 0;
                t = __builtin_amdgcn_cvt_pk_fp8_f32(y[0], y[1], t, false); t = __builtin_amdgcn_cvt_pk_fp8_f32(y[2], y[3], t, true); w.x = (unsigned)t;
                t = __builtin_amdgcn_cvt_pk_fp8_f32(y[4], y[5], t, false); t = __builtin_amdgcn_cvt_pk_fp8_f32(y[6], y[7], t, true); w.y = (unsigned)t;
                *(uint2*)(hid + (size_t)(u.pm * BM + rt) * 5632 + col0) = w; }
    }
};
struct EpiDown {
    static constexpr bool PERM = true, AFTER_DRAIN = false;
    bf16_t* hb;
    __device__ __forceinline__ void operator()(const f32x4 (&acc)[2][2][4][2], const Unit& u, int wr, int wc, int fr, int fq) const {
        unsigned off0 = (unsigned)((u.pm * BM + wr * 64 + fr) * 2048 + u.pn * BM + wc * 32 + 8 * fq);
#pragma unroll
        for (int ai = 0; ai < 2; ++ai) {
            unsigned ob = off0 + (unsigned)(ai * HALF * 2048); asm volatile("" : "+v"(ob));
            u32x4 hv[4][2];
#pragma unroll
            for (int m = 0; m < 4; ++m)
#pragma unroll
                for (int bj = 0; bj < 2; ++bj) hv[m][bj] = __builtin_nontemporal_load((const u32x4*)(hb + (ob + m * 16 * 2048 + bj * HALF)));
#pragma unroll
            for (int m = 0; m < 4; ++m)
#pragma unroll
                for (int bj = 0; bj < 2; ++bj) { const u32x4 h = hv[m][bj]; const f32x4 a0 = acc[ai][bj][m][0], a1 = acc[ai][bj][m][1]; u32x4 w;
                    w.x = cvt_pk_bf16(__uint_as_float(h.x << 16) + a0[0], __uint_as_float(h.x & 0xffff0000u) + a0[1]); w.y = cvt_pk_bf16(__uint_as_float(h.y << 16) + a0[2], __uint_as_float(h.y & 0xffff0000u) + a0[3]);
                    w.z = cvt_pk_bf16(__uint_as_float(h.z << 16) + a1[0], __uint_as_float(h.z & 0xffff0000u) + a1[1]); w.w = cvt_pk_bf16(__uint_as_float(h.w << 16) + a1[2], __uint_as_float(h.w & 0xffff0000u) + a1[3]);
                    *(u32x4*)(hb + (ob + m * 16 * 2048 + bj * HALF)) = w; }
        }
    }
};

template <class Epi, class Sched, bool ALIGN_EPI = false, bool SP2 = false, int MODE = 0>
__device__ __forceinline__ void gemm_phase(PG8_LAS unsigned char* lds, const Gemm g, const Sched& S, const Epi& E) {
    const int tid = threadIdx.x, wid = __builtin_amdgcn_readfirstlane(tid >> 6), lane = tid & 63, wr = wid >> 2, wc = wid & 3, fr = lane & 15, fq = lane >> 4;
    const int K = g.K, nt = K / BK;
    unsigned voffA[2], voffB[2];
#pragma unroll
    for (int i = 0; i < 2; ++i) { int R, C; stage_rc(tid * 16 + i * 8192, R, C); const int Rb = Epi::PERM ? ((R & ~31) + perm32(R & 31)) : R;
        voffA[i] = (unsigned)(R * K + C) * 2u; voffB[i] = (unsigned)(Rb * K + C) * 2u; }
    const size_t kstep = (size_t)(BK * 2);
    const size_t hstep = (size_t)HALF * K * 2;
    const size_t tstep = 2 * hstep;
    const unsigned ldsw = (unsigned)wid * 1024u;
    const int aoff = lds_byte(wr * 64 + fr, fq * 8), boff = lds_byte(wc * 32 + fr, fq * 8);
#define PG8_SA(b, h) (((b) * 2 + (h)) * HTB)
#define PG8_SB(b, h) ((4 + (b) * 2 + (h)) * HTB)
#define PG8_STAGE(bufoff, gbase, voff) do { _Pragma("unroll") for (int _i = 0; _i < 2; ++_i) \
        __builtin_amdgcn_global_load_lds((const unsigned*)((const char*)(gbase) + (voff)[_i]), (PG8_LAS unsigned*)(lds + (bufoff) + ldsw + _i * 8192), 16, 0, 0); } while (0)
#define PG8_LDA(dst, b, h) do { _Pragma("unroll") for (int m = 0; m < 4; ++m) _Pragma("unroll") for (int k = 0; k < 2; ++k) dst[m][k] = *(const PG8_LAS bf16x8*)(lds + PG8_SA(b, h) + aoff + m * 2048 + k * 1024); } while (0)
#define PG8_LDB(dst, b, h) do { _Pragma("unroll") for (int n = 0; n < 2; ++n) _Pragma("unroll") for (int k = 0; k < 2; ++k) dst[n][k] = *(const PG8_LAS bf16x8*)(lds + PG8_SB(b, h) + boff + n * 2048 + k * 1024); } while (0)
#define PG8_MMA(ai, bj, At, Bt) do { __builtin_amdgcn_s_setprio(1); _Pragma("unroll") for (int m = 0; m < 4; ++m) _Pragma("unroll") for (int n = 0; n < 2; ++n) { \
        if constexpr (MODE == 1) { const i32x8 b8_ = cat_frag(Bt[n][0], Bt[n][1]), a8_ = cat_frag(At[m][0], At[m][1]); \
            asm volatile("v_mfma_scale_f32_16x16x128_f8f6f4 %0, %1, %2, %0, %3, %4 op_sel_hi:[0,0,0]" : "+v"(acc[ai][bj][m][n]) : "v"(b8_), "v"(a8_), "v"(g.sw), "v"(g.sa)); } \
        else if constexpr (MODE == 2) { _Pragma("unroll") for (int k = 0; k < 2; ++k) acc[ai][bj][m][n] = __builtin_bit_cast(f32x4, __builtin_amdgcn_mfma_i32_16x16x64_i8(__builtin_bit_cast(i32x4, Bt[n][k]), __builtin_bit_cast(i32x4, At[m][k]), __builtin_bit_cast(i32x4, acc[ai][bj][m][n]), 0, 0, 0)); } \
        else { _Pragma("unroll") for (int k = 0; k < 2; ++k) acc[ai][bj][m][n] = __builtin_amdgcn_mfma_f32_16x16x32_bf16(Bt[n][k], At[m][k], acc[ai][bj][m][n], 0, 0, 0); } } \
        __builtin_amdgcn_s_setprio(0); } while (0)
#define PG8_WAIT_V(n) asm volatile("s_waitcnt vmcnt(" #n ")" ::: "memory")
#define PG8_WAIT_L(n) asm volatile("s_waitcnt lgkmcnt(" #n ")" ::: "memory")
#define PG8_BAR __builtin_amdgcn_s_barrier()
#define PG8_SCHED __builtin_amdgcn_sched_barrier(0)
    Unit cur, nxt; int ui = 0;
    if (!S.next(0, cur)) return;
    f32x4 acc[2][2][4][2];
#pragma unroll
    for (int a = 0; a < 2; ++a)
#pragma unroll
        for (int b = 0; b < 2; ++b)
#pragma unroll
            for (int m = 0; m < 4; ++m)
#pragma unroll
                for (int n = 0; n < 2; ++n) acc[a][b][m][n] = (f32x4){0.f, 0.f, 0.f, 0.f};
    bf16x8 At[4][2], B0[2][2], B1[2][2];
    const char* cA = (const char*)g.A + (size_t)cur.pm * tstep; const char* cB = (const char*)g.Bt + (size_t)cur.pn * tstep;
    S.a_ready(cur);
    if constexpr (SP2) {
        PG8_STAGE(PG8_SB(0, 0), cB, voffB); PG8_STAGE(PG8_SB(0, 1), cB + hstep, voffB); PG8_STAGE(PG8_SA(0, 0), cA, voffA); PG8_STAGE(PG8_SA(0, 1), cA + hstep, voffA);
        if (wr == 1) PG8_BAR;
        PG8_WAIT_V(2); PG8_BAR;
        PG8_STAGE(PG8_SB(1, 0), cB + kstep, voffB); PG8_STAGE(PG8_SA(1, 0), cA + kstep, voffA); PG8_STAGE(PG8_SB(1, 1), cB + hstep + kstep, voffB);
        PG8_WAIT_V(6); PG8_BAR;
    } else {
        PG8_STAGE(PG8_SB(0, 0), cB, voffB); PG8_STAGE(PG8_SA(0, 0), cA, voffA); PG8_STAGE(PG8_SB(0, 1), cB + hstep, voffB); PG8_STAGE(PG8_SA(0, 1), cA + hstep, voffA);
        if (wr == 1) PG8_BAR;
        PG8_WAIT_V(4); PG8_BAR;
        PG8_STAGE(PG8_SB(1, 0), cB + kstep, voffB); PG8_STAGE(PG8_SA(1, 0), cA + kstep, voffA); PG8_STAGE(PG8_SB(1, 1), cB + hstep + kstep, voffB);
        PG8_WAIT_V(6); PG8_BAR;
    }
    for (;;) {
        const bool has_next = S.next(ui + 1, nxt);
        const char* nA = has_next ? (const char*)g.A + (size_t)nxt.pm * tstep : cA; const char* nB = has_next ? (const char*)g.Bt + (size_t)nxt.pn * tstep : cB;
        for (int t = 0; t < nt; t += 2) {
            const bool last = (t == nt - 2);
            const char* a1 = cA + (size_t)(t + 1) * kstep;
            const char* a2 = last ? nA : cA + (size_t)(t + 2) * kstep; const char* b2 = last ? nB : cB + (size_t)(t + 2) * kstep;
            const char* a3 = a2 + kstep; const char* b3 = b2 + kstep;
            if (last && has_next) S.a_ready(nxt);
            if constexpr (SP2) {
            PG8_LDB(B0, 0, 0); PG8_LDB(B1, 0, 1); PG8_SCHED; PG8_LDA(At, 0, 0); PG8_STAGE(PG8_SA(1, 1), a1 + hstep, voffA);
            PG8_WAIT_V(8); PG8_WAIT_L(0); PG8_BAR; PG8_MMA(0, 0, At, B0); PG8_MMA(0, 1, At, B1); PG8_BAR; PG8_SCHED;
            PG8_LDA(At, 0, 1); PG8_STAGE(PG8_SB(0, 0), b2, voffB); PG8_STAGE(PG8_SB(0, 1), b2 + hstep, voffB); PG8_STAGE(PG8_SA(0, 0), a2, voffA);
            PG8_WAIT_V(8); PG8_WAIT_L(0); PG8_BAR; PG8_MMA(1, 0, At, B0); PG8_MMA(1, 1, At, B1); PG8_BAR; PG8_SCHED;
            PG8_LDB(B0, 1, 0); PG8_LDB(B1, 1, 1); PG8_SCHED; PG8_LDA(At, 1, 0); PG8_STAGE(PG8_SA(0, 1), a2 + hstep, voffA);
            PG8_WAIT_V(8); PG8_WAIT_L(0); PG8_BAR; PG8_MMA(0, 0, At, B0); PG8_MMA(0, 1, At, B1); PG8_BAR; PG8_SCHED;
            PG8_LDA(At, 1, 1); PG8_STAGE(PG8_SB(1, 0), b3, voffB); PG8_STAGE(PG8_SB(1, 1), b3 + hstep, voffB); PG8_STAGE(PG8_SA(1, 0), a3, voffA);
            PG8_WAIT_V(8); PG8_WAIT_L(0); PG8_BAR; PG8_MMA(1, 0, At, B0); PG8_MMA(1, 1, At, B1); PG8_BAR; PG8_SCHED;
            } else {
            PG8_LDB(B0, 0, 0); PG8_SCHED; PG8_LDA(At, 0, 0); PG8_STAGE(PG8_SA(1, 1), a1 + hstep, voffA);
            PG8_WAIT_L(8); PG8_BAR; PG8_WAIT_L(0); PG8_MMA(0, 0, At, B0); PG8_BAR; PG8_SCHED;
            PG8_LDB(B1, 0, 1); PG8_STAGE(PG8_SB(0, 0), b2, voffB);
            PG8_BAR; PG8_WAIT_L(0); PG8_MMA(0, 1, At, B1); PG8_BAR;
            PG8_LDA(At, 0, 1); PG8_STAGE(PG8_SA(0, 0), a2, voffA);
            PG8_BAR; PG8_WAIT_L(0); PG8_MMA(1, 0, At, B0); PG8_BAR; PG8_SCHED;
            PG8_STAGE(PG8_SB(0, 1), b2 + hstep, voffB);
            PG8_WAIT_V(6); PG8_BAR; PG8_MMA(1, 1, At, B1); PG8_BAR;
            PG8_LDB(B0, 1, 0); PG8_SCHED; PG8_LDA(At, 1, 0); PG8_STAGE(PG8_SA(0, 1), a2 + hstep, voffA);
            PG8_WAIT_L(8); PG8_BAR; PG8_WAIT_L(0); PG8_MMA(0, 0, At, B0); PG8_BAR; PG8_SCHED;
            PG8_LDB(B1, 1, 1); PG8_STAGE(PG8_SB(1, 0), b3, voffB);
            PG8_BAR; PG8_WAIT_L(0); PG8_MMA(0, 1, At, B1); PG8_BAR;
            PG8_LDA(At, 1, 1); PG8_STAGE(PG8_SA(1, 0), a3, voffA);
            PG8_BAR; PG8_WAIT_L(0); PG8_MMA(1, 0, At, B0); PG8_BAR; PG8_SCHED;
            PG8_STAGE(PG8_SB(1, 1), b3 + hstep, voffB);
            PG8_WAIT_V(6); PG8_BAR; PG8_MMA(1, 1, At, B1); PG8_BAR;
            }
        }
        if constexpr (MODE == 1) asm volatile("s_nop 15\n\ts_nop 15" ::: "memory");
        if constexpr (ALIGN_EPI) { if (wr == 0) PG8_BAR; }
        if constexpr (MODE == 2) {
#pragma unroll
            for (int a = 0; a < 2; ++a)
#pragma unroll
                for (int b = 0; b < 2; ++b)
#pragma unroll
                    for (int m = 0; m < 4; ++m)
#pragma unroll
                        for (int n = 0; n < 2; ++n) acc[a][b][m][n] = __builtin_convertvector(__builtin_bit_cast(i32x4, acc[a][b][m][n]), f32x4);
        }
        if constexpr (!Epi::AFTER_DRAIN) { E(acc, cur, wr, wc, fr, fq); S.done(cur); }
        if (!has_next) break;
#pragma unroll
        for (int a = 0; a < 2; ++a)
#pragma unroll
            for (int b = 0; b < 2; ++b)
#pragma unroll
                for (int m = 0; m < 4; ++m)
#pragma unroll
                    for (int n = 0; n < 2; ++n) acc[a][b][m][n] = (f32x4){0.f, 0.f, 0.f, 0.f};
        cur = nxt; cA = nA; cB = nB; ++ui;
        if constexpr (ALIGN_EPI) { if (wr == 1) PG8_BAR; }
    }
    PG8_WAIT_V(0);
    if constexpr (!ALIGN_EPI) { if (wr == 0) PG8_BAR; }
    PG8_BAR;
    if constexpr (Epi::AFTER_DRAIN) { E.fused(acc, cur, wr, wc, fr, fq, lds, wid, lane); S.done(cur); }
#undef PG8_SA
#undef PG8_SB
#undef PG8_STAGE
#undef PG8_LDA
#undef PG8_LDB
#undef PG8_MMA
#undef PG8_WAIT_V
#undef PG8_WAIT_L
#undef PG8_BAR
#undef PG8_SCHED
}
}

#ifndef PG8_SP2
#define PG8_SP2 true
#endif
#ifndef PG8_ALIGN
#define PG8_ALIGN true
#endif
constexpr int RING_OFF = 0, RING_BYTES = 131072;
constexpr int LDS_BYTES = 163840;
constexpr int LDSCTL_OFF = LDS_BYTES - 2048, MISC_OFF = LDSCTL_OFF + 320;
constexpr int RTAB_OFF = LDSCTL_OFF + 1024;
constexpr int NWAVES = 8;
constexpr int CW_BAR = 4096;

#define GAS __attribute__((address_space(1)))
#define LAS __attribute__((address_space(3)))
typedef unsigned v4u __attribute__((ext_vector_type(4)));
typedef float f32x4 __attribute__((ext_vector_type(4)));
typedef GAS unsigned gu32;
#define LDS_WAIT() asm volatile("s_waitcnt lgkmcnt(0)" ::: "memory")
#define VM_WAIT() asm volatile("s_waitcnt vmcnt(0)" ::: "memory")
__device__ __forceinline__ unsigned f2bf_u(float f) { unsigned u = __builtin_bit_cast(unsigned, f); return (u + 0x7fffu + ((u >> 16) & 1u)) >> 16; }
__device__ __forceinline__ unsigned pk2(float lo, float hi) { return f2bf_u(lo) | (f2bf_u(hi) << 16); }
__device__ __forceinline__ float wave_sum(float v) {
#pragma unroll
    for (int o = 1; o < 64; o <<= 1) v += __shfl_xor(v, o);
    return v;
}
__device__ __forceinline__ float wave_max(float v) {
#pragma unroll
    for (int o = 1; o < 64; o <<= 1) v = fmaxf(v, __shfl_xor(v, o));
    return v;
}
__device__ __forceinline__ unsigned pack4_i8(float a, float b, float c, float d, float inv) {
    const unsigned t0 = __float_as_uint(__builtin_fmaf(a, inv, 12582912.0f)), t1 = __float_as_uint(__builtin_fmaf(b, inv, 12582912.0f)),
                   t2 = __float_as_uint(__builtin_fmaf(c, inv, 12582912.0f)), t3 = __float_as_uint(__builtin_fmaf(d, inv, 12582912.0f));
    const unsigned lo = __builtin_amdgcn_perm(t1, t0, 0x0c0c0400u), hi = __builtin_amdgcn_perm(t3, t2, 0x0c0c0400u);
    return __builtin_amdgcn_perm(hi, lo, 0x05040100u);
}
__device__ __forceinline__ float inv127(float amax) { return 127.0f / fmaxf(amax, 1e-30f); }

#define XB_TMO      128
#define XB_XCNT(j)  (256  + 64 * (j))
#define XB_XSUB(j)  (1280 + 64 * (j))
#define XB_XGEN(j)  (2304 + 64 * (j))
#define XB_TOP      3328
#define XB_TOPGEN   3392
#define XCD_BAR_WORDS 3456
#define XB_SPIN_CAP (1u << 18)

__device__ __forceinline__ unsigned xb_ld(unsigned* p)              { return __hip_atomic_load(p, __ATOMIC_RELAXED, __HIP_MEMORY_SCOPE_AGENT); }
__device__ __forceinline__ unsigned xb_add(unsigned* p, unsigned v) { return __hip_atomic_fetch_add(p, v, __ATOMIC_RELAXED, __HIP_MEMORY_SCOPE_AGENT); }
__device__ __forceinline__ unsigned xb_xcc_id() { return (unsigned)__builtin_amdgcn_s_getreg((3 << 11) | 20) & 0xFu; }
#define XB_SPIN(cond, bar) do { unsigned _sp = 0; while (cond) { __builtin_amdgcn_s_sleep(1); \
    if ((++_sp & 255u) == 0u) { if (xb_ld(&(bar)[XB_TMO])) break; if (_sp > XB_SPIN_CAP) { atomicAdd(&(bar)[XB_TMO], 1u); break; } } } } while (0)

struct XcdBarrier {
    unsigned* bar; unsigned x;
    volatile LAS unsigned* st;
};

__device__ __forceinline__ XcdBarrier xcd_barrier_post(unsigned* bar, volatile LAS unsigned* st) {
    XcdBarrier b; b.bar = bar; b.x = xb_xcc_id(); b.st = st;
    if (threadIdx.x == 0) (void)xb_add(&bar[XB_XCNT(b.x)], 1u);
    return b;
}
__device__ __forceinline__ void xcd_barrier_complete(unsigned* bar, unsigned x, unsigned& nloc, unsigned& nx) {
    const unsigned G = gridDim.x * gridDim.y * gridDim.z;
    unsigned sum, cnt, mine, sp = 0u;
    for (;;) {
        sum = 0u; cnt = 0u; mine = 0u;
#pragma unroll
        for (unsigned j = 0; j < 16; ++j) { const unsigned c = xb_ld(&bar[XB_XCNT(j)]); sum += c; cnt += (c > 0u) ? 1u : 0u; mine = (j == x) ? c : mine; }
        if (sum == G) break;
        __builtin_amdgcn_s_sleep(1);
        if ((++sp & 255u) == 0u) { if (xb_ld(&bar[XB_TMO])) break; if (sp > XB_SPIN_CAP) { atomicAdd(&bar[XB_TMO], 1u); break; } }
    }
    nloc = mine > 0u ? mine : 1u; nx = cnt > 0u ? cnt : 1u;
}

__device__ __forceinline__ void xcd_barrier(const XcdBarrier& b) {
    asm volatile("s_waitcnt vmcnt(0)" ::: "memory");
    __syncthreads();
    if (threadIdx.x == 0) {
        unsigned* bar = b.bar;
        __builtin_amdgcn_s_waitcnt(0);
        unsigned nloc = b.st[0], nx = b.st[1];
        if (nloc == 0u) { xcd_barrier_complete(bar, b.x, nloc, nx); b.st[0] = nloc; b.st[1] = nx; }
        const unsigned old = xb_add(&bar[XB_XSUB(b.x)], 1u);
        const unsigned gen = old / nloc;
        if (old + 1u == (gen + 1u) * nloc) {
            __builtin_amdgcn_fence(__ATOMIC_RELEASE, "agent");
            asm volatile("s_waitcnt vmcnt(0)" ::: "memory");
            const unsigned og = xb_add(&bar[XB_TOP], 1u);
            const unsigned tg = og / nx;
            if (og + 1u == (tg + 1u) * nx) xb_add(&bar[XB_TOPGEN], 1u);
            else XB_SPIN(xb_ld(&bar[XB_TOPGEN]) == tg, bar);
            __builtin_amdgcn_fence(__ATOMIC_ACQUIRE, "agent");
            xb_add(&bar[XB_XGEN(b.x)], 1u);
            asm volatile("s_waitcnt vmcnt(0)" ::: "memory");
        } else {
            XB_SPIN(xb_ld(&bar[XB_XGEN(b.x)]) == gen, bar);
            __builtin_amdgcn_fence(__ATOMIC_ACQUIRE, "agent");
            asm volatile("s_waitcnt vmcnt(0)" ::: "memory");
        }
    }
    __syncthreads();
}

namespace bg {
typedef float f32x4 __attribute__((ext_vector_type(4)));
typedef unsigned u32x4 __attribute__((ext_vector_type(4)));
constexpr int I_O = (DM / 32) * (DM / 64), I_G = 0  , I_D = (DFF / 32) * (DM / 64), NBG = I_O + 2 * I_G + I_D;
struct Ptrs { const float* w_out; const float* w_gate; const float* w_up; const float* w_down; const float* norm2_w; u16* WoT; u16* WguT; u16* WdT; const float* cmax_gu; };
constexpr float WD_SCALE = 256.0f;
struct Dec { const float* W; u16* WT; const float* ksc; int K, N, k0, n0, drow0, f8; };
__device__ __forceinline__ Dec decode(const Ptrs& P, int q) {
    Dec d;
    if (q < I_O) { d.f8 = 0; d.W = P.w_out; d.WT = P.WoT; d.ksc = nullptr; d.K = DM; d.N = DM; d.k0 = 32 * (q / (DM / 64)); d.n0 = 64 * (q % (DM / 64)); d.drow0 = d.n0; return d; }
    q -= I_O;
    if (q < 2 * I_G) { const int up = q >= I_G ? 1 : 0; if (up) q -= I_G; d.f8 = 2; d.W = up ? P.w_up : P.w_gate; d.WT = P.WguT; d.ksc = P.norm2_w; d.K = DM; d.N = DFF;
        d.k0 = 32 * (q / (DFF / 64)); d.n0 = 64 * (q % (DFF / 64)); d.drow0 = 256 * (d.n0 >> 7) + 128 * up + (d.n0 & 127); return d; }
    q -= 2 * I_G;
    d.f8 = 1; d.W = P.w_down; d.WT = P.WdT; d.ksc = nullptr; d.K = DFF; d.N = DM; d.k0 = 32 * (q / (DM / 64)); d.n0 = 64 * (q % (DM / 64)); d.drow0 = d.n0; return d;
}
__device__ __forceinline__ void load(const Ptrs& P, int q, int lane, f32x4 (&v)[8]) {
    const Dec d = decode(P, q); const int kg = lane >> 4, n4 = (lane & 15) * 4;
    const float* src = d.W + (size_t)(d.k0 + 8 * kg) * d.N + d.n0 + n4;
#pragma unroll
    for (int i = 0; i < 8; ++i) v[i] = __builtin_nontemporal_load((const f32x4*)(src + (size_t)i * d.N));
}
__device__ __forceinline__ void store(const Ptrs& P, int q, int lane, f32x4 (&v)[8]) {
    const Dec d = decode(P, q); const int kg = lane >> 4, n4 = (lane & 15) * 4;
    if (d.ksc) { const f32x4 s0 = *(const f32x4*)(d.ksc + d.k0 + 8 * kg), s1 = *(const f32x4*)(d.ksc + d.k0 + 8 * kg + 4);
#pragma unroll
        for (int i = 0; i < 4; ++i) { v[i] = v[i] * s0[i]; v[4 + i] = v[4 + i] * s1[i]; } }
    if (d.f8 == 2) {
        const f32x4 cm = *(const f32x4*)(P.cmax_gu + d.drow0 + n4);
#pragma unroll
        for (int jn = 0; jn < 4; ++jn) { const float inv = inv127(cm[jn]); uint2 o; o.x = pack4_i8(v[0][jn], v[1][jn], v[2][jn], v[3][jn], inv); o.y = pack4_i8(v[4][jn], v[5][jn], v[6][jn], v[7][jn], inv);
            *(uint2*)((unsigned char*)d.WT + (size_t)(d.drow0 + n4 + jn) * d.K + d.k0 + 8 * kg) = o; }
        return; }
    if (d.f8) {
#pragma unroll
        for (int jn = 0; jn < 4; ++jn) { uint2 o; int t = 0;
            t = __builtin_amdgcn_cvt_pk_fp8_f32(v[0][jn] * WD_SCALE, v[1][jn] * WD_SCALE, t, false); t = __builtin_amdgcn_cvt_pk_fp8_f32(v[2][jn] * WD_SCALE, v[3][jn] * WD_SCALE, t, true); o.x = (unsigned)t;
            t = __builtin_amdgcn_cvt_pk_fp8_f32(v[4][jn] * WD_SCALE, v[5][jn] * WD_SCALE, t, false); t = __builtin_amdgcn_cvt_pk_fp8_f32(v[6][jn] * WD_SCALE, v[7][jn] * WD_SCALE, t, true); o.y = (unsigned)t;
            *(uint2*)((unsigned char*)d.WT + (size_t)(d.drow0 + n4 + jn) * d.K + d.k0 + 8 * kg) = o; }
        return; }
#pragma unroll
    for (int jn = 0; jn < 4; ++jn) { u32x4 o; o.x = pk2(v[0][jn], v[1][jn]); o.y = pk2(v[2][jn], v[3][jn]); o.z = pk2(v[4][jn], v[5][jn]); o.w = pk2(v[6][jn], v[7][jn]);
        *(u32x4*)(d.WT + (size_t)(d.drow0 + n4 + jn) * d.K + d.k0 + 8 * kg) = o; }
}
}

namespace hg {
typedef short bf16x8 __attribute__((ext_vector_type(8)));
typedef short s16x4 __attribute__((ext_vector_type(4)));
typedef short v4i16_t __attribute__((ext_vector_type(4)));
typedef float f32x16 __attribute__((ext_vector_type(16)));
typedef float f32x4 __attribute__((ext_vector_type(4)));
typedef float f32x2 __attribute__((ext_vector_type(2)));
typedef unsigned u32x4 __attribute__((ext_vector_type(4)));
typedef unsigned u32x2 __attribute__((ext_vector_type(2)));
#define HG_LAS __attribute__((address_space(3)))
constexpr int SET = 58368, O_QS = 0, O_KS = 16384, O_KD = 32768, O_V = 49152, O_EM = 57344, O_DL = 57856;
constexpr int L_TOT = 2 * SET, L_SLAB = L_TOT + 2048, L_END = L_SLAB + 16384;
__device__ __forceinline__ unsigned cvtpk(float lo, float hi) { typedef float f2_ __attribute__((ext_vector_type(2))); typedef __bf16 b2_ __attribute__((ext_vector_type(2))); const f2_ v = {lo, hi}; return __builtin_bit_cast(unsigned, __builtin_convertvector(v, b2_)); }
__device__ __forceinline__ float bf_lo(unsigned u) { return __uint_as_float(u << 16); }
__device__ __forceinline__ float bf_hi(unsigned u) { return __uint_as_float(u & 0xffff0000u); }
__device__ __forceinline__ float h_lo(unsigned u) { return (float)__builtin_bit_cast(_Float16, (unsigned short)(u & 0xffffu)); }
__device__ __forceinline__ float h_hi(unsigned u) { return (float)__builtin_bit_cast(_Float16, (unsigned short)(u >> 16)); }
__device__ __forceinline__ s16x4 vtr(const HG_LAS unsigned char* p) { return __builtin_bit_cast(s16x4, __builtin_amdgcn_ds_read_tr16_b64_v4i16((HG_LAS v4i16_t*)p)); }
__device__ __forceinline__ bf16x8 pk8(const f32x16& x, int b) {
    u32x4 w; w.x = cvtpk(x[b], x[b + 1]); w.y = cvtpk(x[b + 2], x[b + 3]); w.z = cvtpk(x[b + 4], x[b + 5]); w.w = cvtpk(x[b + 6], x[b + 7]); return __builtin_bit_cast(bf16x8, w); }
__device__ __forceinline__ bf16x8 cat8(s16x4 lo, s16x4 hi) { return (bf16x8){lo[0], lo[1], lo[2], lo[3], hi[0], hi[1], hi[2], hi[3]}; }
__device__ __forceinline__ bf16x8 perm_frag(const HG_LAS unsigned char* mat, int row, int ch, int hi) {
    const HG_LAS unsigned char* p = mat + row * 256 + 8 * hi;
    const u32x2 lo = *(const HG_LAS u32x2*)(p + ((ch ^ (row & 15)) << 4)), hh = *(const HG_LAS u32x2*)(p + (((ch + 1) ^ (row & 15)) << 4));
    return __builtin_bit_cast(bf16x8, (u32x4){lo.x, lo.y, hh.x, hh.y});
}

__device__ __forceinline__ void hgrn_item(HG_LAS unsigned char* lds, const u16* __restrict__ PROJ, u16* __restrict__ ODIR, int item, int tid, const bg::Ptrs& BP, int& bgj, int gcw, int NCW) {
    const int lane = tid & 63, w = __builtin_amdgcn_readfirstlane(tid >> 6), hi = lane >> 5, c32 = lane & 31;
    const int vh = item & 1, dir = (item >> 1) & 1, h = (item >> 2) & 7, b = item >> 5;
    const bool prod = w < 4; const int pw = w & 3;
    const size_t rowbase = (size_t)b * SEQ;
    const int cq = h * 128 + 2 * lane, cf = 2048 + dir * 1024 + h * 128 + 2 * lane;
    const int pt = pw * 64 + lane, vs = pt >> 2, vc = (pt & 3) * 2, cv = 1024 + h * 128 + vh * 64 + vc * 8;
    const int jb = pw & 1, kh = pw >> 1;
    const int trb = (4 * hi + ((lane & 15) >> 2)) * 64 + ((lane >> 4) & 1) * 32 + (lane & 3) * 8;
    f32x16 R0, R1, R2, R3; bg::f32x4 bgv[4], bgx[8];
#pragma unroll
    for (int r = 0; r < 16; ++r) { R0[r] = 0.f; R1[r] = 0.f; }
#define S0 R0
#define S1 R1
#define oown R2
#define ooth R3
#define FU(x) __float_as_uint(x)
#define UF(x) __uint_as_float(x)
#define HG_TOK(c, i) (dir ? (SEQ - 1 - (64 * (c) + (i))) : (64 * (c) + (i)))
    const unsigned rb8 = (unsigned)(rowbase * 8192);
#define HG_LOAD(c) do { _Pragma("unroll") for (int r = 0; r < 16; ++r) { const unsigned ro = rb8 + (unsigned)HG_TOK(c, 16 * pw + r) * 8192u; R0[r] = *(const float*)(PROJ + (ro + cq)); R1[r] = *(const float*)(PROJ + (ro + cf)); } \
        { const unsigned vo_ = rb8 + (unsigned)HG_TOK(c, vs) * 8192u + cv; bgv[2] = *(const bg::f32x4*)(PROJ + vo_); bgv[3] = *(const bg::f32x4*)(PROJ + (vo_ + 8)); } } while (0)
    if (prod) HG_LOAD(0);
    HG_LAS float* tot = (HG_LAS float*)(lds + L_TOT);
    constexpr int NC = SEQ / 64;
    if (prod) {
        for (int c = 0; c <= NC + 1; ++c) {
            HG_LAS unsigned char* ps = lds + (c & 1) * SET;
            const int bgq = bgj * NCW + gcw; const bool bgdo = c < NC && bgq < bg::NBG && ((((c + 1) * 8) >> 5) != ((c * 8) >> 5));
            if (c < NC) {
                R2 = R0; R3 = R1; bgv[0] = bgv[2]; bgv[1] = bgv[3];
                if (c + 1 < NC) { int lq = lane; asm volatile("" : "+v"(lq));
                    const int cq = h * 128 + 2 * lq, cf = 2048 + dir * 1024 + h * 128 + 2 * lq, pt = pw * 64 + lq, vs = pt >> 2, cv = 1024 + h * 128 + vh * 64 + (pt & 3) * 16;
                    HG_LOAD(c + 1); }
                float a0 = 0.f, a1 = 0.f;
#pragma unroll
                for (int r = 0; r < 16; ++r) { a0 += h_lo(FU(R3[r])); a1 += h_hi(FU(R3[r])); }
                *(HG_LAS f32x2*)(tot + pw * 128 + 2 * lane) = (f32x2){a0, a1};
                if (bgdo) bg::load(BP, bgq, lane, bgx);
            }
            __syncthreads();
            if (c < NC) {
                float p0 = 0.f, p1 = 0.f, m0 = 0.f, m1 = 0.f, t0 = 0.f, t1 = 0.f;
#pragma unroll
                for (int ww = 0; ww < 4; ++ww) { const f32x2 x = *(const HG_LAS f32x2*)(tot + ww * 128 + 2 * lane);
                    if (ww < pw) { p0 += x.x; p1 += x.y; } if (ww < 2) { m0 += x.x; m1 += x.y; } t0 += x.x; t1 += x.y; }
                const float El0 = __builtin_amdgcn_exp2f(t0 - m0), El1 = __builtin_amdgcn_exp2f(t1 - m1);
                if (pw == 0) { *(HG_LAS f32x2*)(ps + O_EM + 8 * lane) = (f32x2){__builtin_amdgcn_exp2f(m0), __builtin_amdgcn_exp2f(m1)};
                               *(HG_LAS f32x2*)(ps + O_DL + 8 * lane) = (f32x2){__builtin_amdgcn_exp2f(t0), __builtin_amdgcn_exp2f(t1)}; }
                const float x0 = __builtin_fminf(__builtin_fmaxf(p0 - m0, -56.f), 56.f), x1 = __builtin_fminf(__builtin_fmaxf(p1 - m1, -56.f), 56.f);
                float e0 = __builtin_amdgcn_exp2f(x0), e1 = __builtin_amdgcn_exp2f(x1), g0 = __builtin_amdgcn_exp2f(-x0), g1 = __builtin_amdgcn_exp2f(-x1);
                int lno = lane; asm volatile("" : "+v"(lno));
#pragma unroll
                for (int r = 0; r < 16; ++r) {
                    const int i = 16 * pw + r;
                    const float lf0 = h_lo(FU(R3[r])), lf1 = h_hi(FU(R3[r]));
                    const float f0 = __builtin_amdgcn_exp2f(lf0), f1 = __builtin_amdgcn_exp2f(lf1), fi0 = __builtin_amdgcn_exp2f(-lf0), fi1 = __builtin_amdgcn_exp2f(-lf1);
                    e0 *= f0; e1 *= f1; g0 *= fi0; g1 *= fi1;
                    const float qs0 = bf_lo(FU(R2[r])) * e0, qs1 = bf_hi(FU(R2[r])) * e1, ks0 = (1.0f - f0) * g0, ks1 = (1.0f - f1) * g1;
                    const int sw = i * 256 + ((((lno >> 2) ^ (i & 15))) << 4) + (lno & 3) * 4;
                    *(HG_LAS unsigned*)(ps + O_QS + sw) = cvtpk(qs0, qs1);
                    *(HG_LAS unsigned*)(ps + O_KS + sw) = cvtpk(ks0, ks1);
                    *(HG_LAS unsigned*)(ps + O_KD + (((lno >> 4) * 4 + (i >> 4)) * 1024) + (i & 15) * 64 + (lno & 15) * 4) = cvtpk(ks0 * El0, ks1 * El1);
                }
                { const int pt = pw * 64 + lno, vs = pt >> 2, vc = (pt & 3) * 2;
                  HG_LAS unsigned char* vd = ps + O_V + (((vc >> 2) * 4 + (vs >> 4)) * 1024) + (vs & 15) * 64 + (vc & 3) * 16;
                  *(HG_LAS bg::f32x4*)vd = bgv[0]; *(HG_LAS bg::f32x4*)(vd + 16) = bgv[1]; }
                if (bgdo) { bg::store(BP, bgq, lane, bgx); ++bgj; }
            }
            __syncthreads();
        }
    } else {
        for (int c = 0; c <= NC + 1; ++c) {
            const HG_LAS unsigned char* cs = lds + ((c + 1) & 1) * SET;
            int lnc = lane; asm volatile("" : "+v"(lnc));
            const int hi = lnc >> 5, c32 = lnc & 31, trb = (4 * hi + ((lnc & 15) >> 2)) * 64 + ((lnc >> 4) & 1) * 32 + (lnc & 3) * 8;
            if (c >= 2) {
            const HG_LAS float* slab = (const HG_LAS float*)(lds + L_SLAB) + (jb * 2 + (kh ^ 1)) * 1024 + lnc;
            const unsigned oo = (unsigned)(((size_t)dir * M + rowbase) * 1024) + h * 128 + vh * 64 + jb * 32 + c32;
#pragma unroll
            for (int r = 0; r < 16; ++r) { const int i = kh * 32 + (r & 3) + 8 * (r >> 2) + 4 * hi; const float v = oown[r] + slab[r * 64];
                ODIR[oo + (unsigned)HG_TOK(c - 2, i) * 1024u] = (u16)(cvtpk(v, v) & 0xffffu); }
            }
            __syncthreads();
            if (c >= 1 && c <= NC) {
#pragma unroll
            for (int r = 0; r < 16; ++r) { oown[r] = 0.f; ooth[r] = 0.f; }
            const int rown = kh * 32 + c32, roth = (1 - kh) * 32 + c32, c32o = c32, trbo = trb;
#define HG_SB() __builtin_amdgcn_sched_barrier(0)
            bf16x8 qa[2][2][2], sbf[2][2];
            { f32x4 em[2][4];
#pragma unroll
              for (int t2 = 0; t2 < 2; ++t2) {
#pragma unroll
                for (int g = 0; g < 4; ++g) em[t2][g] = *(const HG_LAS f32x4*)(cs + O_EM + ((2 * kh + t2) * 32 + 8 * g + 4 * hi) * 4);
#pragma unroll
                for (int sp = 0; sp < 2; ++sp) { const int ch = (2 * kh + t2) * 4 + 2 * sp; qa[t2][sp][0] = perm_frag(cs + O_QS, rown, ch, hi); qa[t2][sp][1] = perm_frag(cs + O_QS, roth, ch, hi); } }
              HG_SB();
#pragma unroll
              for (int t2 = 0; t2 < 2; ++t2) { f32x16 Sx = t2 ? S1 : S0;
#pragma unroll
                for (int g = 0; g < 4; ++g) { Sx[4 * g] *= em[t2][g][0]; Sx[4 * g + 1] *= em[t2][g][1]; Sx[4 * g + 2] *= em[t2][g][2]; Sx[4 * g + 3] *= em[t2][g][3]; }
                sbf[t2][0] = pk8(Sx, 0); sbf[t2][1] = pk8(Sx, 8); } }
            HG_SB();
            bf16x8 dk[8], dq[8];
            const HG_LAS unsigned char* dksp = cs + O_KS + rown * 256; const HG_LAS unsigned char* dqsp = cs + O_QS + rown * 256;
#pragma unroll
            for (int st = 0; st < 4; ++st) { const int ch = 2 * st + hi; dk[st] = *(const HG_LAS bf16x8*)(dksp + ((ch ^ (rown & 15)) << 4)); dq[st] = *(const HG_LAS bf16x8*)(dqsp + ((ch ^ (rown & 15)) << 4)); }
            HG_SB();
#pragma unroll
            for (int t2 = 0; t2 < 2; ++t2)
#pragma unroll
                for (int sp = 0; sp < 2; ++sp) {
                    oown = __builtin_amdgcn_mfma_f32_32x32x16_bf16(qa[t2][sp][0], sbf[t2][sp], oown, 0, 0, 0);
                    ooth = __builtin_amdgcn_mfma_f32_32x32x16_bf16(qa[t2][sp][1], sbf[t2][sp], ooth, 0, 0, 0); }
            HG_SB();
#pragma unroll
            for (int st = 4; st < 8; ++st) { const int ch = 2 * st + hi; dk[st] = *(const HG_LAS bf16x8*)(dksp + ((ch ^ (rown & 15)) << 4)); dq[st] = *(const HG_LAS bf16x8*)(dqsp + ((ch ^ (rown & 15)) << 4)); }
            HG_SB();
            f32x16 X;
#pragma unroll
            for (int r = 0; r < 16; ++r) X[r] = 0.f;
#pragma unroll
            for (int st = 0; st < 4; ++st) X = __builtin_amdgcn_mfma_f32_32x32x16_bf16(dk[st], dq[st], X, 0, 0, 0);
            HG_SB();
            bf16x8 vf[4], ok[4], oq[4];
#pragma unroll
            for (int ks = 0; ks < 4; ++ks) { const HG_LAS unsigned char* vp = cs + O_V + (jb * 4 + ks) * 1024 + trbo; vf[ks] = cat8(vtr(vp), vtr(vp + 512)); }
            { const int rs = c32o, ri = 32 + c32o; const HG_LAS unsigned char* ksp = cs + O_KS + rs * 256; const HG_LAS unsigned char* qsp = cs + O_QS + ri * 256;
#pragma unroll
              for (int st = 0; st < 4; ++st) { const int ch = 2 * (4 * kh + st) + hi; ok[st] = *(const HG_LAS bf16x8*)(ksp + ((ch ^ (rs & 15)) << 4)); oq[st] = *(const HG_LAS bf16x8*)(qsp + ((ch ^ (ri & 15)) << 4)); } }
            HG_SB();
#pragma unroll
            for (int st = 4; st < 8; ++st) X = __builtin_amdgcn_mfma_f32_32x32x16_bf16(dk[st], dq[st], X, 0, 0, 0);
#pragma unroll
            for (int r = 0; r < 16; ++r) { const int sl = (r & 3) + 8 * (r >> 2) + 4 * hi; X[r] = (sl <= c32) ? X[r] : 0.f; }
            if (kh) { oown = __builtin_amdgcn_mfma_f32_32x32x16_bf16(pk8(X, 0), vf[2], oown, 0, 0, 0); oown = __builtin_amdgcn_mfma_f32_32x32x16_bf16(pk8(X, 8), vf[3], oown, 0, 0, 0); }
            else    { oown = __builtin_amdgcn_mfma_f32_32x32x16_bf16(pk8(X, 0), vf[0], oown, 0, 0, 0); oown = __builtin_amdgcn_mfma_f32_32x32x16_bf16(pk8(X, 8), vf[1], oown, 0, 0, 0); }
            HG_SB();
            f32x4 dl0[4]; bf16x8 kd0[4];
#pragma unroll
            for (int g = 0; g < 4; ++g) dl0[g] = *(const HG_LAS f32x4*)(cs + O_DL + ((2 * kh) * 32 + 8 * g + 4 * hi) * 4);
#pragma unroll
            for (int ks = 0; ks < 4; ++ks) { const HG_LAS unsigned char* kp = cs + O_KD + ((2 * kh) * 4 + ks) * 1024 + trbo; kd0[ks] = cat8(vtr(kp), vtr(kp + 512)); }
            HG_SB();
#pragma unroll
            for (int r = 0; r < 16; ++r) X[r] = 0.f;
#pragma unroll
            for (int st = 0; st < 4; ++st) X = __builtin_amdgcn_mfma_f32_32x32x16_bf16(ok[st], oq[st], X, 0, 0, 0);
            if (kh) { oown = __builtin_amdgcn_mfma_f32_32x32x16_bf16(pk8(X, 0), vf[0], oown, 0, 0, 0); oown = __builtin_amdgcn_mfma_f32_32x32x16_bf16(pk8(X, 8), vf[1], oown, 0, 0, 0); }
            else    { ooth = __builtin_amdgcn_mfma_f32_32x32x16_bf16(pk8(X, 0), vf[0], ooth, 0, 0, 0); ooth = __builtin_amdgcn_mfma_f32_32x32x16_bf16(pk8(X, 8), vf[1], ooth, 0, 0, 0); }
            HG_SB();
            f32x4 dl1[4]; bf16x8 kd1[4];
#pragma unroll
            for (int g = 0; g < 4; ++g) dl1[g] = *(const HG_LAS f32x4*)(cs + O_DL + ((2 * kh + 1) * 32 + 8 * g + 4 * hi) * 4);
#pragma unroll
            for (int ks = 0; ks < 4; ++ks) { const HG_LAS unsigned char* kp = cs + O_KD + ((2 * kh + 1) * 4 + ks) * 1024 + trbo; kd1[ks] = cat8(vtr(kp), vtr(kp + 512)); }
            HG_SB();
#pragma unroll
            for (int g = 0; g < 4; ++g) { S0[4 * g] *= dl0[g][0]; S0[4 * g + 1] *= dl0[g][1]; S0[4 * g + 2] *= dl0[g][2]; S0[4 * g + 3] *= dl0[g][3]; }
#pragma unroll
            for (int ks = 0; ks < 4; ++ks) S0 = __builtin_amdgcn_mfma_f32_32x32x16_bf16(kd0[ks], vf[ks], S0, 0, 0, 0);
#pragma unroll
            for (int g = 0; g < 4; ++g) { S1[4 * g] *= dl1[g][0]; S1[4 * g + 1] *= dl1[g][1]; S1[4 * g + 2] *= dl1[g][2]; S1[4 * g + 3] *= dl1[g][3]; }
#pragma unroll
            for (int ks = 0; ks < 4; ++ks) S1 = __builtin_amdgcn_mfma_f32_32x32x16_bf16(kd1[ks], vf[ks], S1, 0, 0, 0);
#undef HG_SB
            { HG_LAS float* slab = (HG_LAS float*)(lds + L_SLAB) + (jb * 2 + kh) * 1024 + lnc;
#pragma unroll
              for (int r = 0; r < 16; ++r) slab[r * 64] = ooth[r]; }
            }
            __syncthreads();
        }
    }
#undef HG_TOK
#undef HG_LOAD
#undef S0
#undef S1
#undef oown
#undef ooth
#undef FU
#undef UF
}
}

namespace at {
typedef short bf16x8 __attribute__((ext_vector_type(8)));
typedef short s16x4 __attribute__((ext_vector_type(4)));
typedef short v4i16_t __attribute__((ext_vector_type(4)));
typedef float f32x16 __attribute__((ext_vector_type(16)));
typedef float f32x4 __attribute__((ext_vector_type(4)));
typedef unsigned u32x4 __attribute__((ext_vector_type(4)));
#define AT_LAS __attribute__((address_space(3)))
constexpr int L_K = 0, L_V = 16384, L_WS = 65536, L_LUT = 66560, L_END = 67584;
constexpr float THR = 8.0f;
__device__ __forceinline__ unsigned cvtpk(float lo, float hi) { typedef float f2_ __attribute__((ext_vector_type(2))); typedef __bf16 b2_ __attribute__((ext_vector_type(2))); const f2_ v = {lo, hi}; return __builtin_bit_cast(unsigned, __builtin_convertvector(v, b2_)); }
__device__ __forceinline__ s16x4 vtr(const AT_LAS unsigned char* p) { return __builtin_bit_cast(s16x4, __builtin_amdgcn_ds_read_tr16_b64_v4i16((AT_LAS v4i16_t*)p)); }
__device__ __forceinline__ bf16x8 pk8(const f32x16& x, int b) {
    u32x4 w; w.x = cvtpk(x[b], x[b + 1]); w.y = cvtpk(x[b + 2], x[b + 3]); w.z = cvtpk(x[b + 4], x[b + 5]); w.w = cvtpk(x[b + 6], x[b + 7]); return __builtin_bit_cast(bf16x8, w); }
__device__ __forceinline__ bf16x8 cat8(s16x4 lo, s16x4 hi) { return (bf16x8){lo[0], lo[1], lo[2], lo[3], hi[0], hi[1], hi[2], hi[3]}; }
__device__ __forceinline__ float max3f(float a, float b, float c) { float r; asm("v_max3_f32 %0, %1, %2, %3" : "=v"(r) : "v"(a), "v"(b), "v"(c)); return r; }
__device__ __forceinline__ int rel_bucket(int rel) {
    const int n = rel < 0 ? -rel : rel; int bk;
    if (n < 8) bk = n; else if (n < 12) bk = 8; else if (n < 16) bk = 9; else if (n < 23) bk = 10; else if (n < 32) bk = 11;
    else if (n < 46) bk = 12; else if (n < 64) bk = 13; else if (n < 91) bk = 14; else bk = 15;
    return bk + (rel > 0 ? 16 : 0);
}

__device__ __forceinline__ void attn_unit(AT_LAS unsigned char* lds, const u16* __restrict__ PROJ, const float* __restrict__ relb, float* O1, u16* __restrict__ CAT, const float* __restrict__ subw,
                                          float lam, int b, int h, int qb, int mp, int tid) {
    const int lane = tid & 63, w = __builtin_amdgcn_readfirstlane(tid >> 6), hi = lane >> 5, c32 = lane & 31;
    const size_t rowbase = (size_t)b * SEQ;
    const int q0w = qb * 256 + w * 32;
    AT_LAS float* wsf = (AT_LAS float*)(lds + L_WS) + w * 32;
    AT_LAS float* lut = (AT_LAS float*)(lds + L_LUT);
    if (tid < 183) lut[tid] = relb[rel_bucket(tid - 91) * 8 + h] * 1.4426950408889634f;
    const float bias_neg = relb[15 * 8 + h] * 1.4426950408889634f, bias_pos = relb[31 * 8 + h] * 1.4426950408889634f;
    bf16x8 qf[4];
    { const unsigned qo = (unsigned)((rowbase + q0w + c32) * 8192 + 5120 + h * 128 + mp * 64 + 8 * hi);
#pragma unroll
      for (int st = 0; st < 4; ++st) qf[st] = *(const bf16x8*)(PROJ + (qo + 16 * st)); }
    f32x16 o[4];
#pragma unroll
    for (int d = 0; d < 4; ++d)
#pragma unroll
        for (int r = 0; r < 16; ++r) o[d][r] = 0.f;
    float mhat = 0.f, l = 0.f;
    const int krow = 8 * w + (lane >> 3), kch = (lane & 7) ^ ((krow >> 1) & 7);
    const unsigned kgo = (unsigned)((rowbase + krow) * 8192 + 6144 + h * 128 + mp * 64 + 8 * kch);
    const int vrow = ((2 * w) & 3) * 16 + (lane >> 2);
    const unsigned vgo = (unsigned)((rowbase + vrow) * 8192 + 7168 + h * 128 + (w >> 1) * 32 + (lane & 3) * 8);
    const int trb = (4 * hi + ((lane & 15) >> 2)) * 64 + ((lane >> 4) & 1) * 32 + (lane & 3) * 8;
#define AT_STAGE(t_, ks_, vs_) do { const unsigned go_ = (unsigned)(t_) * 64u * 8192u; \
        __builtin_amdgcn_global_load_lds((const unsigned*)(PROJ + (kgo + go_)), (AT_LAS unsigned*)(lds + L_K + (ks_) * 8192 + w * 1024), 16, 0, 0); \
        __builtin_amdgcn_global_load_lds((const unsigned*)(PROJ + (vgo + go_)), (AT_LAS unsigned*)(lds + L_V + (vs_) * 16384 + (2 * w) * 1024), 16, 0, 0); \
        __builtin_amdgcn_global_load_lds((const unsigned*)(PROJ + (vgo + go_ + 16u * 8192u)), (AT_LAS unsigned*)(lds + L_V + (vs_) * 16384 + (2 * w + 1) * 1024), 16, 0, 0); } while (0)
    AT_STAGE(0, 0, 0);
    asm volatile("s_waitcnt vmcnt(0)" ::: "memory");
    __syncthreads();
    constexpr int NT = SEQ / 64;
    const bool late = w >= 4;
    bf16x8 pa0, pa1, pa2, pa3, va_[4], vb_[4]; f32x16 p0, p1;
#define AT_VF(dst, VB, d) do { const AT_LAS unsigned char* vp_ = (VB) + (d) * 4096 + trb; \
        _Pragma("unroll") for (int k_ = 0; k_ < 4; ++k_) dst[k_] = cat8(vtr(vp_ + k_ * 1024), vtr(vp_ + k_ * 1024 + 512)); } while (0)
#define AT_MM(d, vf) do { o[d] = __builtin_amdgcn_mfma_f32_32x32x16_bf16(pa0, vf[0], o[d], 0, 0, 0); o[d] = __builtin_amdgcn_mfma_f32_32x32x16_bf16(pa1, vf[1], o[d], 0, 0, 0); \
        o[d] = __builtin_amdgcn_mfma_f32_32x32x16_bf16(pa2, vf[2], o[d], 0, 0, 0); o[d] = __builtin_amdgcn_mfma_f32_32x32x16_bf16(pa3, vf[3], o[d], 0, 0, 0); } while (0)
#define AT_SB() __builtin_amdgcn_sched_barrier(0)
#define AT_VPRE(VB) do { AT_SB(); AT_VF(va_, VB, 0); AT_VF(vb_, VB, 1); AT_SB(); } while (0)
#define AT_PV(VB) do { AT_SB(); AT_MM(0, va_); AT_SB(); AT_VF(va_, VB, 2); AT_SB(); AT_MM(1, vb_); AT_SB(); AT_VF(vb_, VB, 3); AT_SB(); AT_MM(2, va_); AT_SB(); AT_MM(3, vb_); AT_SB(); } while (0)
#define AT_QK(tt) do { const AT_LAS unsigned char* Kb = lds + L_K + ((tt) & 1) * 8192; \
        const int kv0_ = 64 * (tt), far_ = (kv0_ - (q0w + 31) >= 91) ? 1 : ((kv0_ + 63 - q0w <= -91) ? -1 : 0); \
        const float ini = (far_ > 0 ? bias_pos : (far_ < 0 ? bias_neg : 0.f)) - mhat; \
        _Pragma("unroll") for (int r = 0; r < 16; ++r) { p0[r] = ini; p1[r] = ini; } \
        const int r0 = c32, r1 = 32 + c32; bf16x8 ka[4], kb[4]; \
        _Pragma("unroll") for (int st = 0; st < 4; ++st) { const int ch = 2 * st + hi; \
            ka[st] = *(const AT_LAS bf16x8*)(Kb + r0 * 128 + ((ch ^ ((r0 >> 1) & 7)) << 4)); kb[st] = *(const AT_LAS bf16x8*)(Kb + r1 * 128 + ((ch ^ ((r1 >> 1) & 7)) << 4)); } \
        _Pragma("unroll") for (int st = 0; st < 4; ++st) { p0 = __builtin_amdgcn_mfma_f32_32x32x16_bf16(ka[st], qf[st], p0, 0, 0, 0); p1 = __builtin_amdgcn_mfma_f32_32x32x16_bf16(kb[st], qf[st], p1, 0, 0, 0); } } while (0)
#define AT_SM(tt) do { const int kv0_ = 64 * (tt); const bool band_ = !(kv0_ - (q0w + 31) >= 91) && !(kv0_ + 63 - q0w <= -91); \
        if (band_) { const int rb = kv0_ + 4 * hi - (q0w + c32) + 91; \
            _Pragma("unroll") for (int r = 0; r < 16; ++r) { const int i0 = rb + (r & 3) + 8 * (r >> 2), i1 = i0 + 32; \
                p0[r] += lut[i0 < 0 ? 0 : (i0 > 182 ? 182 : i0)]; p1[r] += lut[i1 < 0 ? 0 : (i1 > 182 ? 182 : i1)]; } } \
        float rm, rm2;                                             \
        rm = max3f(p0[0], p0[1], p1[0]); rm2 = max3f(p0[2], p0[3], p1[1]); rm = max3f(rm, p1[2], p1[3]); \
        _Pragma("unroll") for (int r = 4; r < 16; r += 4) { rm = max3f(rm, p0[r], p0[r + 1]); rm2 = max3f(rm2, p0[r + 2], p0[r + 3]); rm = max3f(rm, p1[r], p1[r + 1]); rm2 = max3f(rm2, p1[r + 2], p1[r + 3]); } \
        rm = __builtin_fmaxf(rm, rm2); \
        { const auto rr = __builtin_amdgcn_permlane32_swap(__float_as_uint(rm), __float_as_uint(rm), false, false); rm = __builtin_fmaxf(__uint_as_float(rr[0]), __uint_as_float(rr[1])); } \
        if ((tt) == 0 || __any(rm > THR)) { \
            const float dl = ((tt) == 0) ? rm : __builtin_fmaxf(rm, 0.f); \
            mhat += dl; \
            _Pragma("unroll") for (int r = 0; r < 16; ++r) { p0[r] -= dl; p1[r] -= dl; } \
            if ((tt) > 0) { const float f = __builtin_amdgcn_exp2f(-dl); l *= f; \
                if (hi == 0) wsf[c32] = f; \
                asm volatile("s_waitcnt lgkmcnt(0)" ::: "memory"); \
                _Pragma("unroll") for (int g = 0; g < 4; ++g) { const f32x4 fv = *(const AT_LAS f32x4*)(wsf + 8 * g + 4 * hi); \
                    _Pragma("unroll") for (int d = 0; d < 4; ++d) { o[d][4 * g] *= fv[0]; o[d][4 * g + 1] *= fv[1]; o[d][4 * g + 2] *= fv[2]; o[d][4 * g + 3] *= fv[3]; } } } } \
        float ls = 0.f; \
        _Pragma("unroll") for (int r = 0; r < 16; ++r) { p0[r] = __builtin_amdgcn_exp2f(p0[r]); p1[r] = __builtin_amdgcn_exp2f(p1[r]); ls += p0[r] + p1[r]; } \
        l += ls; \
        pa0 = pk8(p0, 0); pa1 = pk8(p0, 8); pa2 = pk8(p1, 0); pa3 = pk8(p1, 8); } while (0)
#define AT_END() do { vprev = vslot; vslot = (vslot == 2) ? 0 : vslot + 1; \
        asm volatile("s_waitcnt vmcnt(0)" ::: "memory");            \
        __syncthreads(); } while (0)
    int vslot = 0, vprev = 0;
    if (!late) {
        for (int t = 0; t < NT; ++t) {
            if (t + 1 < NT) { AT_STAGE(t + 1, (t + 1) & 1, (vslot == 2) ? 0 : vslot + 1); }
            AT_QK(t); AT_VPRE(lds + L_V + vslot * 16384); AT_SM(t); AT_PV(lds + L_V + vslot * 16384);
            AT_END();
        }
    } else {
        for (int t = 0; t < NT; ++t) {
            if (t + 1 < NT) { AT_STAGE(t + 1, (t + 1) & 1, (vslot == 2) ? 0 : vslot + 1); }
            if (t > 0) { AT_PV(lds + L_V + vprev * 16384); }
            AT_QK(t); AT_SM(t); AT_VPRE(lds + L_V + vslot * 16384);
            AT_END();
        }
        AT_PV(lds + L_V + vprev * 16384);
    }
#undef AT_QK
#undef AT_SM
#undef AT_END
#undef AT_VPRE
#undef AT_PV
#undef AT_VPRE
#undef AT_VF
#undef AT_SB
#undef AT_MM
#undef AT_STAGE
    l += __shfl_xor(l, 32);
    if (hi == 0) wsf[c32] = __builtin_amdgcn_rcpf(l);
    asm volatile("s_waitcnt lgkmcnt(0)" ::: "memory");
    float rl[16];
#pragma unroll
    for (int g = 0; g < 4; ++g) { const f32x4 fv = *(const AT_LAS f32x4*)(wsf + 8 * g + 4 * hi); rl[4 * g] = fv[0]; rl[4 * g + 1] = fv[1]; rl[4 * g + 2] = fv[2]; rl[4 * g + 3] = fv[3]; }
    unsigned oo = (unsigned)((rowbase + q0w + 4 * hi) * 1024 + h * 128 + c32);
    if (mp == 0) {
#pragma unroll
        for (int r = 0; r < 16; ++r) { unsigned ro = oo + (unsigned)(((r & 3) + 8 * (r >> 2)) * 1024); asm volatile("" : "+v"(ro));
#pragma unroll
            for (int d = 0; d < 4; ++d) O1[ro + d * 32] = o[d][r] * rl[r]; }
    } else {
        float sw[4];
#pragma unroll
        for (int d = 0; d < 4; ++d) sw[d] = subw[d * 32 + c32] * 0.8f;
        const unsigned co = (unsigned)((rowbase + q0w + 4 * hi) * 2048 + 1024 + h * 128 + c32);
#pragma unroll
        for (int r = 0; r < 16; ++r) { unsigned ro = oo + (unsigned)(((r & 3) + 8 * (r >> 2)) * 1024), rc = co + (unsigned)(((r & 3) + 8 * (r >> 2)) * 2048); asm volatile("" : "+v"(ro), "+v"(rc));
            float x[4]; float ss = 0.f;
#pragma unroll
            for (int d = 0; d < 4; ++d) { x[d] = O1[ro + d * 32] - lam * (o[d][r] * rl[r]); ss += x[d] * x[d]; }
            ss += __shfl_xor(ss, 1); ss += __shfl_xor(ss, 2); ss += __shfl_xor(ss, 4); ss += __shfl_xor(ss, 8); ss += __shfl_xor(ss, 16);
            const float rr = __builtin_amdgcn_rsqf(ss * (1.0f / 128.0f) + 1e-6f);
#pragma unroll
            for (int d = 0; d < 4; ++d) CAT[rc + d * 32] = (u16)(cvtpk(x[d] * rr * sw[d], 0.f) & 0xffffu); }
    }
}
}

__device__ __forceinline__ void p0_item64(const float* W, int K, int N, const float* ksc, u16* WT, int k0, int n0, int drow0, int lane) {
    const int kg = lane >> 4, n4 = (lane & 15) * 4;
    const float* src = W + (size_t)(k0 + 8 * kg) * N + n0 + n4;
    f32x4 v[2][8];
#pragma unroll
    for (int r = 0; r < 2; ++r)
#pragma unroll
        for (int i = 0; i < 8; ++i) v[r][i] = __builtin_nontemporal_load((const f32x4*)(src + (size_t)(32 * r + i) * N));
    if (ksc) {
#pragma unroll
        for (int r = 0; r < 2; ++r) { const f32x4 s0 = *(const f32x4*)(ksc + k0 + 32 * r + 8 * kg), s1 = *(const f32x4*)(ksc + k0 + 32 * r + 8 * kg + 4);
#pragma unroll
            for (int i = 0; i < 4; ++i) { v[r][i] = v[r][i] * s0[i]; v[r][4 + i] = v[r][4 + i] * s1[i]; } }
    }
#pragma unroll
    for (int jn = 0; jn < 4; ++jn) { u16* dst = WT + (size_t)(drow0 + n4 + jn) * K + k0 + 8 * kg;
#pragma unroll
        for (int r = 0; r < 2; ++r) { v4u o; o.x = pk2(v[r][0][jn], v[r][1][jn]); o.y = pk2(v[r][2][jn], v[r][3][jn]); o.z = pk2(v[r][4][jn], v[r][5][jn]); o.w = pk2(v[r][6][jn], v[r][7][jn]);
            *(v4u*)(dst + 32 * r) = o; } }
}
__device__ __forceinline__ void p0_strip(LAS float* smax, const float* W, int N, const float* ksc, float* cmax, unsigned char* WT, int n0, int drow0, int tid) {
    const int lane = tid & 63, w = tid >> 6, g = lane & 7, kk = lane >> 3, kb = 256 * w + 32 * kk;
    const float* src = W + (size_t)kb * N + n0 + 4 * g;
    f32x4 v[32];
#pragma unroll
    for (int i = 0; i < 32; ++i) v[i] = __builtin_nontemporal_load((const f32x4*)(src + (size_t)i * N));
    if (ksc) {
#pragma unroll
        for (int i4 = 0; i4 < 8; ++i4) { const f32x4 sc = *(const f32x4*)(ksc + kb + 4 * i4);
#pragma unroll
            for (int e = 0; e < 4; ++e) v[4 * i4 + e] = v[4 * i4 + e] * sc[e]; } }
    f32x4 am = {0.f, 0.f, 0.f, 0.f};
#pragma unroll
    for (int i = 0; i < 32; ++i)
#pragma unroll
        for (int jn = 0; jn < 4; ++jn) am[jn] = fmaxf(am[jn], fabsf(v[i][jn]));
#pragma unroll
    for (int jn = 0; jn < 4; ++jn) { float a = am[jn]; a = fmaxf(a, __shfl_xor(a, 8)); a = fmaxf(a, __shfl_xor(a, 16)); a = fmaxf(a, __shfl_xor(a, 32)); am[jn] = a; }
    if (kk == 0) *(LAS f32x4*)(smax + w * 32 + 4 * g) = am;
    __syncthreads();
#pragma unroll
    for (int ww = 0; ww < 8; ++ww) { const f32x4 o = *(const LAS f32x4*)(smax + ww * 32 + 4 * g);
#pragma unroll
        for (int jn = 0; jn < 4; ++jn) am[jn] = fmaxf(am[jn], o[jn]); }
    if (w == 0 && kk == 0) *(f32x4*)(cmax + drow0 + 4 * g) = am;
#pragma unroll
    for (int jn = 0; jn < 4; ++jn) { const float inv = inv127(am[jn]); unsigned char* dst = WT + (size_t)(drow0 + 4 * g + jn) * 2048 + kb;
#pragma unroll
        for (int h = 0; h < 2; ++h) { v4u o;
            o.x = pack4_i8(v[16 * h + 0][jn], v[16 * h + 1][jn], v[16 * h + 2][jn], v[16 * h + 3][jn], inv); o.y = pack4_i8(v[16 * h + 4][jn], v[16 * h + 5][jn], v[16 * h + 6][jn], v[16 * h + 7][jn], inv);
            o.z = pack4_i8(v[16 * h + 8][jn], v[16 * h + 9][jn], v[16 * h + 10][jn], v[16 * h + 11][jn], inv); o.w = pack4_i8(v[16 * h + 12][jn], v[16 * h + 13][jn], v[16 * h + 14][jn], v[16 * h + 15][jn], inv);
            *(v4u*)(dst + 16 * h) = o; } }
}
__device__ __forceinline__ void p0_absmax64(const float* W, int N, const float* ksc, float* cmax, int k0, int n0, int drow0, int lane) {
    const int kg = lane >> 4, n4 = (lane & 15) * 4;
    const float* src = W + (size_t)(k0 + 8 * kg) * N + n0 + n4;
    f32x4 v[2][8];
#pragma unroll
    for (int r = 0; r < 2; ++r)
#pragma unroll
        for (int i = 0; i < 8; ++i) v[r][i] = *(const f32x4*)(src + (size_t)(32 * r + i) * N);
    if (ksc) {
#pragma unroll
        for (int r = 0; r < 2; ++r) { const f32x4 s0 = *(const f32x4*)(ksc + k0 + 32 * r + 8 * kg), s1 = *(const f32x4*)(ksc + k0 + 32 * r + 8 * kg + 4);
#pragma unroll
            for (int i = 0; i < 4; ++i) { v[r][i] = v[r][i] * s0[i]; v[r][4 + i] = v[r][4 + i] * s1[i]; } }
    }
#pragma unroll
    for (int jn = 0; jn < 4; ++jn) { float a = 0.f;
#pragma unroll
        for (int r = 0; r < 2; ++r)
#pragma unroll
            for (int i = 0; i < 8; ++i) a = fmaxf(a, fabsf(v[r][i][jn]));
        a = fmaxf(a, __shfl_xor(a, 16)); a = fmaxf(a, __shfl_xor(a, 32));
        if (kg == 0) atomicMax((unsigned*)(cmax + drow0 + n4 + jn), __float_as_uint(a)); }
}
__device__ __forceinline__ void p0_quant64(const float* W, int K, int N, const float* cmax, unsigned char* WT, int k0, int n0, int drow0, int lane) {
    const int kg = lane >> 4, n4 = (lane & 15) * 4;
    const float* src = W + (size_t)(k0 + 16 * kg) * N + n0 + n4;
    f32x4 v[16];
#pragma unroll
    for (int i = 0; i < 16; ++i) v[i] = __builtin_nontemporal_load((const f32x4*)(src + (size_t)i * N));
    const f32x4 cm = *(const f32x4*)(cmax + drow0 + n4);
#pragma unroll
    for (int jn = 0; jn < 4; ++jn) { const float inv = inv127(cm[jn]); v4u o;
        o.x = pack4_i8(v[0][jn], v[1][jn], v[2][jn], v[3][jn], inv); o.y = pack4_i8(v[4][jn], v[5][jn], v[6][jn], v[7][jn], inv);
        o.z = pack4_i8(v[8][jn], v[9][jn], v[10][jn], v[11][jn], inv); o.w = pack4_i8(v[12][jn], v[13][jn], v[14][jn], v[15][jn], inv);
        *(v4u*)(WT + (size_t)(drow0 + n4 + jn) * K + k0 + 16 * kg) = o; }
}
__device__ __forceinline__ void rms_row_to_bf16(const float* xrow, const float* w, u16* orow, int lane) {
    const f32x4* xr = (const f32x4*)xrow + lane;
    f32x4 v[8]; float s = 0.f;
#pragma unroll
    for (int j = 0; j < 8; ++j) { v[j] = xr[64 * j]; s += (v[j].x * v[j].x + v[j].y * v[j].y) + (v[j].z * v[j].z + v[j].w * v[j].w); }
    const float r = __builtin_amdgcn_rsqf(wave_sum(s) * (1.0f / DM) + EPS);
    const f32x4* wr = (const f32x4*)w + lane;
    uint2* o = (uint2*)orow + lane;
#pragma unroll
    for (int j = 0; j < 8; ++j) { const f32x4 ww = wr[64 * j]; uint2 p; p.x = pk2(v[j].x * r * ww.x, v[j].y * r * ww.y); p.y = pk2(v[j].z * r * ww.z, v[j].w * r * ww.w); o[64 * j] = p; }
}
__device__ __forceinline__ void rms_row_from_bf16(const u16* xrow, const float* w, float* orow, int lane) {
    const v4u* xr = (const v4u*)xrow + lane;
    v4u v[4]; float s = 0.f;
#pragma unroll
    for (int j = 0; j < 4; ++j) { v[j] = __builtin_nontemporal_load(xr + 64 * j);
#pragma unroll
        for (int e = 0; e < 4; ++e) { const float a = __uint_as_float(v[j][e] << 16), b = __uint_as_float(v[j][e] & 0xffff0000u); s += a * a + b * b; } }
    const float r = __builtin_amdgcn_rsqf(wave_sum(s) * (1.0f / DM) + EPS);
#pragma unroll
    for (int j = 0; j < 4; ++j) { const int c = (64 * j + lane) * 8; const f32x4 w0 = *(const f32x4*)(w + c), w1 = *(const f32x4*)(w + c + 4);
        f32x4 o0, o1;
        o0[0] = __uint_as_float(v[j][0] << 16) * r * w0[0]; o0[1] = __uint_as_float(v[j][0] & 0xffff0000u) * r * w0[1]; o0[2] = __uint_as_float(v[j][1] << 16) * r * w0[2]; o0[3] = __uint_as_float(v[j][1] & 0xffff0000u) * r * w0[3];
        o1[0] = __uint_as_float(v[j][2] << 16) * r * w1[0]; o1[1] = __uint_as_float(v[j][2] & 0xffff0000u) * r * w1[1]; o1[2] = __uint_as_float(v[j][3] << 16) * r * w1[2]; o1[3] = __uint_as_float(v[j][3] & 0xffff0000u) * r * w1[3];
        *(f32x4*)(orow + c) = o0; *(f32x4*)(orow + c + 4) = o1; }
}

static_assert(hg::L_END <= LDSCTL_OFF && at::L_END <= LDSCTL_OFF, "phase scratch below the LDS control words");
struct Args { const float* in[17]; float* out; unsigned char* ws; int ph_lo, ph_hi, li, pad; };
enum { PH_PRO = 0, PH_INPROJ = 1, PH_MIX = 2, PH_HGFIN = 3, PH_OUTPROJ = 4, PH_QUANT = 5, PH_GATEUP = 6, PH_DOWN = 7, PH_FINAL = 8, PH_N = 9 };

__global__ void __launch_bounds__(NWAVES * 64, 2) mk_fwd(Args args) {
    extern __shared__ __attribute__((aligned(16))) unsigned char lds_raw[];
    LAS unsigned char* lds = (LAS unsigned char*)lds_raw;
    volatile LAS unsigned* MISC = (volatile LAS unsigned*)(lds + MISC_OFF);
    const int tid = threadIdx.x, lane = tid & 63, wave = __builtin_amdgcn_readfirstlane(tid >> 6);
    const int G = gridDim.x; const int bx = blockIdx.x; const int vcu = (G % 8 == 0) ? (bx % 8) * (G / 8) + bx / 8 : bx;
    unsigned char* ws = args.ws;
    gu32* ctl = (gu32*)(ws + WS_CTL);
    float* rs2 = (float*)(ws + WS_PART); float* sa1 = (float*)(ws + WS_PART + 65536);
    float* cmax_gu = (float*)(ws + WS_CTL + CMAX_GU_OFF); float* cmax_in = (float*)(ws + WS_CTL + CMAX_IN_OFF);
    unsigned char* H1Q = ws + WS_WIN;
    u16* WinT = (u16*)(ws + WS_WIN); u16* WoT = (u16*)(ws + WS_WO); u16* WguT = (u16*)(ws + WS_WGU); u16* WdT = (u16*)(ws + WS_WD);
    u16* XN = (u16*)(ws + WS_XN); u16* BB = (u16*)(ws + WS_B); u16* PROJ = (u16*)(ws + WS_PROJ);
    for (int u = tid; u < (LDS_BYTES - LDSCTL_OFF) / 4; u += NWAVES * 64) ((LAS unsigned*)(lds + LDSCTL_OFF))[u] = 0u;
    __syncthreads();
    XcdBarrier bar = xcd_barrier_post((unsigned*)(ctl + CW_BAR) + args.li * XCD_BAR_WORDS, MISC + 8);
    const int lo = args.ph_lo, hi = args.ph_hi;
#define IN(k) (lo <= (k) && (k) < hi)
#define SEAM(k) do { if (IN(k) && (k) + 1 < hi) xcd_barrier(bar); } while (0)
    const int gw = vcu * NWAVES + wave, NGW = G * NWAVES;
    constexpr int PROBE_PH = -1, PROBE_BX = 0;
    unsigned long long pr_t0 = 0, pr_dt = 0, pr_c0 = 0;
#define PROBE_BEGIN(k) do { if (PROBE_PH == (k) && bx == PROBE_BX && tid == 0) pr_t0 = __builtin_amdgcn_s_memrealtime(); if (PROBE_PH == 100 + (k) && bx == PROBE_BX && tid == 0) pr_c0 = __builtin_amdgcn_s_memtime(); } while (0)
#define PROBE_END(k) do { if (PROBE_PH == (k) && bx == PROBE_BX && tid == 0) pr_dt = __builtin_amdgcn_s_memrealtime() - pr_t0; if (PROBE_PH == 100 + (k) && bx == PROBE_BX && tid == 0) pr_dt = (__builtin_amdgcn_s_memtime() - pr_c0) / 24; } while (0)

    PROBE_BEGIN(99);
    PROBE_BEGIN(PH_PRO);
    if (IN(PH_PRO)) {
        constexpr int NS_IN = INC / 32, NS_G = DFF / 32, NS = NS_IN + 2 * NS_G;
        { int par = 0;
          for (int st = vcu; st < NS; st += G, par ^= 1) { LAS float* smax = (LAS float*)(lds + RING_OFF) + par * 256;
              if (st < NS_IN) p0_strip(smax, args.in[2], INC, nullptr, cmax_in, (unsigned char*)WinT, 32 * st, 32 * st, tid);
              else { const int up = (st - NS_IN) >= NS_G ? 1 : 0, n0 = 32 * (st - NS_IN - up * NS_G);
                  p0_strip(smax, up ? args.in[14] : args.in[13], DFF, args.in[12], cmax_gu, (unsigned char*)WguT, n0, 256 * (n0 >> 7) + 128 * up + (n0 & 127), tid); } } }
        { int r0, cnt, rstep;
          { const int q = NS / G, rem = NS % G, B = (32 * NS + M + G - 1) / G;
            if (B - 32 * (q + 1) >= 0) { r0 = vcu * (B - 32 * q) - 32 * (vcu < rem ? vcu : rem); cnt = B - 32 * (q + (vcu < rem ? 1 : 0)); if (r0 > M) r0 = M; if (r0 + cnt > M || vcu == G - 1) cnt = M - r0; r0 += wave; rstep = NWAVES; cnt = r0 - wave + cnt; }
            else { r0 = gw; rstep = NGW; cnt = M; } }
          f32x4 wv[8];
#pragma unroll
          for (int j = 0; j < 8; ++j) wv[j] = *((const f32x4*)args.in[1] + lane + 64 * j);
          f32x4 cur[8], nxt[8];
          if (r0 < cnt) {
#pragma unroll
              for (int j = 0; j < 8; ++j) nxt[j] = __builtin_nontemporal_load((const f32x4*)(args.in[0] + (size_t)r0 * DM) + lane + 64 * j); }
          for (int m = r0; m < cnt; m += rstep) {
#pragma unroll
              for (int j = 0; j < 8; ++j) cur[j] = nxt[j];
              if (m + rstep < cnt) {
#pragma unroll
                  for (int j = 0; j < 8; ++j) nxt[j] = __builtin_nontemporal_load((const f32x4*)(args.in[0] + (size_t)(m + rstep) * DM) + lane + 64 * j); }
              float s = 0.f;
#pragma unroll
              for (int j = 0; j < 8; ++j) s += (cur[j].x * cur[j].x + cur[j].y * cur[j].y) + (cur[j].z * cur[j].z + cur[j].w * cur[j].w);
              const float r = __builtin_amdgcn_rsqf(wave_sum(s) * (1.0f / DM) + EPS);
              float am = 0.f;
#pragma unroll
              for (int j = 0; j < 8; ++j) { cur[j] = cur[j] * r * wv[j]; am = fmaxf(fmaxf(am, fmaxf(fabsf(cur[j].x), fabsf(cur[j].y))), fmaxf(fabsf(cur[j].z), fabsf(cur[j].w))); }
              am = wave_max(am); const float inv = inv127(am);
              unsigned* o = (unsigned*)((unsigned char*)XN + (size_t)m * DM) + lane;
#pragma unroll
              for (int j = 0; j < 8; ++j) o[64 * j] = pack4_i8(cur[j].x, cur[j].y, cur[j].z, cur[j].w, inv);
              if (lane == 0) sa1[m] = am * (1.0f / 127.0f); } }
    }
    SEAM(PH_PRO);
    PROBE_END(PH_PRO);
    PROBE_BEGIN(PH_INPROJ);
    if (IN(PH_INPROJ)) {
        pg8::Gemm g{XN, WinT, M, INC, DM / 2}; pg8::StaticOrder S; S.init(M, INC, G, bx);
        pg8::EpiInProj E{PROJ, args.in[3], sa1, cmax_in};
        pg8::gemm_phase<pg8::EpiInProj, pg8::StaticOrder, PG8_ALIGN, PG8_SP2, 2>(lds + RING_OFF, g, S, E);
    }
    PROBE_BEGIN(53);
    SEAM(PH_INPROJ);
    PROBE_END(53);
    PROBE_END(PH_INPROJ);
    PROBE_BEGIN(PH_MIX);
    if (IN(PH_MIX)) {
        PROBE_BEGIN(20);
        const bg::Ptrs BP{args.in[11], args.in[13], args.in[14], args.in[15], args.in[12], WoT, WguT, WdT, cmax_gu}; int bgj = 0;
        const int gcw = vcu * 4 + (wave & 3), NCW = G * 4;
        for (int item = vcu; item < 256; item += G) { hg::hgrn_item(lds + RING_OFF, PROJ, BB, item, tid, BP, bgj, gcw, NCW); __syncthreads(); }
        if (wave < 4) for (; bgj * NCW + gcw < bg::NBG; ++bgj) { bg::f32x4 v[8]; bg::load(BP, bgj * NCW + gcw, lane, v); bg::store(BP, bgj * NCW + gcw, lane, v); }
        PROBE_END(20);
        PROBE_BEGIN(21);
        { const float lam = __expf(wave_sum(args.in[5][lane] * args.in[6][lane])) - __expf(wave_sum(args.in[7][lane] * args.in[8][lane])) + 0.2f;
          for (int p = vcu; p < 512; p += G) { const int b = p >> 6, h = (p >> 3) & 7, qb = p & 7;
              at::attn_unit(lds + RING_OFF, PROJ, args.in[10], args.out, XN, args.in[9], lam, b, h, qb, 0, tid);
              at::attn_unit(lds + RING_OFF, PROJ, args.in[10], args.out, XN, args.in[9], lam, b, h, qb, 1, tid); } }
        PROBE_END(21);
    }
    PROBE_BEGIN(54);
    SEAM(PH_MIX);
    PROBE_END(54);
    PROBE_END(PH_MIX);
    PROBE_BEGIN(PH_HGFIN);
    if (IN(PH_HGFIN)) {
        const int l16 = lane & 15; f32x4 wa = *(const f32x4*)(args.in[4] + l16 * 8), wb = *(const f32x4*)(args.in[4] + l16 * 8 + 4);
        for (int p4 = gw; p4 < M * 2; p4 += NGW) { const int p = p4 * 4 + (lane >> 4), m = p >> 3, c = (p & 7) * 128 + l16 * 8;
            const v4u a = __builtin_nontemporal_load((const v4u*)(BB + (size_t)m * HGW + c)), bb = __builtin_nontemporal_load((const v4u*)(BB + ((size_t)M + m) * HGW + c)), g = __builtin_nontemporal_load((const v4u*)(PROJ + (size_t)m * INC + 4096 + c));
            float o[8]; float ss = 0.f;
#pragma unroll
            for (int e = 0; e < 4; ++e) { o[2 * e] = __uint_as_float(a[e] << 16) + __uint_as_float(bb[e] << 16); o[2 * e + 1] = __uint_as_float(a[e] & 0xffff0000u) + __uint_as_float(bb[e] & 0xffff0000u);
                ss += o[2 * e] * o[2 * e] + o[2 * e + 1] * o[2 * e + 1]; }
            ss += __shfl_xor(ss, 1); ss += __shfl_xor(ss, 2); ss += __shfl_xor(ss, 4); ss += __shfl_xor(ss, 8);
            const float r = __builtin_amdgcn_rsqf(ss * (1.0f / 128.0f) + EPS);
            v4u y;
#pragma unroll
            for (int e = 0; e < 4; ++e) { const float w0 = e < 2 ? wa[2 * e] : wb[2 * e - 4], w1 = e < 2 ? wa[2 * e + 1] : wb[2 * e - 3];
                y[e] = pk2(o[2 * e] * r * w0 * __uint_as_float(g[e] << 16), o[2 * e + 1] * r * w1 * __uint_as_float(g[e] & 0xffff0000u)); }
            *(v4u*)(XN + (size_t)m * DM + c) = y; }
    }
    PROBE_BEGIN(57);
    SEAM(PH_HGFIN);
    PROBE_END(57);
    PROBE_END(PH_HGFIN);
    PROBE_BEGIN(PH_OUTPROJ);
    if (IN(PH_OUTPROJ)) {
        pg8::Gemm g{XN, WoT, M, DM, DM}; pg8::StaticOrder S; S.init(M, DM, G, bx);
        pg8::EpiOutProj E{args.in[0], BB};
        pg8::gemm_phase<pg8::EpiOutProj, pg8::StaticOrder, PG8_ALIGN, PG8_SP2>(lds + RING_OFF, g, S, E);
    }
    PROBE_BEGIN(58);
    SEAM(PH_OUTPROJ);
    PROBE_END(58);
    PROBE_END(PH_OUTPROJ);
    PROBE_BEGIN(PH_QUANT);
    if (IN(PH_QUANT)) {
        v4u cur[4], nxt[4];
        if (gw < M) {
#pragma unroll
            for (int j = 0; j < 4; ++j) nxt[j] = *((const v4u*)(BB + (size_t)gw * DM) + lane + 64 * j); }
        for (int m = gw; m < M; m += NGW) {
#pragma unroll
            for (int j = 0; j < 4; ++j) cur[j] = nxt[j];
            if (m + NGW < M) {
#pragma unroll
                for (int j = 0; j < 4; ++j) nxt[j] = *((const v4u*)(BB + (size_t)(m + NGW) * DM) + lane + 64 * j); }
            float s = 0.f, am = 0.f;
#pragma unroll
            for (int j = 0; j < 4; ++j)
#pragma unroll
                for (int e = 0; e < 4; ++e) { const float a = __uint_as_float(cur[j][e] << 16), b = __uint_as_float(cur[j][e] & 0xffff0000u); s += a * a + b * b; am = fmaxf(am, fmaxf(fabsf(a), fabsf(b))); }
            s = wave_sum(s); am = wave_max(am);
            const float inv = inv127(am);
            uint2* o = (uint2*)(H1Q + (size_t)m * DM) + lane;
#pragma unroll
            for (int j = 0; j < 4; ++j) { uint2 w;
                w.x = pack4_i8(__uint_as_float(cur[j][0] << 16), __uint_as_float(cur[j][0] & 0xffff0000u), __uint_as_float(cur[j][1] << 16), __uint_as_float(cur[j][1] & 0xffff0000u), inv);
                w.y = pack4_i8(__uint_as_float(cur[j][2] << 16), __uint_as_float(cur[j][2] & 0xffff0000u), __uint_as_float(cur[j][3] << 16), __uint_as_float(cur[j][3] & 0xffff0000u), inv);
                o[64 * j] = w; }
            if (lane == 0) rs2[m] = __builtin_amdgcn_rsqf(s * (1.0f / DM) + EPS) * am * (1.0f / 127.0f); }
    }
    SEAM(PH_QUANT);
    PROBE_END(PH_QUANT);
    PROBE_BEGIN(PH_GATEUP);
    if (IN(PH_GATEUP)) {
        pg8::Gemm g{(const u16*)H1Q, WguT, M, NGU, DM / 2}; pg8::StaticOrder S; S.init(M, NGU, G, bx);
        pg8::Unit u0; u0.pm = 0; u0.pn = 0; (void)S.next(0, u0);
        LAS float* rtab = (LAS float*)(lds + RTAB_OFF);
        if (tid < 256) rtab[tid] = rs2[u0.pm * 256 + tid];
        __syncthreads();
        pg8::EpiSwiGLU8 E{(unsigned char*)PROJ, (const LAS float*)rtab, u0.pm, rs2, cmax_gu};
        pg8::gemm_phase<pg8::EpiSwiGLU8, pg8::StaticOrder, PG8_ALIGN, PG8_SP2, 2>(lds + RING_OFF, g, S, E);
    }
    PROBE_BEGIN(55);
    SEAM(PH_GATEUP);
    PROBE_END(55);
    PROBE_END(PH_GATEUP);
    PROBE_BEGIN(PH_DOWN);
    if (IN(PH_DOWN)) {
        pg8::Gemm g{PROJ, WdT, M, DM, DFF / 2, 0x77777777u  , 0x7d7d7d7du  }; pg8::StaticOrder S; S.init(M, DM, G, bx);
        pg8::EpiDown E{BB};
        pg8::gemm_phase<pg8::EpiDown, pg8::StaticOrder, PG8_ALIGN, PG8_SP2, 1>(lds + RING_OFF, g, S, E);
    }
    PROBE_BEGIN(56);
    SEAM(PH_DOWN);
    PROBE_END(56);
    PROBE_END(PH_DOWN);
    PROBE_BEGIN(PH_FINAL);
    if (IN(PH_FINAL)) {
        for (int m = gw; m < M; m += NGW) rms_row_from_bf16(BB + (size_t)m * DM, args.in[16], args.out + (size_t)m * DM, lane);
    }
    PROBE_END(PH_FINAL);
    PROBE_END(99);
    if (PROBE_PH >= 0 && bx == PROBE_BX && tid == 0) { const unsigned long long t1 = __builtin_amdgcn_s_memrealtime(); while (__builtin_amdgcn_s_memrealtime() - t1 < 4 * pr_dt) __builtin_amdgcn_s_sleep(8); }
#undef IN
#undef SEAM
}

extern "C" void kernel_launch(void* const* d_in, const int* in_sizes, int n_in, void* d_out, int out_size, void* d_ws, size_t ws_size, hipStream_t stream) {
    static int grid = 0;
    if (grid == 0) {
        if (n_in != 17 || ws_size < WS_NEED || out_size != M * DM) { fprintf(stderr, "kernel_launch: unexpected shapes (n_in %d, ws %zu, out %d)\n", n_in, ws_size, out_size); grid = -1; return; }
        int dev = 0, cus = 0;
        if (hipGetDevice(&dev) != hipSuccess || hipDeviceGetAttribute(&cus, hipDeviceAttributeMultiprocessorCount, dev) != hipSuccess) { grid = -1; return; }
        if (hipFuncSetAttribute((const void*)mk_fwd, hipFuncAttributeMaxDynamicSharedMemorySize, LDS_BYTES) != hipSuccess) { fprintf(stderr, "kernel_launch: hipFuncSetAttribute failed\n"); grid = -1; return; }
        (void)hipGetLastError();
        grid = cus;
    }
    if (grid < 0) return;
    unsigned char* ws = (unsigned char*)d_ws;
    (void)hipMemsetAsync(ws + WS_CTL, 0, CTL_ZERO_BYTES, stream);
    Args a{};
    for (int i = 0; i < 17; ++i) a.in[i] = (const float*)d_in[i];
    a.out = (float*)d_out; a.ws = ws;
    a.ph_lo = PH_PRO; a.ph_hi = PH_N; a.li = 0;
    hipLaunchKernelGGL(mk_fwd, dim3(grid), dim3(NWAVES * 64), LDS_BYTES, stream, a);
}
```

```cpp
#include <hip/hip_runtime.h>
#include <stdint.h>
#include <cstdio>

typedef unsigned short u16;
constexpr int BATCH = 8, SEQ = 2048, DM = 2048, M = BATCH * SEQ;
constexpr int HGW = 1024, DAW = 1024, INC = 8192, DFF = 5632, NGU = 2 * DFF;
constexpr float EPS = 1e-6f;
constexpr float LOG2E = 1.4426950408889634f;
constexpr float C2 = 0.125f * LOG2E;
constexpr size_t MiB = 1u << 20;
constexpr size_t WS_CTL = 0, CTL_ZERO_BYTES = 65536, CMAX_GU_OFF = 65536  , CMAX_IN_OFF = 114688  , WS_PART = 2 * MiB, WS_WIN = 4 * MiB, WS_WO = 36 * MiB, WS_WGU = 44 * MiB, WS_WD = 88 * MiB,
                 WS_XN = 112 * MiB, WS_B = 176 * MiB, WS_PROJ = 240 * MiB, WS_NEED = 496 * MiB;
namespace pg8 {
#define PG8_LAS __attribute__((address_space(3)))
typedef unsigned short bf16_t;
typedef short bf16x8 __attribute__((ext_vector_type(8)));
typedef float f32x4 __attribute__((ext_vector_type(4)));
typedef unsigned u32x4 __attribute__((ext_vector_type(4)));
constexpr int BM = 256, BK = 64, HALF = 128, HTB = HALF * BK * 2  , STAGE_BYTES = 8 * HTB, NXCD = 8, WGM = 8;

__host__ __device__ __forceinline__ int lds_byte(int r, int c) { const int st = (r >> 4) * 2 + (c >> 5), rr = r & 15, cc = c & 31, ob = rr * 64 + cc * 2; return st * 1024 + (ob ^ (((ob >> 9) & 1) << 5)); }
__host__ __device__ __forceinline__ void stage_rc(int b, int& R, int& C) { const int st = b / 1024, sb = b % 1024, swz = sb ^ (((sb >> 9) & 1) << 5); R = (st >> 1) * 16 + swz / 64; C = (st & 1) * 32 + (swz % 64) / 2; }
__host__ __device__ __forceinline__ int perm32(int rho) { const int n = rho >> 4, i = rho & 15; return 8 * (i >> 2) + 4 * n + (i & 3); }

struct Unit { int pm, pn; };
struct Gemm { const bf16_t* A; const bf16_t* Bt; int M, N, K; unsigned sw = 0x7f7f7f7fu, sa = 0x7f7f7f7fu; };
typedef int i32x4 __attribute__((ext_vector_type(4)));
typedef int i32x8 __attribute__((ext_vector_type(8)));
__device__ __forceinline__ i32x8 cat_frag(bf16x8 lo, bf16x8 hi) { return __builtin_shufflevector(__builtin_bit_cast(i32x4, lo), __builtin_bit_cast(i32x4, hi), 0, 1, 2, 3, 4, 5, 6, 7); }

struct StaticOrder {
    int nM, nN, nwg, G, c;
    __host__ __device__ void init(int M, int N, int G_, int c_) { nM = M / BM; nN = N / BM; nwg = nM * nN; G = G_; c = c_; }
    __host__ __device__ bool next(int i, Unit& u) const {
        const long L = (long)i * G + c; if (L >= nwg) return false;
        int wgid = (int)L; { const int q = nwg / NXCD, r = nwg % NXCD, xcd = wgid % NXCD, off = wgid / NXCD; wgid = (xcd < r ? xcd * (q + 1) : r * (q + 1) + (xcd - r) * q) + off; }
        const int nig = WGM * nN, gid = wgid / nig, fm = gid * WGM, gsz = (nM - fm) < WGM ? (nM - fm) : WGM;
        u.pm = fm + ((wgid % nig) % gsz); u.pn = (wgid % nig) / gsz; return true;
    }
    __device__ __forceinline__ void a_ready(const Unit&) const {}
    __device__ __forceinline__ void done(const Unit&) const {}
};
__device__ __forceinline__ unsigned cvt_pk_bf16(float lo, float hi) { typedef float f2_ __attribute__((ext_vector_type(2))); typedef __bf16 b2_ __attribute__((ext_vector_type(2))); const f2_ v = {lo, hi}; return __builtin_bit_cast(unsigned, __builtin_convertvector(v, b2_)); }
typedef float f32x2 __attribute__((ext_vector_type(2)));
__device__ __forceinline__ unsigned pk_h2(float lo, float hi) { return (unsigned)__builtin_bit_cast(unsigned short, (_Float16)lo) | ((unsigned)__builtin_bit_cast(unsigned short, (_Float16)hi) << 16); }
__device__ __forceinline__ float fsig(float x) { return __builtin_amdgcn_rcpf(1.0f + __builtin_amdgcn_exp2f(-1.4426950408889634f * x)); }
__device__ __forceinline__ float fsilu(float x) { return x * fsig(x); }
struct EpiInProj {
    static constexpr bool PERM = true, AFTER_DRAIN = false;
    bf16_t* proj; const float* lbl; const float* sa; const float* cmax;
    __device__ __forceinline__ void operator()(const f32x4 (&acc)[2][2][4][2], const Unit& u, int wr, int wc, int fr, int fq) const {
        const int row0 = u.pm * BM + wr * 64 + fr, t = u.pn >> 2, col0 = u.pn * BM + wc * 32 + 8 * fq;
        bf16_t* base = proj + (size_t)row0 * 8192 + col0;
        float rs[2][4];
#pragma unroll
        for (int ai = 0; ai < 2; ++ai)
#pragma unroll
            for (int m = 0; m < 4; ++m) rs[ai][m] = sa[row0 + ai * HALF + m * 16];
        if (t == 2 || t == 3) {
#pragma unroll
            for (int bj = 0; bj < 2; ++bj) {
                f32x4 lb[2], ol[2], cs[2];
                { const float* l0 = lbl + (t - 2) * 2048 + (col0 & 1023) + bj * HALF;
#pragma unroll
                  for (int n = 0; n < 2; ++n) { const f32x4 a0 = *(const f32x4*)(l0 + 4 * n), b0 = *(const f32x4*)(l0 + 1024 + 4 * n);
#pragma unroll
                      for (int c = 0; c < 4; ++c) lb[n][c] = fsig(a0[c] - b0[c]);
                      ol[n] = 1.0f - lb[n]; cs[n] = *(const f32x4*)(cmax + col0 + bj * HALF + 4 * n) * (-1.4426950408889634f / 127.0f); } }
#pragma unroll
                for (int ai = 0; ai < 2; ++ai)
#pragma unroll
                    for (int m = 0; m < 4; ++m) { f32x4 y[2];
#pragma unroll
                        for (int n = 0; n < 2; ++n) { const f32x4 e = acc[ai][bj][m][n] * (cs[n] * rs[ai][m]); f32x4 d;
#pragma unroll
                            for (int c = 0; c < 4; ++c) d[c] = __builtin_amdgcn_exp2f(e[c]);
                            d = d + 1.0f;
#pragma unroll
                            for (int c = 0; c < 4; ++c) d[c] = __builtin_amdgcn_rcpf(d[c]);
                            const f32x4 f = lb[n] + ol[n] * d;
#pragma unroll
                            for (int c = 0; c < 4; ++c) y[n][c] = __builtin_amdgcn_logf(f[c]); }
                        u32x4 w; w.x = pk_h2(y[0][0], y[0][1]); w.y = pk_h2(y[0][2], y[0][3]); w.z = pk_h2(y[1][0], y[1][1]); w.w = pk_h2(y[1][2], y[1][3]);
                        *(u32x4*)(base + (size_t)(ai * HALF + m * 16) * 8192 + bj * HALF) = w; }
            }
        } else {
            const float sc = (t == 5) ? 0.18033688011112042f * (1.0f / 127.0f) : (1.0f / 127.0f);
            const bool act = (t == 0 || t == 4);
#pragma unroll
            for (int bj = 0; bj < 2; ++bj) {
                f32x4 cs[2];
#pragma unroll
                for (int n = 0; n < 2; ++n) cs[n] = *(const f32x4*)(cmax + col0 + bj * HALF + 4 * n) * sc;
                if (act) {
#pragma unroll
                    for (int ai = 0; ai < 2; ++ai)
#pragma unroll
                        for (int m = 0; m < 4; ++m) { f32x4 y[2];
#pragma unroll
                            for (int n = 0; n < 2; ++n) { const f32x4 a = acc[ai][bj][m][n] * (cs[n] * rs[ai][m]); const f32x4 e = a * (-1.4426950408889634f); f32x4 d;
#pragma unroll
                                for (int c = 0; c < 4; ++c) d[c] = __builtin_amdgcn_exp2f(e[c]);
                                d = d + 1.0f;
#pragma unroll
                                for (int c = 0; c < 4; ++c) d[c] = __builtin_amdgcn_rcpf(d[c]);
                                y[n] = a * d; }
                            u32x4 w; w.x = cvt_pk_bf16(y[0][0], y[0][1]); w.y = cvt_pk_bf16(y[0][2], y[0][3]); w.z = cvt_pk_bf16(y[1][0], y[1][1]); w.w = cvt_pk_bf16(y[1][2], y[1][3]);
                            *(u32x4*)(base + (size_t)(ai * HALF + m * 16) * 8192 + bj * HALF) = w; }
                } else {
#pragma unroll
                    for (int ai = 0; ai < 2; ++ai)
#pragma unroll
                        for (int m = 0; m < 4; ++m) { f32x4 y[2];
#pragma unroll
                            for (int n = 0; n < 2; ++n) y[n] = acc[ai][bj][m][n] * (cs[n] * rs[ai][m]);
                            u32x4 w; w.x = cvt_pk_bf16(y[0][0], y[0][1]); w.y = cvt_pk_bf16(y[0][2], y[0][3]); w.z = cvt_pk_bf16(y[1][0], y[1][1]); w.w = cvt_pk_bf16(y[1][2], y[1][3]);
                            *(u32x4*)(base + (size_t)(ai * HALF + m * 16) * 8192 + bj * HALF) = w; }
                }
            }
        }
    }
};
struct EpiOutProj {
    static constexpr bool PERM = true, AFTER_DRAIN = false;
    const float* x; bf16_t* h1b;
    __device__ __forceinline__ void operator()(const f32x4 (&acc)[2][2][4][2], const Unit& u, int wr, int wc, int fr, int fq) const {
        const int row0 = u.pm * BM + wr * 64 + fr, col0 = u.pn * BM + wc * 32 + 8 * fq;
#pragma unroll
        for (int ai = 0; ai < 2; ++ai) {
            f32x4 xv[4][2][2];
#pragma unroll
            for (int m = 0; m < 4; ++m)
#pragma unroll
                for (int bj = 0; bj < 2; ++bj) { const float* p = x + (size_t)(row0 + ai * HALF + m * 16) * 2048 + col0 + bj * HALF; xv[m][bj][0] = __builtin_nontemporal_load((const f32x4*)p); xv[m][bj][1] = __builtin_nontemporal_load((const f32x4*)(p + 4)); }
#pragma unroll
            for (int m = 0; m < 4; ++m) { const int row = row0 + ai * HALF + m * 16; const size_t off = (size_t)row * 2048 + col0;
#pragma unroll
                for (int bj = 0; bj < 2; ++bj) { const f32x4 h0 = xv[m][bj][0] + acc[ai][bj][m][0], h1 = xv[m][bj][1] + acc[ai][bj][m][1];
                    u32x4 w; w.x = cvt_pk_bf16(h0[0], h0[1]); w.y = cvt_pk_bf16(h0[2], h0[3]); w.z = cvt_pk_bf16(h1[0], h1[1]); w.w = cvt_pk_bf16(h1[2], h1[3]); *(u32x4*)(h1b + off + bj * HALF) = w; } }
        }
    }
};
constexpr float HID_SCALE = 4.0f;
struct EpiSwiGLU8 {
    static constexpr bool PERM = true, AFTER_DRAIN = false;
    unsigned char* hid; const PG8_LAS float* rtab; int pm_tab; const float* rsg; const float* cmax;
    __device__ __forceinline__ void operator()(const f32x4 (&acc)[2][2][4][2], const Unit& u, int wr, int wc, int fr, int fq) const {
        const int rt0 = wr * 64 + fr, col0 = u.pn * HALF + wc * 32 + 8 * fq;
        f32x4 sg[2], su[2];
        { const float* c0 = cmax + u.pn * BM + wc * 32 + 8 * fq;
          sg[0] = *(const f32x4*)c0 * (1.0f / 127.0f); sg[1] = *(const f32x4*)(c0 + 4) * (1.0f / 127.0f); su[0] = *(const f32x4*)(c0 + HALF) * (HID_SCALE / 127.0f); su[1] = *(const f32x4*)(c0 + HALF + 4) * (HID_SCALE / 127.0f); }
#pragma unroll
        for (int ai = 0; ai < 2; ++ai)
#pragma unroll
            for (int m = 0; m < 4; ++m) { const int rt = rt0 + ai * HALF + m * 16;
                const float r = (u.pm == pm_tab) ? rtab[rt] : rsg[u.pm * BM + rt];
                f32x4 y[2];
#pragma unroll
                for (int n = 0; n < 2; ++n) { const f32x4 g = acc[ai][0][m][n] * (sg[n] * r), up = acc[ai][1][m][n] * (su[n] * r); const f32x4 t = g * (-1.4426950408889634f); f32x4 d;
#pragma unroll
                    for (int c = 0; c < 4; ++c) d[c] = __builtin_amdgcn_exp2f(t[c]);
                    d = d + 1.0f;
#pragma unroll
                    for (int c = 0; c < 4; ++c) d[c] = __builtin_amdgcn_rcpf(d[c]);
                    y[n] = (g * up) * d; }
                uint2 w; int t = 0;
                t = __builtin_amdgcn_cvt_pk_fp8_f32(y[0][0], y[0][1], t, false); t = __builtin_amdgcn_cvt_pk_fp8_f32(y[0][2], y[0][3], t, true); w.x = (unsigned)t;
                t = __builtin_amdgcn_cvt_pk_fp8_f32(y[1][0], y[1][1], t, false); t = __builtin_amdgcn_cvt_pk_fp8_f32(y[1][2], y[1][3], t, true); w.y = (unsigned)t;
                *(uint2*)(hid + (size_t)(u.pm * BM + rt) * 5632 + col0) = w; }
    }
};
struct EpiDown {
    static constexpr bool PERM = true, AFTER_DRAIN = false;
    bf16_t* hb;
    __device__ __forceinline__ void operator()(const f32x4 (&acc)[2][2][4][2], const Unit& u, int wr, int wc, int fr, int fq) const {
        unsigned off0 = (unsigned)((u.pm * BM + wr * 64 + fr) * 2048 + u.pn * BM + wc * 32 + 8 * fq);
#pragma unroll
        for (int ai = 0; ai < 2; ++ai)
#pragma unroll
            for (int mp = 0; mp < 2; ++mp) {
                unsigned ob = off0 + (unsigned)((ai * HALF + mp * 32) * 2048); asm volatile("" : "+v"(ob));
                u32x4 hv[2][2];
#pragma unroll
                for (int m2 = 0; m2 < 2; ++m2)
#pragma unroll
                    for (int bj = 0; bj < 2; ++bj) hv[m2][bj] = __builtin_nontemporal_load((const u32x4*)(hb + (ob + m2 * 16 * 2048 + bj * HALF)));
#pragma unroll
                for (int m2 = 0; m2 < 2; ++m2) { const int m = 2 * mp + m2;
#pragma unroll
                    for (int bj = 0; bj < 2; ++bj) { const u32x4 h = hv[m2][bj]; const f32x4 a0 = acc[ai][bj][m][0], a1 = acc[ai][bj][m][1]; u32x4 w;
                        w.x = cvt_pk_bf16(__uint_as_float(h.x << 16) + a0[0], __uint_as_float(h.x & 0xffff0000u) + a0[1]); w.y = cvt_pk_bf16(__uint_as_float(h.y << 16) + a0[2], __uint_as_float(h.y & 0xffff0000u) + a0[3]);
                        w.z = cvt_pk_bf16(__uint_as_float(h.z << 16) + a1[0], __uint_as_float(h.z & 0xffff0000u) + a1[1]); w.w = cvt_pk_bf16(__uint_as_float(h.w << 16) + a1[2], __uint_as_float(h.w & 0xffff0000u) + a1[3]);
                        *(u32x4*)(hb + (ob + m2 * 16 * 2048 + bj * HALF)) = w; } }
            }
    }
};

template <class Epi, class Sched, bool ALIGN_EPI = false, bool SP2 = false, int MODE = 0>
__device__ __forceinline__ void gemm_phase(PG8_LAS unsigned char* lds, const Gemm g, const Sched& S, const Epi& E) {
    const int tid = threadIdx.x, wid = __builtin_amdgcn_readfirstlane(tid >> 6), lane = tid & 63, wr = wid >> 2, wc = wid & 3, fr = lane & 15, fq = lane >> 4;
    const int K = g.K, nt = K / BK;
    unsigned voffA[2], voffB[2];
#pragma unroll
    for (int i = 0; i < 2; ++i) { int R, C; stage_rc(tid * 16 + i * 8192, R, C); const int Rb = Epi::PERM ? ((R & ~31) + perm32(R & 31)) : R;
        voffA[i] = (unsigned)(R * K + C) * 2u; voffB[i] = (unsigned)(Rb * K + C) * 2u; }
    const size_t kstep = (size_t)(BK * 2);
    const size_t hstep = (size_t)HALF * K * 2;
    const size_t tstep = 2 * hstep;
    const unsigned ldsw = (unsigned)wid * 1024u;
    const int aoff = lds_byte(wr * 64 + fr, fq * 8), boff = lds_byte(wc * 32 + fr, fq * 8);
#define PG8_SA(b, h) (((b) * 2 + (h)) * HTB)
#define PG8_SB(b, h) ((4 + (b) * 2 + (h)) * HTB)
#define PG8_STAGE(bufoff, gbase, voff) do { _Pragma("unroll") for (int _i = 0; _i < 2; ++_i) \
        __builtin_amdgcn_global_load_lds((const unsigned*)((const char*)(gbase) + (voff)[_i]), (PG8_LAS unsigned*)(lds + (bufoff) + ldsw + _i * 8192), 16, 0, 0); } while (0)
#define PG8_LDA(dst, b, h) do { _Pragma("unroll") for (int m = 0; m < 4; ++m) _Pragma("unroll") for (int k = 0; k < 2; ++k) dst[m][k] = *(const PG8_LAS bf16x8*)(lds + PG8_SA(b, h) + aoff + m * 2048 + k * 1024); } while (0)
#define PG8_LDB(dst, b, h) do { _Pragma("unroll") for (int n = 0; n < 2; ++n) _Pragma("unroll") for (int k = 0; k < 2; ++k) dst[n][k] = *(const PG8_LAS bf16x8*)(lds + PG8_SB(b, h) + boff + n * 2048 + k * 1024); } while (0)
#define PG8_MMA(ai, bj, At, Bt) do { __builtin_amdgcn_s_setprio(1); _Pragma("unroll") for (int m = 0; m < 4; ++m) _Pragma("unroll") for (int n = 0; n < 2; ++n) { \
        if constexpr (MODE == 1) { const i32x8 b8_ = cat_frag(Bt[n][0], Bt[n][1]), a8_ = cat_frag(At[m][0], At[m][1]); \
            asm volatile("v_mfma_scale_f32_16x16x128_f8f6f4 %0, %1, %2, %0, %3, %4 op_sel_hi:[0,0,0]" : "+v"(acc[ai][bj][m][n]) : "v"(b8_), "v"(a8_), "v"(g.sw), "v"(g.sa)); } \
        else if constexpr (MODE == 2) { _Pragma("unroll") for (int k = 0; k < 2; ++k) acc[ai][bj][m][n] = __builtin_bit_cast(f32x4, __builtin_amdgcn_mfma_i32_16x16x64_i8(__builtin_bit_cast(i32x4, Bt[n][k]), __builtin_bit_cast(i32x4, At[m][k]), __builtin_bit_cast(i32x4, acc[ai][bj][m][n]), 0, 0, 0)); } \
        else { _Pragma("unroll") for (int k = 0; k < 2; ++k) acc[ai][bj][m][n] = __builtin_amdgcn_mfma_f32_16x16x32_bf16(Bt[n][k], At[m][k], acc[ai][bj][m][n], 0, 0, 0); } } \
        __builtin_amdgcn_s_setprio(0); } while (0)
#define PG8_WAIT_V(n) asm volatile("s_waitcnt vmcnt(" #n ")" ::: "memory")
#define PG8_WAIT_L(n) asm volatile("s_waitcnt lgkmcnt(" #n ")" ::: "memory")
#define PG8_BAR __builtin_amdgcn_s_barrier()
#define PG8_SCHED __builtin_amdgcn_sched_barrier(0)
    Unit cur, nxt; int ui = 0;
    if (!S.next(0, cur)) return;
    f32x4 acc[2][2][4][2];
#pragma unroll
    for (int a = 0; a < 2; ++a)
#pragma unroll
        for (int b = 0; b < 2; ++b)
#pragma unroll
            for (int m = 0; m < 4; ++m)
#pragma unroll
                for (int n = 0; n < 2; ++n) acc[a][b][m][n] = (f32x4){0.f, 0.f, 0.f, 0.f};
    bf16x8 At[4][2], B0[2][2], B1[2][2];
    const char* cA = (const char*)g.A + (size_t)cur.pm * tstep; const char* cB = (const char*)g.Bt + (size_t)cur.pn * tstep;
    S.a_ready(cur);
    if constexpr (SP2) {
        PG8_STAGE(PG8_SB(0, 0), cB, voffB); PG8_STAGE(PG8_SB(0, 1), cB + hstep, voffB); PG8_STAGE(PG8_SA(0, 0), cA, voffA); PG8_STAGE(PG8_SA(0, 1), cA + hstep, voffA);
        if (wr == 1) PG8_BAR;
        PG8_WAIT_V(2); PG8_BAR;
        PG8_STAGE(PG8_SB(1, 0), cB + kstep, voffB); PG8_STAGE(PG8_SA(1, 0), cA + kstep, voffA); PG8_STAGE(PG8_SB(1, 1), cB + hstep + kstep, voffB);
        PG8_WAIT_V(6); PG8_BAR;
    } else {
        PG8_STAGE(PG8_SB(0, 0), cB, voffB); PG8_STAGE(PG8_SA(0, 0), cA, voffA); PG8_STAGE(PG8_SB(0, 1), cB + hstep, voffB); PG8_STAGE(PG8_SA(0, 1), cA + hstep, voffA);
        if (wr == 1) PG8_BAR;
        PG8_WAIT_V(4); PG8_BAR;
        PG8_STAGE(PG8_SB(1, 0), cB + kstep, voffB); PG8_STAGE(PG8_SA(1, 0), cA + kstep, voffA); PG8_STAGE(PG8_SB(1, 1), cB + hstep + kstep, voffB);
        PG8_WAIT_V(6); PG8_BAR;
    }
    for (;;) {
        const bool has_next = S.next(ui + 1, nxt);
        const char* nA = has_next ? (const char*)g.A + (size_t)nxt.pm * tstep : cA; const char* nB = has_next ? (const char*)g.Bt + (size_t)nxt.pn * tstep : cB;
        for (int t = 0; t < nt; t += 2) {
            const bool last = (t == nt - 2);
            const char* a1 = cA + (size_t)(t + 1) * kstep;
            const char* a2 = last ? nA : cA + (size_t)(t + 2) * kstep; const char* b2 = last ? nB : cB + (size_t)(t + 2) * kstep;
            const char* a3 = a2 + kstep; const char* b3 = b2 + kstep;
            if (last && has_next) S.a_ready(nxt);
            if constexpr (SP2) {
            PG8_LDB(B0, 0, 0); PG8_LDB(B1, 0, 1); PG8_SCHED; PG8_LDA(At, 0, 0); PG8_STAGE(PG8_SA(1, 1), a1 + hstep, voffA);
            PG8_WAIT_V(8); PG8_WAIT_L(0); PG8_BAR; PG8_MMA(0, 0, At, B0); PG8_MMA(0, 1, At, B1); PG8_BAR; PG8_SCHED;
            PG8_LDA(At, 0, 1); PG8_STAGE(PG8_SB(0, 0), b2, voffB); PG8_STAGE(PG8_SB(0, 1), b2 + hstep, voffB); PG8_STAGE(PG8_SA(0, 0), a2, voffA);
            PG8_WAIT_V(8); PG8_WAIT_L(0); PG8_BAR; PG8_MMA(1, 0, At, B0); PG8_MMA(1, 1, At, B1); PG8_BAR; PG8_SCHED;
            PG8_LDB(B0, 1, 0); PG8_LDB(B1, 1, 1); PG8_SCHED; PG8_LDA(At, 1, 0); PG8_STAGE(PG8_SA(0, 1), a2 + hstep, voffA);
            PG8_WAIT_V(8); PG8_WAIT_L(0); PG8_BAR; PG8_MMA(0, 0, At, B0); PG8_MMA(0, 1, At, B1); PG8_BAR; PG8_SCHED;
            PG8_LDA(At, 1, 1); PG8_STAGE(PG8_SB(1, 0), b3, voffB); PG8_STAGE(PG8_SB(1, 1), b3 + hstep, voffB); PG8_STAGE(PG8_SA(1, 0), a3, voffA);
            PG8_WAIT_V(8); PG8_WAIT_L(0); PG8_BAR; PG8_MMA(1, 0, At, B0); PG8_MMA(1, 1, At, B1); PG8_BAR; PG8_SCHED;
            } else {
            PG8_LDB(B0, 0, 0); PG8_SCHED; PG8_LDA(At, 0, 0); PG8_STAGE(PG8_SA(1, 1), a1 + hstep, voffA);
            PG8_WAIT_L(8); PG8_BAR; PG8_WAIT_L(0); PG8_MMA(0, 0, At, B0); PG8_BAR; PG8_SCHED;
            PG8_LDB(B1, 0, 1); PG8_STAGE(PG8_SB(0, 0), b2, voffB);
            PG8_BAR; PG8_WAIT_L(0); PG8_MMA(0, 1, At, B1); PG8_BAR;
            PG8_LDA(At, 0, 1); PG8_STAGE(PG8_SA(0, 0), a2, voffA);
            PG8_BAR; PG8_WAIT_L(0); PG8_MMA(1, 0, At, B0); PG8_BAR; PG8_SCHED;
            PG8_STAGE(PG8_SB(0, 1), b2 + hstep, voffB);
            PG8_WAIT_V(6); PG8_BAR; PG8_MMA(1, 1, At, B1); PG8_BAR;
            PG8_LDB(B0, 1, 0); PG8_SCHED; PG8_LDA(At, 1, 0); PG8_STAGE(PG8_SA(0, 1), a2 + hstep, voffA);
            PG8_WAIT_L(8); PG8_BAR; PG8_WAIT_L(0); PG8_MMA(0, 0, At, B0); PG8_BAR; PG8_SCHED;
            PG8_LDB(B1, 1, 1); PG8_STAGE(PG8_SB(1, 0), b3, voffB);
            PG8_BAR; PG8_WAIT_L(0); PG8_MMA(0, 1, At, B1); PG8_BAR;
            PG8_LDA(At, 1, 1); PG8_STAGE(PG8_SA(1, 0), a3, voffA);
            PG8_BAR; PG8_WAIT_L(0); PG8_MMA(1, 0, At, B0); PG8_BAR; PG8_SCHED;
            PG8_STAGE(PG8_SB(1, 1), b3 + hstep, voffB);
            PG8_WAIT_V(6); PG8_BAR; PG8_MMA(1, 1, At, B1); PG8_BAR;
            }
        }
        if constexpr (MODE == 1) asm volatile("s_nop 15\n\ts_nop 15" ::: "memory");
        if constexpr (ALIGN_EPI) { if (wr == 0) PG8_BAR; }
        if constexpr (MODE == 2) {
#pragma unroll
            for (int a = 0; a < 2; ++a)
#pragma unroll
                for (int b = 0; b < 2; ++b)
#pragma unroll
                    for (int m = 0; m < 4; ++m)
#pragma unroll
                        for (int n = 0; n < 2; ++n) acc[a][b][m][n] = __builtin_convertvector(__builtin_bit_cast(i32x4, acc[a][b][m][n]), f32x4);
        }
        if constexpr (!Epi::AFTER_DRAIN) { E(acc, cur, wr, wc, fr, fq); S.done(cur); }
        if (!has_next) break;
#pragma unroll
        for (int a = 0; a < 2; ++a)
#pragma unroll
            for (int b = 0; b < 2; ++b)
#pragma unroll
                for (int m = 0; m < 4; ++m)
#pragma unroll
                    for (int n = 0; n < 2; ++n) acc[a][b][m][n] = (f32x4){0.f, 0.f, 0.f, 0.f};
        cur = nxt; cA = nA; cB = nB; ++ui;
        if constexpr (ALIGN_EPI) { if (wr == 1) PG8_BAR; }
    }
    PG8_WAIT_V(0);
    if constexpr (!ALIGN_EPI) { if (wr == 0) PG8_BAR; }
    PG8_BAR;
    if constexpr (Epi::AFTER_DRAIN) { E.fused(acc, cur, wr, wc, fr, fq, lds, wid, lane); S.done(cur); }
#undef PG8_SA
#undef PG8_SB
#undef PG8_STAGE
#undef PG8_LDA
#undef PG8_LDB
#undef PG8_MMA
#undef PG8_WAIT_V
#undef PG8_WAIT_L
#undef PG8_BAR
#undef PG8_SCHED
}
}

#ifndef PG8_SP2
#define PG8_SP2 true
#endif
#ifndef PG8_ALIGN
#define PG8_ALIGN true
#endif
constexpr int RING_OFF = 0, RING_BYTES = 131072;
constexpr int LDS_BYTES = 163840;
constexpr int LDSCTL_OFF = LDS_BYTES - 2048, MISC_OFF = LDSCTL_OFF + 320;
constexpr int RTAB_OFF = LDSCTL_OFF + 1024;
constexpr int NWAVES = 8;
constexpr int CW_BAR = 4096;

#define GAS __attribute__((address_space(1)))
#define LAS __attribute__((address_space(3)))
typedef unsigned v4u __attribute__((ext_vector_type(4)));
typedef float f32x4 __attribute__((ext_vector_type(4)));
typedef GAS unsigned gu32;
#define LDS_WAIT() asm volatile("s_waitcnt lgkmcnt(0)" ::: "memory")
#define VM_WAIT() asm volatile("s_waitcnt vmcnt(0)" ::: "memory")
__device__ __forceinline__ unsigned f2bf_u(float f) { unsigned u = __builtin_bit_cast(unsigned, f); return (u + 0x7fffu + ((u >> 16) & 1u)) >> 16; }
__device__ __forceinline__ unsigned pk2(float lo, float hi) { return f2bf_u(lo) | (f2bf_u(hi) << 16); }
__device__ __forceinline__ float wave_sum(float v) {
#pragma unroll
    for (int o = 1; o < 64; o <<= 1) v += __shfl_xor(v, o);
    return v;
}
__device__ __forceinline__ float wave_max(float v) {
#pragma unroll
    for (int o = 1; o < 64; o <<= 1) v = fmaxf(v, __shfl_xor(v, o));
    return v;
}
__device__ __forceinline__ unsigned pack4_i8(float a, float b, float c, float d, float inv) {
    const unsigned t0 = __float_as_uint(__builtin_fmaf(a, inv, 12582912.0f)), t1 = __float_as_uint(__builtin_fmaf(b, inv, 12582912.0f)),
                   t2 = __float_as_uint(__builtin_fmaf(c, inv, 12582912.0f)), t3 = __float_as_uint(__builtin_fmaf(d, inv, 12582912.0f));
    const unsigned lo = __builtin_amdgcn_perm(t1, t0, 0x0c0c0400u), hi = __builtin_amdgcn_perm(t3, t2, 0x0c0c0400u);
    return __builtin_amdgcn_perm(hi, lo, 0x05040100u);
}
__device__ __forceinline__ float inv127(float amax) { return 127.0f / fmaxf(amax, 1e-30f); }

#define XB_TMO      128
#define XB_XCNT(j)  (256  + 64 * (j))
#define XB_XSUB(j)  (1280 + 64 * (j))
#define XB_XGEN(j)  (2304 + 64 * (j))
#define XB_TOP      3328
#define XB_TOPGEN   3392
#define XCD_BAR_WORDS 3456
#define XB_SPIN_CAP (1u << 18)

__device__ __forceinline__ unsigned xb_ld(unsigned* p)              { return __hip_atomic_load(p, __ATOMIC_RELAXED, __HIP_MEMORY_SCOPE_AGENT); }
__device__ __forceinline__ unsigned xb_add(unsigned* p, unsigned v) { return __hip_atomic_fetch_add(p, v, __ATOMIC_RELAXED, __HIP_MEMORY_SCOPE_AGENT); }
__device__ __forceinline__ unsigned xb_xcc_id() { return (unsigned)__builtin_amdgcn_s_getreg((3 << 11) | 20) & 0xFu; }
#define XB_SPIN(cond, bar) do { unsigned _sp = 0; while (cond) { __builtin_amdgcn_s_sleep(1); \
    if ((++_sp & 255u) == 0u) { if (xb_ld(&(bar)[XB_TMO])) break; if (_sp > XB_SPIN_CAP) { atomicAdd(&(bar)[XB_TMO], 1u); break; } } } } while (0)

struct XcdBarrier {
    unsigned* bar; unsigned x;
    volatile LAS unsigned* st;
};

__device__ __forceinline__ XcdBarrier xcd_barrier_post(unsigned* bar, volatile LAS unsigned* st) {
    XcdBarrier b; b.bar = bar; b.x = xb_xcc_id(); b.st = st;
    if (threadIdx.x == 0) (void)xb_add(&bar[XB_XCNT(b.x)], 1u);
    return b;
}
__device__ __forceinline__ void xcd_barrier_complete(unsigned* bar, unsigned x, unsigned& nloc, unsigned& nx) {
    const unsigned G = gridDim.x * gridDim.y * gridDim.z;
    unsigned sum, cnt, mine, sp = 0u;
    for (;;) {
        sum = 0u; cnt = 0u; mine = 0u;
#pragma unroll
        for (unsigned j = 0; j < 16; ++j) { const unsigned c = xb_ld(&bar[XB_XCNT(j)]); sum += c; cnt += (c > 0u) ? 1u : 0u; mine = (j == x) ? c : mine; }
        if (sum == G) break;
        __builtin_amdgcn_s_sleep(1);
        if ((++sp & 255u) == 0u) { if (xb_ld(&bar[XB_TMO])) break; if (sp > XB_SPIN_CAP) { atomicAdd(&bar[XB_TMO], 1u); break; } }
    }
    nloc = mine > 0u ? mine : 1u; nx = cnt > 0u ? cnt : 1u;
}

__device__ __forceinline__ void xcd_barrier(const XcdBarrier& b) {
    asm volatile("s_waitcnt vmcnt(0)" ::: "memory");
    __syncthreads();
    if (threadIdx.x == 0) {
        unsigned* bar = b.bar;
        __builtin_amdgcn_s_waitcnt(0);
        unsigned nloc = b.st[0], nx = b.st[1];
        if (nloc == 0u) { xcd_barrier_complete(bar, b.x, nloc, nx); b.st[0] = nloc; b.st[1] = nx; }
        const unsigned old = xb_add(&bar[XB_XSUB(b.x)], 1u);
        const unsigned gen = old / nloc;
        if (old + 1u == (gen + 1u) * nloc) {
            __builtin_amdgcn_fence(__ATOMIC_RELEASE, "agent");
            asm volatile("s_waitcnt vmcnt(0)" ::: "memory");
            const unsigned og = xb_add(&bar[XB_TOP], 1u);
            const unsigned tg = og / nx;
            if (og + 1u == (tg + 1u) * nx) xb_add(&bar[XB_TOPGEN], 1u);
            else XB_SPIN(xb_ld(&bar[XB_TOPGEN]) == tg, bar);
            __builtin_amdgcn_fence(__ATOMIC_ACQUIRE, "agent");
            xb_add(&bar[XB_XGEN(b.x)], 1u);
            asm volatile("s_waitcnt vmcnt(0)" ::: "memory");
        } else {
            XB_SPIN(xb_ld(&bar[XB_XGEN(b.x)]) == gen, bar);
            __builtin_amdgcn_fence(__ATOMIC_ACQUIRE, "agent");
            asm volatile("s_waitcnt vmcnt(0)" ::: "memory");
        }
    }
    __syncthreads();
}

namespace bg {
typedef float f32x4 __attribute__((ext_vector_type(4)));
typedef unsigned u32x4 __attribute__((ext_vector_type(4)));
constexpr int I_O = (DM / 32) * (DM / 64), I_G = 0  , I_D = (DFF / 32) * (DM / 64), NBG = I_O + 2 * I_G + I_D;
struct Ptrs { const float* w_out; const float* w_gate; const float* w_up; const float* w_down; const float* norm2_w; u16* WoT; u16* WguT; u16* WdT; const float* cmax_gu; };
constexpr float WD_SCALE = 256.0f;
struct Dec { const float* W; u16* WT; const float* ksc; int K, N, k0, n0, drow0, f8; };
__device__ __forceinline__ Dec decode(const Ptrs& P, int q) {
    Dec d;
    if (q < I_O) { d.f8 = 0; d.W = P.w_out; d.WT = P.WoT; d.ksc = nullptr; d.K = DM; d.N = DM; d.k0 = 32 * (q / (DM / 64)); d.n0 = 64 * (q % (DM / 64)); d.drow0 = d.n0; return d; }
    q -= I_O;
    if (q < 2 * I_G) { const int up = q >= I_G ? 1 : 0; if (up) q -= I_G; d.f8 = 2; d.W = up ? P.w_up : P.w_gate; d.WT = P.WguT; d.ksc = P.norm2_w; d.K = DM; d.N = DFF;
        d.k0 = 32 * (q / (DFF / 64)); d.n0 = 64 * (q % (DFF / 64)); d.drow0 = 256 * (d.n0 >> 7) + 128 * up + (d.n0 & 127); return d; }
    q -= 2 * I_G;
    d.f8 = 1; d.W = P.w_down; d.WT = P.WdT; d.ksc = nullptr; d.K = DFF; d.N = DM; d.k0 = 32 * (q / (DM / 64)); d.n0 = 64 * (q % (DM / 64)); d.drow0 = d.n0; return d;
}
__device__ __forceinline__ void load(const Ptrs& P, int q, int lane, f32x4 (&v)[8]) {
    const Dec d = decode(P, q); const int kg = lane >> 4, n4 = (lane & 15) * 4;
    const float* src = d.W + (size_t)(d.k0 + 8 * kg) * d.N + d.n0 + n4;
#pragma unroll
    for (int i = 0; i < 8; ++i) v[i] = __builtin_nontemporal_load((const f32x4*)(src + (size_t)i * d.N));
}
__device__ __forceinline__ void store(const Ptrs& P, int q, int lane, f32x4 (&v)[8]) {
    const Dec d = decode(P, q); const int kg = lane >> 4, n4 = (lane & 15) * 4;
    if (d.ksc) { const f32x4 s0 = *(const f32x4*)(d.ksc + d.k0 + 8 * kg), s1 = *(const f32x4*)(d.ksc + d.k0 + 8 * kg + 4);
#pragma unroll
        for (int i = 0; i < 4; ++i) { v[i] = v[i] * s0[i]; v[4 + i] = v[4 + i] * s1[i]; } }
    if (d.f8 == 2) {
        const f32x4 cm = *(const f32x4*)(P.cmax_gu + d.drow0 + n4);
#pragma unroll
        for (int jn = 0; jn < 4; ++jn) { const float inv = inv127(cm[jn]); uint2 o; o.x = pack4_i8(v[0][jn], v[1][jn], v[2][jn], v[3][jn], inv); o.y = pack4_i8(v[4][jn], v[5][jn], v[6][jn], v[7][jn], inv);
            *(uint2*)((unsigned char*)d.WT + (size_t)(d.drow0 + n4 + jn) * d.K + d.k0 + 8 * kg) = o; }
        return; }
    if (d.f8) {
#pragma unroll
        for (int jn = 0; jn < 4; ++jn) { uint2 o; int t = 0;
            t = __builtin_amdgcn_cvt_pk_fp8_f32(v[0][jn] * WD_SCALE, v[1][jn] * WD_SCALE, t, false); t = __builtin_amdgcn_cvt_pk_fp8_f32(v[2][jn] * WD_SCALE, v[3][jn] * WD_SCALE, t, true); o.x = (unsigned)t;
            t = __builtin_amdgcn_cvt_pk_fp8_f32(v[4][jn] * WD_SCALE, v[5][jn] * WD_SCALE, t, false); t = __builtin_amdgcn_cvt_pk_fp8_f32(v[6][jn] * WD_SCALE, v[7][jn] * WD_SCALE, t, true); o.y = (unsigned)t;
            *(uint2*)((unsigned char*)d.WT + (size_t)(d.drow0 + n4 + jn) * d.K + d.k0 + 8 * kg) = o; }
        return; }
#pragma unroll
    for (int jn = 0; jn < 4; ++jn) { u32x4 o; o.x = pk2(v[0][jn], v[1][jn]); o.y = pk2(v[2][jn], v[3][jn]); o.z = pk2(v[4][jn], v[5][jn]); o.w = pk2(v[6][jn], v[7][jn]);
        *(u32x4*)(d.WT + (size_t)(d.drow0 + n4 + jn) * d.K + d.k0 + 8 * kg) = o; }
}
}

namespace hg {
typedef short bf16x8 __attribute__((ext_vector_type(8)));
typedef short s16x4 __attribute__((ext_vector_type(4)));
typedef short v4i16_t __attribute__((ext_vector_type(4)));
typedef float f32x16 __attribute__((ext_vector_type(16)));
typedef float f32x4 __attribute__((ext_vector_type(4)));
typedef float f32x2 __attribute__((ext_vector_type(2)));
typedef unsigned u32x4 __attribute__((ext_vector_type(4)));
typedef unsigned u32x2 __attribute__((ext_vector_type(2)));
#define HG_LAS __attribute__((address_space(3)))
constexpr int SET = 58368, O_QS = 0, O_KS = 16384, O_KD = 32768, O_V = 49152, O_EM = 57344, O_DL = 57856;
constexpr int L_TOT = 2 * SET, L_SLAB = L_TOT + 2048, L_END = L_SLAB + 16384;
__device__ __forceinline__ unsigned cvtpk(float lo, float hi) { typedef float f2_ __attribute__((ext_vector_type(2))); typedef __bf16 b2_ __attribute__((ext_vector_type(2))); const f2_ v = {lo, hi}; return __builtin_bit_cast(unsigned, __builtin_convertvector(v, b2_)); }
__device__ __forceinline__ float bf_lo(unsigned u) { return __uint_as_float(u << 16); }
__device__ __forceinline__ float bf_hi(unsigned u) { return __uint_as_float(u & 0xffff0000u); }
__device__ __forceinline__ float h_lo(unsigned u) { return (float)__builtin_bit_cast(_Float16, (unsigned short)(u & 0xffffu)); }
__device__ __forceinline__ float h_hi(unsigned u) { return (float)__builtin_bit_cast(_Float16, (unsigned short)(u >> 16)); }
__device__ __forceinline__ s16x4 vtr(const HG_LAS unsigned char* p) { return __builtin_bit_cast(s16x4, __builtin_amdgcn_ds_read_tr16_b64_v4i16((HG_LAS v4i16_t*)p)); }
__device__ __forceinline__ bf16x8 pk8(const f32x16& x, int b) {
    u32x4 w; w.x = cvtpk(x[b], x[b + 1]); w.y = cvtpk(x[b + 2], x[b + 3]); w.z = cvtpk(x[b + 4], x[b + 5]); w.w = cvtpk(x[b + 6], x[b + 7]); return __builtin_bit_cast(bf16x8, w); }
__device__ __forceinline__ bf16x8 cat8(s16x4 lo, s16x4 hi) { return (bf16x8){lo[0], lo[1], lo[2], lo[3], hi[0], hi[1], hi[2], hi[3]}; }
__device__ __forceinline__ bf16x8 perm_frag(const HG_LAS unsigned char* mat, int row, int ch, int hi) {
    const HG_LAS unsigned char* p = mat + row * 256 + 8 * hi;
    const u32x2 lo = *(const HG_LAS u32x2*)(p + ((ch ^ (row & 15)) << 4)), hh = *(const HG_LAS u32x2*)(p + (((ch + 1) ^ (row & 15)) << 4));
    return __builtin_bit_cast(bf16x8, (u32x4){lo.x, lo.y, hh.x, hh.y});
}

__device__ __forceinline__ void hgrn_item(HG_LAS unsigned char* lds, const u16* __restrict__ PROJ, u16* __restrict__ ODIR, int item, int tid, const bg::Ptrs& BP, int& bgj, int gcw, int NCW) {
    const int lane = tid & 63, w = __builtin_amdgcn_readfirstlane(tid >> 6), hi = lane >> 5, c32 = lane & 31;
    const int vh = item & 1, dir = (item >> 1) & 1, h = (item >> 2) & 7, b = item >> 5;
    const bool prod = w < 4; const int pw = w & 3;
    const size_t rowbase = (size_t)b * SEQ;
    const int cq = h * 128 + 2 * lane, cf = 2048 + dir * 1024 + h * 128 + 2 * lane;
    const int pt = pw * 64 + lane, vs = pt >> 2, vc = (pt & 3) * 2, cv = 1024 + h * 128 + vh * 64 + vc * 8;
    const int jb = pw & 1, kh = pw >> 1;
    const int trb = (4 * hi + ((lane & 15) >> 2)) * 64 + ((lane >> 4) & 1) * 32 + (lane & 3) * 8;
    f32x16 R0, R1, R2, R3; bg::f32x4 bgv[4], bgx[8];
#pragma unroll
    for (int r = 0; r < 16; ++r) { R0[r] = 0.f; R1[r] = 0.f; }
#define S0 R0
#define S1 R1
#define oown R2
#define ooth R3
#define FU(x) __float_as_uint(x)
#define UF(x) __uint_as_float(x)
#define HG_TOK(c, i) (dir ? (SEQ - 1 - (64 * (c) + (i))) : (64 * (c) + (i)))
    const unsigned rb8 = (unsigned)(rowbase * 8192);
#define HG_LOAD(c) do { _Pragma("unroll") for (int r = 0; r < 16; ++r) { const unsigned ro = rb8 + (unsigned)HG_TOK(c, 16 * pw + r) * 8192u; R0[r] = *(const float*)(PROJ + (ro + cq)); R1[r] = *(const float*)(PROJ + (ro + cf)); } \
        { const unsigned vo_ = rb8 + (unsigned)HG_TOK(c, vs) * 8192u + cv; bgv[2] = *(const bg::f32x4*)(PROJ + vo_); bgv[3] = *(const bg::f32x4*)(PROJ + (vo_ + 8)); } } while (0)
    if (prod) HG_LOAD(0);
    HG_LAS float* tot = (HG_LAS float*)(lds + L_TOT);
    constexpr int NC = SEQ / 64;
    if (prod) {
        for (int c = 0; c <= NC + 1; ++c) {
            HG_LAS unsigned char* ps = lds + (c & 1) * SET;
            const int bgq = bgj * NCW + gcw; const bool bgdo = c < NC && bgq < bg::NBG && ((((c + 1) * 8) >> 5) != ((c * 8) >> 5));
            if (c < NC) {
                R2 = R0; R3 = R1; bgv[0] = bgv[2]; bgv[1] = bgv[3];
                if (c + 1 < NC) { int lq = lane; asm volatile("" : "+v"(lq));
                    const int cq = h * 128 + 2 * lq, cf = 2048 + dir * 1024 + h * 128 + 2 * lq, pt = pw * 64 + lq, vs = pt >> 2, cv = 1024 + h * 128 + vh * 64 + (pt & 3) * 16;
                    HG_LOAD(c + 1); }
                float a0 = 0.f, a1 = 0.f;
#pragma unroll
                for (int r = 0; r < 16; ++r) { a0 += h_lo(FU(R3[r])); a1 += h_hi(FU(R3[r])); }
                *(HG_LAS f32x2*)(tot + pw * 128 + 2 * lane) = (f32x2){a0, a1};
                if (bgdo) bg::load(BP, bgq, lane, bgx);
            }
            __syncthreads();
            if (c < NC) {
                float p0 = 0.f, p1 = 0.f, m0 = 0.f, m1 = 0.f, t0 = 0.f, t1 = 0.f;
#pragma unroll
                for (int ww = 0; ww < 4; ++ww) { const f32x2 x = *(const HG_LAS f32x2*)(tot + ww * 128 + 2 * lane);
                    if (ww < pw) { p0 += x.x; p1 += x.y; } if (ww < 2) { m0 += x.x; m1 += x.y; } t0 += x.x; t1 += x.y; }
                const float El0 = __builtin_amdgcn_exp2f(t0 - m0), El1 = __builtin_amdgcn_exp2f(t1 - m1);
                if (pw == 0) { *(HG_LAS f32x2*)(ps + O_EM + 8 * lane) = (f32x2){__builtin_amdgcn_exp2f(m0), __builtin_amdgcn_exp2f(m1)};
                               *(HG_LAS f32x2*)(ps + O_DL + 8 * lane) = (f32x2){__builtin_amdgcn_exp2f(t0), __builtin_amdgcn_exp2f(t1)}; }
                const float x0 = __builtin_fminf(__builtin_fmaxf(p0 - m0, -56.f), 56.f), x1 = __builtin_fminf(__builtin_fmaxf(p1 - m1, -56.f), 56.f);
                float e0 = __builtin_amdgcn_exp2f(x0), e1 = __builtin_amdgcn_exp2f(x1), g0 = __builtin_amdgcn_exp2f(-x0), g1 = __builtin_amdgcn_exp2f(-x1);
                int lno = lane; asm volatile("" : "+v"(lno));
#pragma unroll
                for (int r = 0; r < 16; ++r) {
                    const int i = 16 * pw + r;
                    const float lf0 = h_lo(FU(R3[r])), lf1 = h_hi(FU(R3[r]));
                    const float f0 = __builtin_amdgcn_exp2f(lf0), f1 = __builtin_amdgcn_exp2f(lf1), fi0 = __builtin_amdgcn_exp2f(-lf0), fi1 = __builtin_amdgcn_exp2f(-lf1);
                    e0 *= f0; e1 *= f1; g0 *= fi0; g1 *= fi1;
                    const float qs0 = bf_lo(FU(R2[r])) * e0, qs1 = bf_hi(FU(R2[r])) * e1, ks0 = (1.0f - f0) * g0, ks1 = (1.0f - f1) * g1;
                    const int sw = i * 256 + ((((lno >> 2) ^ (i & 15))) << 4) + (lno & 3) * 4;
                    *(HG_LAS unsigned*)(ps + O_QS + sw) = cvtpk(qs0, qs1);
                    *(HG_LAS unsigned*)(ps + O_KS + sw) = cvtpk(ks0, ks1);
                    *(HG_LAS unsigned*)(ps + O_KD + (((lno >> 4) * 4 + (i >> 4)) * 1024) + (i & 15) * 64 + (lno & 15) * 4) = cvtpk(ks0 * El0, ks1 * El1);
                }
                { const int pt = pw * 64 + lno, vs = pt >> 2, vc = (pt & 3) * 2;
                  HG_LAS unsigned char* vd = ps + O_V + (((vc >> 2) * 4 + (vs >> 4)) * 1024) + (vs & 15) * 64 + (vc & 3) * 16;
                  *(HG_LAS bg::f32x4*)vd = bgv[0]; *(HG_LAS bg::f32x4*)(vd + 16) = bgv[1]; }
                if (bgdo) { bg::store(BP, bgq, lane, bgx); ++bgj; }
            }
            __syncthreads();
        }
    } else {
        for (int c = 0; c <= NC + 1; ++c) {
            const HG_LAS unsigned char* cs = lds + ((c + 1) & 1) * SET;
            int lnc = lane; asm volatile("" : "+v"(lnc));
            const int hi = lnc >> 5, c32 = lnc & 31, trb = (4 * hi + ((lnc & 15) >> 2)) * 64 + ((lnc >> 4) & 1) * 32 + (lnc & 3) * 8;
            if (c >= 2) {
            const HG_LAS float* slab = (const HG_LAS float*)(lds + L_SLAB) + (jb * 2 + (kh ^ 1)) * 1024 + lnc;
            const unsigned oo = (unsigned)(((size_t)dir * M + rowbase) * 1024) + h * 128 + vh * 64 + jb * 32 + c32;
#pragma unroll
            for (int r = 0; r < 16; ++r) { const int i = kh * 32 + (r & 3) + 8 * (r >> 2) + 4 * hi; const float v = oown[r] + slab[r * 64];
                ODIR[oo + (unsigned)HG_TOK(c - 2, i) * 1024u] = (u16)(cvtpk(v, v) & 0xffffu); }
            }
            __syncthreads();
            if (c >= 1 && c <= NC) {
#pragma unroll
            for (int r = 0; r < 16; ++r) { oown[r] = 0.f; ooth[r] = 0.f; }
            const int rown = kh * 32 + c32, roth = (1 - kh) * 32 + c32, c32o = c32, trbo = trb;
#define HG_SB() __builtin_amdgcn_sched_barrier(0)
            bf16x8 qa[2][2][2], sbf[2][2];
            { f32x4 em[2][4];
#pragma unroll
              for (int t2 = 0; t2 < 2; ++t2) {
#pragma unroll
                for (int g = 0; g < 4; ++g) em[t2][g] = *(const HG_LAS f32x4*)(cs + O_EM + ((2 * kh + t2) * 32 + 8 * g + 4 * hi) * 4);
#pragma unroll
                for (int sp = 0; sp < 2; ++sp) { const int ch = (2 * kh + t2) * 4 + 2 * sp; qa[t2][sp][0] = perm_frag(cs + O_QS, rown, ch, hi); qa[t2][sp][1] = perm_frag(cs + O_QS, roth, ch, hi); } }
              HG_SB();
#pragma unroll
              for (int t2 = 0; t2 < 2; ++t2) { f32x16 Sx = t2 ? S1 : S0;
#pragma unroll
                for (int g = 0; g < 4; ++g) { Sx[4 * g] *= em[t2][g][0]; Sx[4 * g + 1] *= em[t2][g][1]; Sx[4 * g + 2] *= em[t2][g][2]; Sx[4 * g + 3] *= em[t2][g][3]; }
                sbf[t2][0] = pk8(Sx, 0); sbf[t2][1] = pk8(Sx, 8); } }
            HG_SB();
            bf16x8 dk[8], dq[8];
            const HG_LAS unsigned char* dksp = cs + O_KS + rown * 256; const HG_LAS unsigned char* dqsp = cs + O_QS + rown * 256;
#pragma unroll
            for (int st = 0; st < 4; ++st) { const int ch = 2 * st + hi; dk[st] = *(const HG_LAS bf16x8*)(dksp + ((ch ^ (rown & 15)) << 4)); dq[st] = *(const HG_LAS bf16x8*)(dqsp + ((ch ^ (rown & 15)) << 4)); }
            HG_SB();
#pragma unroll
            for (int t2 = 0; t2 < 2; ++t2)
#pragma unroll
                for (int sp = 0; sp < 2; ++sp) {
                    oown = __builtin_amdgcn_mfma_f32_32x32x16_bf16(qa[t2][sp][0], sbf[t2][sp], oown, 0, 0, 0);
                    ooth = __builtin_amdgcn_mfma_f32_32x32x16_bf16(qa[t2][sp][1], sbf[t2][sp], ooth, 0, 0, 0); }
            HG_SB();
#pragma unroll
            for (int st = 4; st < 8; ++st) { const int ch = 2 * st + hi; dk[st] = *(const HG_LAS bf16x8*)(dksp + ((ch ^ (rown & 15)) << 4)); dq[st] = *(const HG_LAS bf16x8*)(dqsp + ((ch ^ (rown & 15)) << 4)); }
            HG_SB();
            f32x16 X;
#pragma unroll
            for (int r = 0; r < 16; ++r) X[r] = 0.f;
#pragma unroll
            for (int st = 0; st < 4; ++st) X = __builtin_amdgcn_mfma_f32_32x32x16_bf16(dk[st], dq[st], X, 0, 0, 0);
            HG_SB();
            bf16x8 vf[4], ok[4], oq[4];
#pragma unroll
            for (int ks = 0; ks < 4; ++ks) { const HG_LAS unsigned char* vp = cs + O_V + (jb * 4 + ks) * 1024 + trbo; vf[ks] = cat8(vtr(vp), vtr(vp + 512)); }
            { const int rs = c32o, ri = 32 + c32o; const HG_LAS unsigned char* ksp = cs + O_KS + rs * 256; const HG_LAS unsigned char* qsp = cs + O_QS + ri * 256;
#pragma unroll
              for (int st = 0; st < 4; ++st) { const int ch = 2 * (4 * kh + st) + hi; ok[st] = *(const HG_LAS bf16x8*)(ksp + ((ch ^ (rs & 15)) << 4)); oq[st] = *(const HG_LAS bf16x8*)(qsp + ((ch ^ (ri & 15)) << 4)); } }
            HG_SB();
#pragma unroll
            for (int st = 4; st < 8; ++st) X = __builtin_amdgcn_mfma_f32_32x32x16_bf16(dk[st], dq[st], X, 0, 0, 0);
#pragma unroll
            for (int r = 0; r < 16; ++r) { const int sl = (r & 3) + 8 * (r >> 2) + 4 * hi; X[r] = (sl <= c32) ? X[r] : 0.f; }
            if (kh) { oown = __builtin_amdgcn_mfma_f32_32x32x16_bf16(pk8(X, 0), vf[2], oown, 0, 0, 0); oown = __builtin_amdgcn_mfma_f32_32x32x16_bf16(pk8(X, 8), vf[3], oown, 0, 0, 0); }
            else    { oown = __builtin_amdgcn_mfma_f32_32x32x16_bf16(pk8(X, 0), vf[0], oown, 0, 0, 0); oown = __builtin_amdgcn_mfma_f32_32x32x16_bf16(pk8(X, 8), vf[1], oown, 0, 0, 0); }
            HG_SB();
            f32x4 dl0[4]; bf16x8 kd0[4];
#pragma unroll
            for (int g = 0; g < 4; ++g) dl0[g] = *(const HG_LAS f32x4*)(cs + O_DL + ((2 * kh) * 32 + 8 * g + 4 * hi) * 4);
#pragma unroll
            for (int ks = 0; ks < 4; ++ks) { const HG_LAS unsigned char* kp = cs + O_KD + ((2 * kh) * 4 + ks) * 1024 + trbo; kd0[ks] = cat8(vtr(kp), vtr(kp + 512)); }
            HG_SB();
#pragma unroll
            for (int r = 0; r < 16; ++r) X[r] = 0.f;
#pragma unroll
            for (int st = 0; st < 4; ++st) X = __builtin_amdgcn_mfma_f32_32x32x16_bf16(ok[st], oq[st], X, 0, 0, 0);
            if (kh) { oown = __builtin_amdgcn_mfma_f32_32x32x16_bf16(pk8(X, 0), vf[0], oown, 0, 0, 0); oown = __builtin_amdgcn_mfma_f32_32x32x16_bf16(pk8(X, 8), vf[1], oown, 0, 0, 0); }
            else    { ooth = __builtin_amdgcn_mfma_f32_32x32x16_bf16(pk8(X, 0), vf[0], ooth, 0, 0, 0); ooth = __builtin_amdgcn_mfma_f32_32x32x16_bf16(pk8(X, 8), vf[1], ooth, 0, 0, 0); }
            HG_SB();
            f32x4 dl1[4]; bf16x8 kd1[4];
#pragma unroll
            for (int g = 0; g < 4; ++g) dl1[g] = *(const HG_LAS f32x4*)(cs + O_DL + ((2 * kh + 1) * 32 + 8 * g + 4 * hi) * 4);
#pragma unroll
            for (int ks = 0; ks < 4; ++ks) { const HG_LAS unsigned char* kp = cs + O_KD + ((2 * kh + 1) * 4 + ks) * 1024 + trbo; kd1[ks] = cat8(vtr(kp), vtr(kp + 512)); }
            HG_SB();
#pragma unroll
            for (int g = 0; g < 4; ++g) { S0[4 * g] *= dl0[g][0]; S0[4 * g + 1] *= dl0[g][1]; S0[4 * g + 2] *= dl0[g][2]; S0[4 * g + 3] *= dl0[g][3]; }
#pragma unroll
            for (int ks = 0; ks < 4; ++ks) S0 = __builtin_amdgcn_mfma_f32_32x32x16_bf16(kd0[ks], vf[ks], S0, 0, 0, 0);
#pragma unroll
            for (int g = 0; g < 4; ++g) { S1[4 * g] *= dl1[g][0]; S1[4 * g + 1] *= dl1[g][1]; S1[4 * g + 2] *= dl1[g][2]; S1[4 * g + 3] *= dl1[g][3]; }
#pragma unroll
            for (int ks = 0; ks < 4; ++ks) S1 = __builtin_amdgcn_mfma_f32_32x32x16_bf16(kd1[ks], vf[ks], S1, 0, 0, 0);
#undef HG_SB
            { HG_LAS float* slab = (HG_LAS float*)(lds + L_SLAB) + (jb * 2 + kh) * 1024 + lnc;
#pragma unroll
              for (int r = 0; r < 16; ++r) slab[r * 64] = ooth[r]; }
            }
            __syncthreads();
        }
    }
#undef HG_TOK
#undef HG_LOAD
#undef S0
#undef S1
#undef oown
#undef ooth
#undef FU
#undef UF
}
}

namespace at {
typedef short bf16x8 __attribute__((ext_vector_type(8)));
typedef short s16x4 __attribute__((ext_vector_type(4)));
typedef short v4i16_t __attribute__((ext_vector_type(4)));
typedef float f32x16 __attribute__((ext_vector_type(16)));
typedef float f32x4 __attribute__((ext_vector_type(4)));
typedef unsigned u32x4 __attribute__((ext_vector_type(4)));
#define AT_LAS __attribute__((address_space(3)))
constexpr int L_K = 0, L_V = 16384, L_WS = 65536, L_LUT = 66560, L_END = 67584;
constexpr float THR = 8.0f;
__device__ __forceinline__ unsigned cvtpk(float lo, float hi) { typedef float f2_ __attribute__((ext_vector_type(2))); typedef __bf16 b2_ __attribute__((ext_vector_type(2))); const f2_ v = {lo, hi}; return __builtin_bit_cast(unsigned, __builtin_convertvector(v, b2_)); }
__device__ __forceinline__ s16x4 vtr(const AT_LAS unsigned char* p) { return __builtin_bit_cast(s16x4, __builtin_amdgcn_ds_read_tr16_b64_v4i16((AT_LAS v4i16_t*)p)); }
__device__ __forceinline__ bf16x8 pk8(const f32x16& x, int b) {
    u32x4 w; w.x = cvtpk(x[b], x[b + 1]); w.y = cvtpk(x[b + 2], x[b + 3]); w.z = cvtpk(x[b + 4], x[b + 5]); w.w = cvtpk(x[b + 6], x[b + 7]); return __builtin_bit_cast(bf16x8, w); }
__device__ __forceinline__ bf16x8 cat8(s16x4 lo, s16x4 hi) { return (bf16x8){lo[0], lo[1], lo[2], lo[3], hi[0], hi[1], hi[2], hi[3]}; }
__device__ __forceinline__ float max3f(float a, float b, float c) { float r; asm("v_max3_f32 %0, %1, %2, %3" : "=v"(r) : "v"(a), "v"(b), "v"(c)); return r; }
__device__ __forceinline__ int rel_bucket(int rel) {
    const int n = rel < 0 ? -rel : rel; int bk;
    if (n < 8) bk = n; else if (n < 12) bk = 8; else if (n < 16) bk = 9; else if (n < 23) bk = 10; else if (n < 32) bk = 11;
    else if (n < 46) bk = 12; else if (n < 64) bk = 13; else if (n < 91) bk = 14; else bk = 15;
    return bk + (rel > 0 ? 16 : 0);
}

__device__ __forceinline__ void attn_unit(AT_LAS unsigned char* lds, const u16* __restrict__ PROJ, const float* __restrict__ relb, float* O1, u16* __restrict__ CAT, const float* __restrict__ subw,
                                          float lam, int b, int h, int qb, int mp, int tid) {
    const int lane = tid & 63, w = __builtin_amdgcn_readfirstlane(tid >> 6), hi = lane >> 5, c32 = lane & 31;
    const size_t rowbase = (size_t)b * SEQ;
    const int q0w = qb * 256 + w * 32;
    AT_LAS float* wsf = (AT_LAS float*)(lds + L_WS) + w * 32;
    AT_LAS float* lut = (AT_LAS float*)(lds + L_LUT);
    if (tid < 183) lut[tid] = relb[rel_bucket(tid - 91) * 8 + h] * 1.4426950408889634f;
    const float bias_neg = relb[15 * 8 + h] * 1.4426950408889634f, bias_pos = relb[31 * 8 + h] * 1.4426950408889634f;
    bf16x8 qf[4];
    { const unsigned qo = (unsigned)((rowbase + q0w + c32) * 8192 + 5120 + h * 128 + mp * 64 + 8 * hi);
#pragma unroll
      for (int st = 0; st < 4; ++st) qf[st] = *(const bf16x8*)(PROJ + (qo + 16 * st)); }
    f32x16 o[4];
#pragma unroll
    for (int d = 0; d < 4; ++d)
#pragma unroll
        for (int r = 0; r < 16; ++r) o[d][r] = 0.f;
    float mhat = 0.f, l = 0.f;
    const int krow = 8 * w + (lane >> 3), kch = (lane & 7) ^ ((krow >> 1) & 7);
    const unsigned kgo = (unsigned)((rowbase + krow) * 8192 + 6144 + h * 128 + mp * 64 + 8 * kch);
    const int vrow = ((2 * w) & 3) * 16 + (lane >> 2);
    const unsigned vgo = (unsigned)((rowbase + vrow) * 8192 + 7168 + h * 128 + (w >> 1) * 32 + (lane & 3) * 8);
    const int trb = (4 * hi + ((lane & 15) >> 2)) * 64 + ((lane >> 4) & 1) * 32 + (lane & 3) * 8;
#define AT_STAGE(t_, ks_, vs_) do { const unsigned go_ = (unsigned)(t_) * 64u * 8192u; \
        __builtin_amdgcn_global_load_lds((const unsigned*)(PROJ + (kgo + go_)), (AT_LAS unsigned*)(lds + L_K + (ks_) * 8192 + w * 1024), 16, 0, 0); \
        __builtin_amdgcn_global_load_lds((const unsigned*)(PROJ + (vgo + go_)), (AT_LAS unsigned*)(lds + L_V + (vs_) * 16384 + (2 * w) * 1024), 16, 0, 0); \
        __builtin_amdgcn_global_load_lds((const unsigned*)(PROJ + (vgo + go_ + 16u * 8192u)), (AT_LAS unsigned*)(lds + L_V + (vs_) * 16384 + (2 * w + 1) * 1024), 16, 0, 0); } while (0)
    AT_STAGE(0, 0, 0);
    asm volatile("s_waitcnt vmcnt(0)" ::: "memory");
    __syncthreads();
    constexpr int NT = SEQ / 64;
    const bool late = w >= 4;
    bf16x8 pa0, pa1, pa2, pa3, va_[4], vb_[4]; f32x16 p0, p1;
#define AT_VF(dst, VB, d) do { const AT_LAS unsigned char* vp_ = (VB) + (d) * 4096 + trb; \
        _Pragma("unroll") for (int k_ = 0; k_ < 4; ++k_) dst[k_] = cat8(vtr(vp_ + k_ * 1024), vtr(vp_ + k_ * 1024 + 512)); } while (0)
#define AT_MM(d, vf) do { o[d] = __builtin_amdgcn_mfma_f32_32x32x16_bf16(pa0, vf[0], o[d], 0, 0, 0); o[d] = __builtin_amdgcn_mfma_f32_32x32x16_bf16(pa1, vf[1], o[d], 0, 0, 0); \
        o[d] = __builtin_amdgcn_mfma_f32_32x32x16_bf16(pa2, vf[2], o[d], 0, 0, 0); o[d] = __builtin_amdgcn_mfma_f32_32x32x16_bf16(pa3, vf[3], o[d], 0, 0, 0); } while (0)
#define AT_SB() __builtin_amdgcn_sched_barrier(0)
#define AT_VPRE(VB) do { AT_SB(); AT_VF(va_, VB, 0); AT_VF(vb_, VB, 1); AT_SB(); } while (0)
#define AT_PV(VB) do { AT_SB(); AT_MM(0, va_); AT_SB(); AT_VF(va_, VB, 2); AT_SB(); AT_MM(1, vb_); AT_SB(); AT_VF(vb_, VB, 3); AT_SB(); AT_MM(2, va_); AT_SB(); AT_MM(3, vb_); AT_SB(); } while (0)
#define AT_QK(tt) do { const AT_LAS unsigned char* Kb = lds + L_K + ((tt) & 1) * 8192; \
        const int kv0_ = 64 * (tt), far_ = (kv0_ - (q0w + 31) >= 91) ? 1 : ((kv0_ + 63 - q0w <= -91) ? -1 : 0); \
        const float ini = (far_ > 0 ? bias_pos : (far_ < 0 ? bias_neg : 0.f)) - mhat; \
        _Pragma("unroll") for (int r = 0; r < 16; ++r) { p0[r] = ini; p1[r] = ini; } \
        const int r0 = c32, r1 = 32 + c32; bf16x8 ka[4], kb[4]; \
        _Pragma("unroll") for (int st = 0; st < 4; ++st) { const int ch = 2 * st + hi; \
            ka[st] = *(const AT_LAS bf16x8*)(Kb + r0 * 128 + ((ch ^ ((r0 >> 1) & 7)) << 4)); kb[st] = *(const AT_LAS bf16x8*)(Kb + r1 * 128 + ((ch ^ ((r1 >> 1) & 7)) << 4)); } \
        _Pragma("unroll") for (int st = 0; st < 4; ++st) { p0 = __builtin_amdgcn_mfma_f32_32x32x16_bf16(ka[st], qf[st], p0, 0, 0, 0); p1 = __builtin_amdgcn_mfma_f32_32x32x16_bf16(kb[st], qf[st], p1, 0, 0, 0); } } while (0)
#define AT_SM(tt) do { const int kv0_ = 64 * (tt); const bool band_ = !(kv0_ - (q0w + 31) >= 91) && !(kv0_ + 63 - q0w <= -91); \
        if (band_) { const int rb = kv0_ + 4 * hi - (q0w + c32) + 91; \
            _Pragma("unroll") for (int r = 0; r < 16; ++r) { const int i0 = rb + (r & 3) + 8 * (r >> 2), i1 = i0 + 32; \
                p0[r] += lut[i0 < 0 ? 0 : (i0 > 182 ? 182 : i0)]; p1[r] += lut[i1 < 0 ? 0 : (i1 > 182 ? 182 : i1)]; } } \
        float rm, rm2;                                             \
        rm = max3f(p0[0], p0[1], p1[0]); rm2 = max3f(p0[2], p0[3], p1[1]); rm = max3f(rm, p1[2], p1[3]); \
        _Pragma("unroll") for (int r = 4; r < 16; r += 4) { rm = max3f(rm, p0[r], p0[r + 1]); rm2 = max3f(rm2, p0[r + 2], p0[r + 3]); rm = max3f(rm, p1[r], p1[r + 1]); rm2 = max3f(rm2, p1[r + 2], p1[r + 3]); } \
        rm = __builtin_fmaxf(rm, rm2); \
        { const auto rr = __builtin_amdgcn_permlane32_swap(__float_as_uint(rm), __float_as_uint(rm), false, false); rm = __builtin_fmaxf(__uint_as_float(rr[0]), __uint_as_float(rr[1])); } \
        if ((tt) == 0 || __any(rm > THR)) { \
            const float dl = ((tt) == 0) ? rm : __builtin_fmaxf(rm, 0.f); \
            mhat += dl; \
            _Pragma("unroll") for (int r = 0; r < 16; ++r) { p0[r] -= dl; p1[r] -= dl; } \
            if ((tt) > 0) { const float f = __builtin_amdgcn_exp2f(-dl); l *= f; \
                if (hi == 0) wsf[c32] = f; \
                asm volatile("s_waitcnt lgkmcnt(0)" ::: "memory"); \
                _Pragma("unroll") for (int g = 0; g < 4; ++g) { const f32x4 fv = *(const AT_LAS f32x4*)(wsf + 8 * g + 4 * hi); \
                    _Pragma("unroll") for (int d = 0; d < 4; ++d) { o[d][4 * g] *= fv[0]; o[d][4 * g + 1] *= fv[1]; o[d][4 * g + 2] *= fv[2]; o[d][4 * g + 3] *= fv[3]; } } } } \
        float ls = 0.f; \
        _Pragma("unroll") for (int r = 0; r < 16; ++r) { p0[r] = __builtin_amdgcn_exp2f(p0[r]); p1[r] = __builtin_amdgcn_exp2f(p1[r]); ls += p0[r] + p1[r]; } \
        l += ls; \
        pa0 = pk8(p0, 0); pa1 = pk8(p0, 8); pa2 = pk8(p1, 0); pa3 = pk8(p1, 8); } while (0)
#define AT_END() do { vprev = vslot; vslot = (vslot == 2) ? 0 : vslot + 1; \
        asm volatile("s_waitcnt vmcnt(0)" ::: "memory");            \
        __syncthreads(); } while (0)
    int vslot = 0, vprev = 0;
    if (!late) {
        for (int t = 0; t < NT; ++t) {
            if (t + 1 < NT) { AT_STAGE(t + 1, (t + 1) & 1, (vslot == 2) ? 0 : vslot + 1); }
            AT_QK(t); AT_VPRE(lds + L_V + vslot * 16384); AT_SM(t); AT_PV(lds + L_V + vslot * 16384);
            AT_END();
        }
    } else {
        for (int t = 0; t < NT; ++t) {
            if (t + 1 < NT) { AT_STAGE(t + 1, (t + 1) & 1, (vslot == 2) ? 0 : vslot + 1); }
            if (t > 0) { AT_PV(lds + L_V + vprev * 16384); }
            AT_QK(t); AT_SM(t); AT_VPRE(lds + L_V + vslot * 16384);
            AT_END();
        }
        AT_PV(lds + L_V + vprev * 16384);
    }
#undef AT_QK
#undef AT_SM
#undef AT_END
#undef AT_VPRE
#undef AT_PV
#undef AT_VPRE
#undef AT_VF
#undef AT_SB
#undef AT_MM
#undef AT_STAGE
    l += __shfl_xor(l, 32);
    if (hi == 0) wsf[c32] = __builtin_amdgcn_rcpf(l);
    asm volatile("s_waitcnt lgkmcnt(0)" ::: "memory");
    float rl[16];
#pragma unroll
    for (int g = 0; g < 4; ++g) { const f32x4 fv = *(const AT_LAS f32x4*)(wsf + 8 * g + 4 * hi); rl[4 * g] = fv[0]; rl[4 * g + 1] = fv[1]; rl[4 * g + 2] = fv[2]; rl[4 * g + 3] = fv[3]; }
    unsigned oo = (unsigned)((rowbase + q0w + 4 * hi) * 1024 + h * 128 + c32);
    if (mp == 0) {
#pragma unroll
        for (int r = 0; r < 16; ++r) { unsigned ro = oo + (unsigned)(((r & 3) + 8 * (r >> 2)) * 1024); asm volatile("" : "+v"(ro));
#pragma unroll
            for (int d = 0; d < 4; ++d) O1[ro + d * 32] = o[d][r] * rl[r]; }
    } else {
        float sw[4];
#pragma unroll
        for (int d = 0; d < 4; ++d) sw[d] = subw[d * 32 + c32] * 0.8f;
        const unsigned co = (unsigned)((rowbase + q0w + 4 * hi) * 2048 + 1024 + h * 128 + c32);
#pragma unroll
        for (int r = 0; r < 16; ++r) { unsigned ro = oo + (unsigned)(((r & 3) + 8 * (r >> 2)) * 1024), rc = co + (unsigned)(((r & 3) + 8 * (r >> 2)) * 2048); asm volatile("" : "+v"(ro), "+v"(rc));
            float x[4]; float ss = 0.f;
#pragma unroll
            for (int d = 0; d < 4; ++d) { x[d] = O1[ro + d * 32] - lam * (o[d][r] * rl[r]); ss += x[d] * x[d]; }
            ss += __shfl_xor(ss, 1); ss += __shfl_xor(ss, 2); ss += __shfl_xor(ss, 4); ss += __shfl_xor(ss, 8); ss += __shfl_xor(ss, 16);
            const float rr = __builtin_amdgcn_rsqf(ss * (1.0f / 128.0f) + 1e-6f);
#pragma unroll
            for (int d = 0; d < 4; ++d) CAT[rc + d * 32] = (u16)(cvtpk(x[d] * rr * sw[d], 0.f) & 0xffffu); }
    }
}
}

__device__ __forceinline__ void p0_item64(const float* W, int K, int N, const float* ksc, u16* WT, int k0, int n0, int drow0, int lane) {
    const int kg = lane >> 4, n4 = (lane & 15) * 4;
    const float* src = W + (size_t)(k0 + 8 * kg) * N + n0 + n4;
    f32x4 v[2][8];
#pragma unroll
    for (int r = 0; r < 2; ++r)
#pragma unroll
        for (int i = 0; i < 8; ++i) v[r][i] = __builtin_nontemporal_load((const f32x4*)(src + (size_t)(32 * r + i) * N));
    if (ksc) {
#pragma unroll
        for (int r = 0; r < 2; ++r) { const f32x4 s0 = *(const f32x4*)(ksc + k0 + 32 * r + 8 * kg), s1 = *(const f32x4*)(ksc + k0 + 32 * r + 8 * kg + 4);
#pragma unroll
            for (int i = 0; i < 4; ++i) { v[r][i] = v[r][i] * s0[i]; v[r][4 + i] = v[r][4 + i] * s1[i]; } }
    }
#pragma unroll
    for (int jn = 0; jn < 4; ++jn) { u16* dst = WT + (size_t)(drow0 + n4 + jn) * K + k0 + 8 * kg;
#pragma unroll
        for (int r = 0; r < 2; ++r) { v4u o; o.x = pk2(v[r][0][jn], v[r][1][jn]); o.y = pk2(v[r][2][jn], v[r][3][jn]); o.z = pk2(v[r][4][jn], v[r][5][jn]); o.w = pk2(v[r][6][jn], v[r][7][jn]);
            *(v4u*)(dst + 32 * r) = o; } }
}
__device__ __forceinline__ void p0_strip(LAS float* smax, const float* W, int N, const float* ksc, float* cmax, unsigned char* WT, int n0, int drow0, int tid) {
    const int lane = tid & 63, w = tid >> 6, g = lane & 7, kk = lane >> 3, kb = 256 * w + 32 * kk;
    const float* src = W + (size_t)kb * N + n0 + 4 * g;
    f32x4 v[32];
#pragma unroll
    for (int i = 0; i < 32; ++i) v[i] = __builtin_nontemporal_load((const f32x4*)(src + (size_t)i * N));
    if (ksc) {
#pragma unroll
        for (int i4 = 0; i4 < 8; ++i4) { const f32x4 sc = *(const f32x4*)(ksc + kb + 4 * i4);
#pragma unroll
            for (int e = 0; e < 4; ++e) v[4 * i4 + e] = v[4 * i4 + e] * sc[e]; } }
    f32x4 am = {0.f, 0.f, 0.f, 0.f};
#pragma unroll
    for (int i = 0; i < 32; ++i)
#pragma unroll
        for (int jn = 0; jn < 4; ++jn) am[jn] = fmaxf(am[jn], fabsf(v[i][jn]));
#pragma unroll
    for (int jn = 0; jn < 4; ++jn) { float a = am[jn]; a = fmaxf(a, __shfl_xor(a, 8)); a = fmaxf(a, __shfl_xor(a, 16)); a = fmaxf(a, __shfl_xor(a, 32)); am[jn] = a; }
    if (kk == 0) *(LAS f32x4*)(smax + w * 32 + 4 * g) = am;
    __syncthreads();
#pragma unroll
    for (int ww = 0; ww < 8; ++ww) { const f32x4 o = *(const LAS f32x4*)(smax + ww * 32 + 4 * g);
#pragma unroll
        for (int jn = 0; jn < 4; ++jn) am[jn] = fmaxf(am[jn], o[jn]); }
    if (w == 0 && kk == 0) *(f32x4*)(cmax + drow0 + 4 * g) = am;
#pragma unroll
    for (int jn = 0; jn < 4; ++jn) { const float inv = inv127(am[jn]); unsigned char* dst = WT + (size_t)(drow0 + 4 * g + jn) * 2048 + kb;
#pragma unroll
        for (int h = 0; h < 2; ++h) { v4u o;
            o.x = pack4_i8(v[16 * h + 0][jn], v[16 * h + 1][jn], v[16 * h + 2][jn], v[16 * h + 3][jn], inv); o.y = pack4_i8(v[16 * h + 4][jn], v[16 * h + 5][jn], v[16 * h + 6][jn], v[16 * h + 7][jn], inv);
            o.z = pack4_i8(v[16 * h + 8][jn], v[16 * h + 9][jn], v[16 * h + 10][jn], v[16 * h + 11][jn], inv); o.w = pack4_i8(v[16 * h + 12][jn], v[16 * h + 13][jn], v[16 * h + 14][jn], v[16 * h + 15][jn], inv);
            *(v4u*)(dst + 16 * h) = o; } }
}
__device__ __forceinline__ void p0_absmax64(const float* W, int N, const float* ksc, float* cmax, int k0, int n0, int drow0, int lane) {
    const int kg = lane >> 4, n4 = (lane & 15) * 4;
    const float* src = W + (size_t)(k0 + 8 * kg) * N + n0 + n4;
    f32x4 v[2][8];
#pragma unroll
    for (int r = 0; r < 2; ++r)
#pragma unroll
        for (int i = 0; i < 8; ++i) v[r][i] = *(const f32x4*)(src + (size_t)(32 * r + i) * N);
    if (ksc) {
#pragma unroll
        for (int r = 0; r < 2; ++r) { const f32x4 s0 = *(const f32x4*)(ksc + k0 + 32 * r + 8 * kg), s1 = *(const f32x4*)(ksc + k0 + 32 * r + 8 * kg + 4);
#pragma unroll
            for (int i = 0; i < 4; ++i) { v[r][i] = v[r][i] * s0[i]; v[r][4 + i] = v[r][4 + i] * s1[i]; } }
    }
#pragma unroll
    for (int jn = 0; jn < 4; ++jn) { float a = 0.f;
#pragma unroll
        for (int r = 0; r < 2; ++r)
#pragma unroll
            for (int i = 0; i < 8; ++i) a = fmaxf(a, fabsf(v[r][i][jn]));
        a = fmaxf(a, __shfl_xor(a, 16)); a = fmaxf(a, __shfl_xor(a, 32));
        if (kg == 0) atomicMax((unsigned*)(cmax + drow0 + n4 + jn), __float_as_uint(a)); }
}
__device__ __forceinline__ void p0_quant64(const float* W, int K, int N, const float* cmax, unsigned char* WT, int k0, int n0, int drow0, int lane) {
    const int kg = lane >> 4, n4 = (lane & 15) * 4;
    const float* src = W + (size_t)(k0 + 16 * kg) * N + n0 + n4;
    f32x4 v[16];
#pragma unroll
    for (int i = 0; i < 16; ++i) v[i] = __builtin_nontemporal_load((const f32x4*)(src + (size_t)i * N));
    const f32x4 cm = *(const f32x4*)(cmax + drow0 + n4);
#pragma unroll
    for (int jn = 0; jn < 4; ++jn) { const float inv = inv127(cm[jn]); v4u o;
        o.x = pack4_i8(v[0][jn], v[1][jn], v[2][jn], v[3][jn], inv); o.y = pack4_i8(v[4][jn], v[5][jn], v[6][jn], v[7][jn], inv);
        o.z = pack4_i8(v[8][jn], v[9][jn], v[10][jn], v[11][jn], inv); o.w = pack4_i8(v[12][jn], v[13][jn], v[14][jn], v[15][jn], inv);
        *(v4u*)(WT + (size_t)(drow0 + n4 + jn) * K + k0 + 16 * kg) = o; }
}
__device__ __forceinline__ void rms_row_to_bf16(const float* xrow, const float* w, u16* orow, int lane) {
    const f32x4* xr = (const f32x4*)xrow + lane;
    f32x4 v[8]; float s = 0.f;
#pragma unroll
    for (int j = 0; j < 8; ++j) { v[j] = xr[64 * j]; s += (v[j].x * v[j].x + v[j].y * v[j].y) + (v[j].z * v[j].z + v[j].w * v[j].w); }
    const float r = __builtin_amdgcn_rsqf(wave_sum(s) * (1.0f / DM) + EPS);
    const f32x4* wr = (const f32x4*)w + lane;
    uint2* o = (uint2*)orow + lane;
#pragma unroll
    for (int j = 0; j < 8; ++j) { const f32x4 ww = wr[64 * j]; uint2 p; p.x = pk2(v[j].x * r * ww.x, v[j].y * r * ww.y); p.y = pk2(v[j].z * r * ww.z, v[j].w * r * ww.w); o[64 * j] = p; }
}
__device__ __forceinline__ void rms_row_from_bf16(const u16* xrow, const float* w, float* orow, int lane) {
    const v4u* xr = (const v4u*)xrow + lane;
    v4u v[4]; float s = 0.f;
#pragma unroll
    for (int j = 0; j < 4; ++j) { v[j] = __builtin_nontemporal_load(xr + 64 * j);
#pragma unroll
        for (int e = 0; e < 4; ++e) { const float a = __uint_as_float(v[j][e] << 16), b = __uint_as_float(v[j][e] & 0xffff0000u); s += a * a + b * b; } }
    const float r = __builtin_amdgcn_rsqf(wave_sum(s) * (1.0f / DM) + EPS);
#pragma unroll
    for (int j = 0; j < 4; ++j) { const int c = (64 * j + lane) * 8; const f32x4 w0 = *(const f32x4*)(w + c), w1 = *(const f32x4*)(w + c + 4);
        f32x4 o0, o1;
        o0[0] = __uint_as_float(v[j][0] << 16) * r * w0[0]; o0[1] = __uint_as_float(v[j][0] & 0xffff0000u) * r * w0[1]; o0[2] = __uint_as_float(v[j][1] << 16) * r * w0[2]; o0[3] = __uint_as_float(v[j][1] & 0xffff0000u) * r * w0[3];
        o1[0] = __uint_as_float(v[j][2] << 16) * r * w1[0]; o1[1] = __uint_as_float(v[j][2] & 0xffff0000u) * r * w1[1]; o1[2] = __uint_as_float(v[j][3] << 16) * r * w1[2]; o1[3] = __uint_as_float(v[j][3] & 0xffff0000u) * r * w1[3];
        *(f32x4*)(orow + c) = o0; *(f32x4*)(orow + c + 4) = o1; }
}

static_assert(hg::L_END <= LDSCTL_OFF && at::L_END <= LDSCTL_OFF, "phase scratch below the LDS control words");
struct Args { const float* in[17]; float* out; unsigned char* ws; int ph_lo, ph_hi, li, pad; };
enum { PH_PRO = 0, PH_INPROJ = 1, PH_MIX = 2, PH_HGFIN = 3, PH_OUTPROJ = 4, PH_QUANT = 5, PH_GATEUP = 6, PH_DOWN = 7, PH_FINAL = 8, PH_N = 9 };

__global__ void __launch_bounds__(NWAVES * 64, 2) mk_fwd(Args args) {
    extern __shared__ __attribute__((aligned(16))) unsigned char lds_raw[];
    LAS unsigned char* lds = (LAS unsigned char*)lds_raw;
    volatile LAS unsigned* MISC = (volatile LAS unsigned*)(lds + MISC_OFF);
    const int tid = threadIdx.x, lane = tid & 63, wave = __builtin_amdgcn_readfirstlane(tid >> 6);
    const int G = gridDim.x; const int bx = blockIdx.x; const int vcu = (G % 8 == 0) ? (bx % 8) * (G / 8) + bx / 8 : bx;
    unsigned char* ws = args.ws;
    gu32* ctl = (gu32*)(ws + WS_CTL);
    float* rs2 = (float*)(ws + WS_PART); float* sa1 = (float*)(ws + WS_PART + 65536);
    float* cmax_gu = (float*)(ws + WS_CTL + CMAX_GU_OFF); float* cmax_in = (float*)(ws + WS_CTL + CMAX_IN_OFF);
    unsigned char* H1Q = ws + WS_WIN;
    u16* WinT = (u16*)(ws + WS_WIN); u16* WoT = (u16*)(ws + WS_WO); u16* WguT = (u16*)(ws + WS_WGU); u16* WdT = (u16*)(ws + WS_WD);
    u16* XN = (u16*)(ws + WS_XN); u16* BB = (u16*)(ws + WS_B); u16* PROJ = (u16*)(ws + WS_PROJ);
    for (int u = tid; u < (LDS_BYTES - LDSCTL_OFF) / 4; u += NWAVES * 64) ((LAS unsigned*)(lds + LDSCTL_OFF))[u] = 0u;
    __syncthreads();
    XcdBarrier bar = xcd_barrier_post((unsigned*)(ctl + CW_BAR) + args.li * XCD_BAR_WORDS, MISC + 8);
    const int lo = args.ph_lo, hi = args.ph_hi;
#define IN(k) (lo <= (k) && (k) < hi)
#define SEAM(k) do { if (IN(k) && (k) + 1 < hi) xcd_barrier(bar); } while (0)
    const int gw = vcu * NWAVES + wave, NGW = G * NWAVES;
    constexpr int PROBE_PH = -1, PROBE_BX = 0;
    unsigned long long pr_t0 = 0, pr_dt = 0, pr_c0 = 0;
#define PROBE_BEGIN(k) do { if (PROBE_PH == (k) && bx == PROBE_BX && tid == 0) pr_t0 = __builtin_amdgcn_s_memrealtime(); if (PROBE_PH == 100 + (k) && bx == PROBE_BX && tid == 0) pr_c0 = __builtin_amdgcn_s_memtime(); } while (0)
#define PROBE_END(k) do { if (PROBE_PH == (k) && bx == PROBE_BX && tid == 0) pr_dt = __builtin_amdgcn_s_memrealtime() - pr_t0; if (PROBE_PH == 100 + (k) && bx == PROBE_BX && tid == 0) pr_dt = (__builtin_amdgcn_s_memtime() - pr_c0) / 24; } while (0)

    PROBE_BEGIN(99);
    PROBE_BEGIN(PH_PRO);
    if (IN(PH_PRO)) {
        constexpr int NS_IN = INC / 32, NS_G = DFF / 32, NS = NS_IN + 2 * NS_G;
        { int par = 0;
          for (int st = vcu; st < NS; st += G, par ^= 1) { LAS float* smax = (LAS float*)(lds + RING_OFF) + par * 256;
              if (st < NS_IN) p0_strip(smax, args.in[2], INC, nullptr, cmax_in, (unsigned char*)WinT, 32 * st, 32 * st, tid);
              else { const int up = (st - NS_IN) >= NS_G ? 1 : 0, n0 = 32 * (st - NS_IN - up * NS_G);
                  p0_strip(smax, up ? args.in[14] : args.in[13], DFF, args.in[12], cmax_gu, (unsigned char*)WguT, n0, 256 * (n0 >> 7) + 128 * up + (n0 & 127), tid); } } }
        { int r0, cnt, rstep;
          { const int q = NS / G, rem = NS % G, B = (32 * NS + M + G - 1) / G;
            if (B - 32 * (q + 1) >= 0) { r0 = vcu * (B - 32 * q) - 32 * (vcu < rem ? vcu : rem); cnt = B - 32 * (q + (vcu < rem ? 1 : 0)); if (r0 > M) r0 = M; if (r0 + cnt > M || vcu == G - 1) cnt = M - r0; r0 += wave; rstep = NWAVES; cnt = r0 - wave + cnt; }
            else { r0 = gw; rstep = NGW; cnt = M; } }
          f32x4 wv[8];
#pragma unroll
          for (int j = 0; j < 8; ++j) wv[j] = *((const f32x4*)args.in[1] + lane + 64 * j);
          f32x4 cur[8], nxt[8];
          if (r0 < cnt) {
#pragma unroll
              for (int j = 0; j < 8; ++j) nxt[j] = __builtin_nontemporal_load((const f32x4*)(args.in[0] + (size_t)r0 * DM) + lane + 64 * j); }
          for (int m = r0; m < cnt; m += rstep) {
#pragma unroll
              for (int j = 0; j < 8; ++j) cur[j] = nxt[j];
              if (m + rstep < cnt) {
#pragma unroll
                  for (int j = 0; j < 8; ++j) nxt[j] = __builtin_nontemporal_load((const f32x4*)(args.in[0] + (size_t)(m + rstep) * DM) + lane + 64 * j); }
              float s = 0.f;
#pragma unroll
              for (int j = 0; j < 8; ++j) s += (cur[j].x * cur[j].x + cur[j].y * cur[j].y) + (cur[j].z * cur[j].z + cur[j].w * cur[j].w);
              const float r = __builtin_amdgcn_rsqf(wave_sum(s) * (1.0f / DM) + EPS);
              float am = 0.f;
#pragma unroll
              for (int j = 0; j < 8; ++j) { cur[j] = cur[j] * r * wv[j]; am = fmaxf(fmaxf(am, fmaxf(fabsf(cur[j].x), fabsf(cur[j].y))), fmaxf(fabsf(cur[j].z), fabsf(cur[j].w))); }
              am = wave_max(am); const float inv = inv127(am);
              unsigned* o = (unsigned*)((unsigned char*)XN + (size_t)m * DM) + lane;
#pragma unroll
              for (int j = 0; j < 8; ++j) o[64 * j] = pack4_i8(cur[j].x, cur[j].y, cur[j].z, cur[j].w, inv);
              if (lane == 0) sa1[m] = am * (1.0f / 127.0f); } }
    }
    SEAM(PH_PRO);
    PROBE_END(PH_PRO);
    PROBE_BEGIN(PH_INPROJ);
    if (IN(PH_INPROJ)) {
        pg8::Gemm g{XN, WinT, M, INC, DM / 2}; pg8::StaticOrder S; S.init(M, INC, G, bx);
        pg8::EpiInProj E{PROJ, args.in[3], sa1, cmax_in};
        pg8::gemm_phase<pg8::EpiInProj, pg8::StaticOrder, PG8_ALIGN, PG8_SP2, 2>(lds + RING_OFF, g, S, E);
    }
    PROBE_BEGIN(53);
    SEAM(PH_INPROJ);
    PROBE_END(53);
    PROBE_END(PH_INPROJ);
    PROBE_BEGIN(PH_MIX);
    if (IN(PH_MIX)) {
        PROBE_BEGIN(20);
        const bg::Ptrs BP{args.in[11], args.in[13], args.in[14], args.in[15], args.in[12], WoT, WguT, WdT, cmax_gu}; int bgj = 0;
        const int gcw = vcu * 4 + (wave & 3), NCW = G * 4;
        for (int item = vcu; item < 256; item += G) { hg::hgrn_item(lds + RING_OFF, PROJ, BB, item, tid, BP, bgj, gcw, NCW); __syncthreads(); }
        if (wave < 4) for (; bgj * NCW + gcw < bg::NBG; ++bgj) { bg::f32x4 v[8]; bg::load(BP, bgj * NCW + gcw, lane, v); bg::store(BP, bgj * NCW + gcw, lane, v); }
        PROBE_END(20);
        PROBE_BEGIN(21);
        { const float lam = __expf(wave_sum(args.in[5][lane] * args.in[6][lane])) - __expf(wave_sum(args.in[7][lane] * args.in[8][lane])) + 0.2f;
          for (int p = vcu; p < 512; p += G) { const int b = p >> 6, h = (p >> 3) & 7, qb = p & 7;
              at::attn_unit(lds + RING_OFF, PROJ, args.in[10], args.out, XN, args.in[9], lam, b, h, qb, 0, tid);
              at::attn_unit(lds + RING_OFF, PROJ, args.in[10], args.out, XN, args.in[9], lam, b, h, qb, 1, tid); } }
        PROBE_END(21);
    }
    PROBE_BEGIN(54);
    SEAM(PH_MIX);
    PROBE_END(54);
    PROBE_END(PH_MIX);
    PROBE_BEGIN(PH_HGFIN);
    if (IN(PH_HGFIN)) {
        const int l16 = lane & 15; f32x4 wa = *(const f32x4*)(args.in[4] + l16 * 8), wb = *(const f32x4*)(args.in[4] + l16 * 8 + 4);
        for (int p4 = gw; p4 < M * 2; p4 += NGW) { const int p = p4 * 4 + (lane >> 4), m = p >> 3, c = (p & 7) * 128 + l16 * 8;
            const v4u a = __builtin_nontemporal_load((const v4u*)(BB + (size_t)m * HGW + c)), bb = __builtin_nontemporal_load((const v4u*)(BB + ((size_t)M + m) * HGW + c)), g = __builtin_nontemporal_load((const v4u*)(PROJ + (size_t)m * INC + 4096 + c));
            float o[8]; float ss = 0.f;
#pragma unroll
            for (int e = 0; e < 4; ++e) { o[2 * e] = __uint_as_float(a[e] << 16) + __uint_as_float(bb[e] << 16); o[2 * e + 1] = __uint_as_float(a[e] & 0xffff0000u) + __uint_as_float(bb[e] & 0xffff0000u);
                ss += o[2 * e] * o[2 * e] + o[2 * e + 1] * o[2 * e + 1]; }
            ss += __shfl_xor(ss, 1); ss += __shfl_xor(ss, 2); ss += __shfl_xor(ss, 4); ss += __shfl_xor(ss, 8);
            const float r = __builtin_amdgcn_rsqf(ss * (1.0f / 128.0f) + EPS);
            v4u y;
#pragma unroll
            for (int e = 0; e < 4; ++e) { const float w0 = e < 2 ? wa[2 * e] : wb[2 * e - 4], w1 = e < 2 ? wa[2 * e + 1] : wb[2 * e - 3];
                y[e] = pk2(o[2 * e] * r * w0 * __uint_as_float(g[e] << 16), o[2 * e + 1] * r * w1 * __uint_as_float(g[e] & 0xffff0000u)); }
            *(v4u*)(XN + (size_t)m * DM + c) = y; }
    }
    PROBE_BEGIN(57);
    SEAM(PH_HGFIN);
    PROBE_END(57);
    PROBE_END(PH_HGFIN);
    PROBE_BEGIN(PH_OUTPROJ);
    if (IN(PH_OUTPROJ)) {
        pg8::Gemm g{XN, WoT, M, DM, DM}; pg8::StaticOrder S; S.init(M, DM, G, bx);
        pg8::EpiOutProj E{args.in[0], BB};
        pg8::gemm_phase<pg8::EpiOutProj, pg8::StaticOrder, PG8_ALIGN, PG8_SP2>(lds + RING_OFF, g, S, E);
    }
    PROBE_BEGIN(58);
    SEAM(PH_OUTPROJ);
    PROBE_END(58);
    PROBE_END(PH_OUTPROJ);
    PROBE_BEGIN(PH_QUANT);
    if (IN(PH_QUANT)) {
        v4u cur[4], nxt[4];
        if (gw < M) {
#pragma unroll
            for (int j = 0; j < 4; ++j) nxt[j] = *((const v4u*)(BB + (size_t)gw * DM) + lane + 64 * j); }
        for (int m = gw; m < M; m += NGW) {
#pragma unroll
            for (int j = 0; j < 4; ++j) cur[j] = nxt[j];
            if (m + NGW < M) {
#pragma unroll
                for (int j = 0; j < 4; ++j) nxt[j] = *((const v4u*)(BB + (size_t)(m + NGW) * DM) + lane + 64 * j); }
            float s = 0.f, am = 0.f;
#pragma unroll
            for (int j = 0; j < 4; ++j)
#pragma unroll
                for (int e = 0; e < 4; ++e) { const float a = __uint_as_float(cur[j][e] << 16), b = __uint_as_float(cur[j][e] & 0xffff0000u); s += a * a + b * b; am = fmaxf(am, fmaxf(fabsf(a), fabsf(b))); }
            s = wave_sum(s); am = wave_max(am);
            const float inv = inv127(am);
            uint2* o = (uint2*)(H1Q + (size_t)m * DM) + lane;
#pragma unroll
            for (int j = 0; j < 4; ++j) { uint2 w;
                w.x = pack4_i8(__uint_as_float(cur[j][0] << 16), __uint_as_float(cur[j][0] & 0xffff0000u), __uint_as_float(cur[j][1] << 16), __uint_as_float(cur[j][1] & 0xffff0000u), inv);
                w.y = pack4_i8(__uint_as_float(cur[j][2] << 16), __uint_as_float(cur[j][2] & 0xffff0000u), __uint_as_float(cur[j][3] << 16), __uint_as_float(cur[j][3] & 0xffff0000u), inv);
                o[64 * j] = w; }
            if (lane == 0) rs2[m] = __builtin_amdgcn_rsqf(s * (1.0f / DM) + EPS) * am * (1.0f / 127.0f); }
    }
    SEAM(PH_QUANT);
    PROBE_END(PH_QUANT);
    PROBE_BEGIN(PH_GATEUP);
    if (IN(PH_GATEUP)) {
        pg8::Gemm g{(const u16*)H1Q, WguT, M, NGU, DM / 2}; pg8::StaticOrder S; S.init(M, NGU, G, bx);
        pg8::Unit u0; u0.pm = 0; u0.pn = 0; (void)S.next(0, u0);
        LAS float* rtab = (LAS float*)(lds + RTAB_OFF);
        if (tid < 256) rtab[tid] = rs2[u0.pm * 256 + tid];
        __syncthreads();
        pg8::EpiSwiGLU8 E{(unsigned char*)PROJ, (const LAS float*)rtab, u0.pm, rs2, cmax_gu};
        pg8::gemm_phase<pg8::EpiSwiGLU8, pg8::StaticOrder, PG8_ALIGN, PG8_SP2, 2>(lds + RING_OFF, g, S, E);
    }
    PROBE_BEGIN(55);
    SEAM(PH_GATEUP);
    PROBE_END(55);
    PROBE_END(PH_GATEUP);
    PROBE_BEGIN(PH_DOWN);
    if (IN(PH_DOWN)) {
        pg8::Gemm g{PROJ, WdT, M, DM, DFF / 2, 0x77777777u  , 0x7d7d7d7du  }; pg8::StaticOrder S; S.init(M, DM, G, bx);
        pg8::EpiDown E{BB};
        pg8::gemm_phase<pg8::EpiDown, pg8::StaticOrder, PG8_ALIGN, PG8_SP2, 1>(lds + RING_OFF, g, S, E);
    }
    PROBE_BEGIN(56);
    SEAM(PH_DOWN);
    PROBE_END(56);
    PROBE_END(PH_DOWN);
    PROBE_BEGIN(PH_FINAL);
    if (IN(PH_FINAL)) {
        for (int m = gw; m < M; m += NGW) rms_row_from_bf16(BB + (size_t)m * DM, args.in[16], args.out + (size_t)m * DM, lane);
    }
    PROBE_END(PH_FINAL);
    PROBE_END(99);
    if (PROBE_PH >= 0 && bx == PROBE_BX && tid == 0) { const unsigned long long t1 = __builtin_amdgcn_s_memrealtime(); while (__builtin_amdgcn_s_memrealtime() - t1 < 4 * pr_dt) __builtin_amdgcn_s_sleep(8); }
#undef IN
#undef SEAM
}

extern "C" void kernel_launch(void* const* d_in, const int* in_sizes, int n_in, void* d_out, int out_size, void* d_ws, size_t ws_size, hipStream_t stream) {
    static int grid = 0;
    if (grid == 0) {
        if (n_in != 17 || ws_size < WS_NEED || out_size != M * DM) { fprintf(stderr, "kernel_launch: unexpected shapes (n_in %d, ws %zu, out %d)\n", n_in, ws_size, out_size); grid = -1; return; }
        int dev = 0, cus = 0;
        if (hipGetDevice(&dev) != hipSuccess || hipDeviceGetAttribute(&cus, hipDeviceAttributeMultiprocessorCount, dev) != hipSuccess) { grid = -1; return; }
        if (hipFuncSetAttribute((const void*)mk_fwd, hipFuncAttributeMaxDynamicSharedMemorySize, LDS_BYTES) != hipSuccess) { fprintf(stderr, "kernel_launch: hipFuncSetAttribute failed\n"); grid = -1; return; }
        (void)hipGetLastError();
        grid = cus;
    }
    if (grid < 0) return;
    unsigned char* ws = (unsigned char*)d_ws;
    (void)hipMemsetAsync(ws + WS_CTL, 0, CTL_ZERO_BYTES, stream);
    Args a{};
    for (int i = 0; i < 17; ++i) a.in[i] = (const float*)d_in[i];
    a.out = (float*)d_out; a.ws = ws;
    a.ph_lo = PH_PRO; a.ph_hi = PH_N; a.li = 0;
    hipLaunchKernelGGL(mk_fwd, dim3(grid), dim3(NWAVES * 64), LDS_BYTES, stream, a);
}
```

```cpp
#include <hip/hip_runtime.h>
#include <stdint.h>
#include <cstdio>

typedef unsigned short u16;
constexpr int BATCH = 8, SEQ = 2048, DM = 2048, M = BATCH * SEQ;
constexpr int HGW = 1024, DAW = 1024, INC = 8192, DFF = 5632, NGU = 2 * DFF;
constexpr float EPS = 1e-6f;
constexpr float LOG2E = 1.4426950408889634f;
constexpr float C2 = 0.125f * LOG2E;
constexpr size_t MiB = 1u << 20;
constexpr size_t WS_CTL = 0, CTL_ZERO_BYTES = 65536, CMAX_GU_OFF = 65536  , CMAX_IN_OFF = 114688  , WS_PART = 2 * MiB, WS_WIN = 4 * MiB, WS_WO = 36 * MiB, WS_WGU = 44 * MiB, WS_WD = 88 * MiB,
                 WS_XN = 112 * MiB, WS_B = 176 * MiB, WS_PROJ = 240 * MiB, WS_NEED = 496 * MiB;
namespace pg8 {
#define PG8_LAS __attribute__((address_space(3)))
typedef unsigned short bf16_t;
typedef short bf16x8 __attribute__((ext_vector_type(8)));
typedef float f32x4 __attribute__((ext_vector_type(4)));
typedef unsigned u32x4 __attribute__((ext_vector_type(4)));
constexpr int BM = 256, BK = 64, HALF = 128, HTB = HALF * BK * 2  , STAGE_BYTES = 8 * HTB, NXCD = 8, WGM = 8;

__host__ __device__ __forceinline__ int lds_byte(int r, int c) { const int st = (r >> 4) * 2 + (c >> 5), rr = r & 15, cc = c & 31, ob = rr * 64 + cc * 2; return st * 1024 + (ob ^ (((ob >> 9) & 1) << 5)); }
__host__ __device__ __forceinline__ void stage_rc(int b, int& R, int& C) { const int st = b / 1024, sb = b % 1024, swz = sb ^ (((sb >> 9) & 1) << 5); R = (st >> 1) * 16 + swz / 64; C = (st & 1) * 32 + (swz % 64) / 2; }
__host__ __device__ __forceinline__ int perm32(int rho) { const int n = rho >> 4, i = rho & 15; return 8 * (i >> 2) + 4 * n + (i & 3); }

struct Unit { int pm, pn; };
struct Gemm { const bf16_t* A; const bf16_t* Bt; int M, N, K; unsigned sw = 0x7f7f7f7fu, sa = 0x7f7f7f7fu; };
typedef int i32x4 __attribute__((ext_vector_type(4)));
typedef int i32x8 __attribute__((ext_vector_type(8)));
__device__ __forceinline__ i32x8 cat_frag(bf16x8 lo, bf16x8 hi) { return __builtin_shufflevector(__builtin_bit_cast(i32x4, lo), __builtin_bit_cast(i32x4, hi), 0, 1, 2, 3, 4, 5, 6, 7); }

struct StaticOrder {
    int nM, nN, nwg, G, c;
    __host__ __device__ void init(int M, int N, int G_, int c_) { nM = M / BM; nN = N / BM; nwg = nM * nN; G = G_; c = c_; }
    __host__ __device__ bool next(int i, Unit& u) const {
        const long L = (long)i * G + c; if (L >= nwg) return false;
        int wgid = (int)L; { const int q = nwg / NXCD, r = nwg % NXCD, xcd = wgid % NXCD, off = wgid / NXCD; wgid = (xcd < r ? xcd * (q + 1) : r * (q + 1) + (xcd - r) * q) + off; }
        const int nig = WGM * nN, gid = wgid / nig, fm = gid * WGM, gsz = (nM - fm) < WGM ? (nM - fm) : WGM;
        u.pm = fm + ((wgid % nig) % gsz); u.pn = (wgid % nig) / gsz; return true;
    }
    __device__ __forceinline__ void a_ready(const Unit&) const {}
    __device__ __forceinline__ void done(const Unit&) const {}
};
__device__ __forceinline__ unsigned cvt_pk_bf16(float lo, float hi) { typedef float f2_ __attribute__((ext_vector_type(2))); typedef __bf16 b2_ __attribute__((ext_vector_type(2))); const f2_ v = {lo, hi}; return __builtin_bit_cast(unsigned, __builtin_convertvector(v, b2_)); }
typedef float f32x2 __attribute__((ext_vector_type(2)));
__device__ __forceinline__ unsigned pk_h2(float lo, float hi) { typedef float f2_ __attribute__((ext_vector_type(2))); typedef _Float16 h2_ __attribute__((ext_vector_type(2))); const f2_ v = {lo, hi}; return __builtin_bit_cast(unsigned, __builtin_convertvector(v, h2_)); }
__device__ __forceinline__ float fsig(float x) { return __builtin_amdgcn_rcpf(1.0f + __builtin_amdgcn_exp2f(-1.4426950408889634f * x)); }
__device__ __forceinline__ float fsilu(float x) { return x * fsig(x); }
struct EpiInProj {
    static constexpr bool PERM = true, AFTER_DRAIN = false, LAST_FUSED = false;
    bf16_t* proj; const float* lbl; const float* sa; const float* cmax;
    __device__ __forceinline__ void operator()(const f32x4 (&acc)[2][2][4][2], const Unit& u, int wr, int wc, int fr, int fq) const {
        const int row0 = u.pm * BM + wr * 64 + fr, t = u.pn >> 2, col0 = u.pn * BM + wc * 32 + 8 * fq;
        bf16_t* base = proj + (size_t)row0 * 8192 + col0;
        float rs[2][4];
#pragma unroll
        for (int ai = 0; ai < 2; ++ai)
#pragma unroll
            for (int m = 0; m < 4; ++m) rs[ai][m] = sa[row0 + ai * HALF + m * 16];
        if (t == 2 || t == 3) {
#pragma unroll
            for (int bj = 0; bj < 2; ++bj) {
                f32x4 lb[2], ol[2], cs[2];
                { const float* l0 = lbl + (t - 2) * 2048 + (col0 & 1023) + bj * HALF;
#pragma unroll
                  for (int n = 0; n < 2; ++n) { const f32x4 a0 = *(const f32x4*)(l0 + 4 * n), b0 = *(const f32x4*)(l0 + 1024 + 4 * n);
#pragma unroll
                      for (int c = 0; c < 4; ++c) lb[n][c] = fsig(a0[c] - b0[c]);
                      ol[n] = 1.0f - lb[n]; cs[n] = *(const f32x4*)(cmax + col0 + bj * HALF + 4 * n) * (-1.4426950408889634f / 127.0f); } }
#pragma unroll
                for (int ai = 0; ai < 2; ++ai)
#pragma unroll
                    for (int m = 0; m < 4; ++m) { f32x4 y[2];
#pragma unroll
                        for (int n = 0; n < 2; ++n) { const f32x4 e = acc[ai][bj][m][n] * (cs[n] * rs[ai][m]); f32x4 d;
#pragma unroll
                            for (int c = 0; c < 4; ++c) d[c] = __builtin_amdgcn_exp2f(e[c]);
                            d = d + 1.0f;
#pragma unroll
                            for (int c = 0; c < 4; ++c) d[c] = __builtin_amdgcn_rcpf(d[c]);
                            const f32x4 f = lb[n] + ol[n] * d;
#pragma unroll
                            for (int c = 0; c < 4; ++c) y[n][c] = __builtin_amdgcn_logf(f[c]); }
                        u32x4 w; w.x = pk_h2(y[0][0], y[0][1]); w.y = pk_h2(y[0][2], y[0][3]); w.z = pk_h2(y[1][0], y[1][1]); w.w = pk_h2(y[1][2], y[1][3]);
                        *(u32x4*)(base + (size_t)(ai * HALF + m * 16) * 8192 + bj * HALF) = w; }
            }
        } else {
            const float sc = (t == 5) ? 0.18033688011112042f * (1.0f / 127.0f) : (1.0f / 127.0f);
            const bool act = (t == 0 || t == 4);
#pragma unroll
            for (int bj = 0; bj < 2; ++bj) {
                f32x4 cs[2];
#pragma unroll
                for (int n = 0; n < 2; ++n) cs[n] = *(const f32x4*)(cmax + col0 + bj * HALF + 4 * n) * sc;
                if (act) {
#pragma unroll
                    for (int ai = 0; ai < 2; ++ai)
#pragma unroll
                        for (int m = 0; m < 4; ++m) { f32x4 y[2];
#pragma unroll
                            for (int n = 0; n < 2; ++n) { const f32x4 a = acc[ai][bj][m][n] * (cs[n] * rs[ai][m]); const f32x4 e = a * (-1.4426950408889634f); f32x4 d;
#pragma unroll
                                for (int c = 0; c < 4; ++c) d[c] = __builtin_amdgcn_exp2f(e[c]);
                                d = d + 1.0f;
#pragma unroll
                                for (int c = 0; c < 4; ++c) d[c] = __builtin_amdgcn_rcpf(d[c]);
                                y[n] = a * d; }
                            u32x4 w; w.x = cvt_pk_bf16(y[0][0], y[0][1]); w.y = cvt_pk_bf16(y[0][2], y[0][3]); w.z = cvt_pk_bf16(y[1][0], y[1][1]); w.w = cvt_pk_bf16(y[1][2], y[1][3]);
                            *(u32x4*)(base + (size_t)(ai * HALF + m * 16) * 8192 + bj * HALF) = w; }
                } else {
#pragma unroll
                    for (int ai = 0; ai < 2; ++ai)
#pragma unroll
                        for (int m = 0; m < 4; ++m) { f32x4 y[2];
#pragma unroll
                            for (int n = 0; n < 2; ++n) y[n] = acc[ai][bj][m][n] * (cs[n] * rs[ai][m]);
                            u32x4 w; w.x = cvt_pk_bf16(y[0][0], y[0][1]); w.y = cvt_pk_bf16(y[0][2], y[0][3]); w.z = cvt_pk_bf16(y[1][0], y[1][1]); w.w = cvt_pk_bf16(y[1][2], y[1][3]);
                            *(u32x4*)(base + (size_t)(ai * HALF + m * 16) * 8192 + bj * HALF) = w; }
                }
            }
        }
    }
};
struct EpiOutProj {
    static constexpr bool PERM = true, AFTER_DRAIN = false, LAST_FUSED = false;
    const float* x; bf16_t* h1b;
    __device__ __forceinline__ void operator()(const f32x4 (&acc)[2][2][4][2], const Unit& u, int wr, int wc, int fr, int fq) const {
        const int row0 = u.pm * BM + wr * 64 + fr, col0 = u.pn * BM + wc * 32 + 8 * fq;
        f32x4 xv[4][2][2]; u32x4 pk[4][2];
#pragma unroll
        for (int m = 0; m < 4; ++m)
#pragma unroll
            for (int bj = 0; bj < 2; ++bj) { const float* p = x + (size_t)(row0 + m * 16) * 2048 + col0 + bj * HALF; xv[m][bj][0] = __builtin_nontemporal_load((const f32x4*)p); xv[m][bj][1] = __builtin_nontemporal_load((const f32x4*)(p + 4)); }
#pragma unroll
        for (int m = 0; m < 4; ++m)
#pragma unroll
            for (int bj = 0; bj < 2; ++bj) { const f32x4 h0 = xv[m][bj][0] + acc[0][bj][m][0], h1 = xv[m][bj][1] + acc[0][bj][m][1];
                pk[m][bj].x = cvt_pk_bf16(h0[0], h0[1]); pk[m][bj].y = cvt_pk_bf16(h0[2], h0[3]); pk[m][bj].z = cvt_pk_bf16(h1[0], h1[1]); pk[m][bj].w = cvt_pk_bf16(h1[2], h1[3]); }
#pragma unroll
        for (int m = 0; m < 4; ++m)
#pragma unroll
            for (int bj = 0; bj < 2; ++bj) { const float* p = x + (size_t)(row0 + HALF + m * 16) * 2048 + col0 + bj * HALF; xv[m][bj][0] = __builtin_nontemporal_load((const f32x4*)p); xv[m][bj][1] = __builtin_nontemporal_load((const f32x4*)(p + 4)); }
#pragma unroll
        for (int m = 0; m < 4; ++m)
#pragma unroll
            for (int bj = 0; bj < 2; ++bj) *(u32x4*)(h1b + (size_t)(row0 + m * 16) * 2048 + col0 + bj * HALF) = pk[m][bj];
#pragma unroll
        for (int m = 0; m < 4; ++m)
#pragma unroll
            for (int bj = 0; bj < 2; ++bj) { const f32x4 h0 = xv[m][bj][0] + acc[1][bj][m][0], h1 = xv[m][bj][1] + acc[1][bj][m][1]; u32x4 w;
                w.x = cvt_pk_bf16(h0[0], h0[1]); w.y = cvt_pk_bf16(h0[2], h0[3]); w.z = cvt_pk_bf16(h1[0], h1[1]); w.w = cvt_pk_bf16(h1[2], h1[3]);
                *(u32x4*)(h1b + (size_t)(row0 + HALF + m * 16) * 2048 + col0 + bj * HALF) = w; }
    }
};
constexpr float HID_SCALE = 4.0f;
struct EpiSwiGLU8 {
    static constexpr bool PERM = true, AFTER_DRAIN = false, LAST_FUSED = false;
    unsigned char* hid; const PG8_LAS float* rtab; int pm_tab; const float* rsg; const float* cmax;
    __device__ __forceinline__ void operator()(const f32x4 (&acc)[2][2][4][2], const Unit& u, int wr, int wc, int fr, int fq) const {
        const int rt0 = wr * 64 + fr, col0 = u.pn * HALF + wc * 32 + 8 * fq;
        f32x4 sg[2], su[2];
        { const float* c0 = cmax + u.pn * BM + wc * 32 + 8 * fq;
          sg[0] = *(const f32x4*)c0 * (1.0f / 127.0f); sg[1] = *(const f32x4*)(c0 + 4) * (1.0f / 127.0f); su[0] = *(const f32x4*)(c0 + HALF) * (HID_SCALE / 127.0f); su[1] = *(const f32x4*)(c0 + HALF + 4) * (HID_SCALE / 127.0f); }
#pragma unroll
        for (int ai = 0; ai < 2; ++ai)
#pragma unroll
            for (int m = 0; m < 4; ++m) { const int rt = rt0 + ai * HALF + m * 16;
                const float r = (u.pm == pm_tab) ? rtab[rt] : rsg[u.pm * BM + rt];
                f32x4 y[2];
#pragma unroll
                for (int n = 0; n < 2; ++n) { const f32x4 g = acc[ai][0][m][n] * (sg[n] * r), up = acc[ai][1][m][n] * (su[n] * r); const f32x4 t = g * (-1.4426950408889634f); f32x4 d;
#pragma unroll
                    for (int c = 0; c < 4; ++c) d[c] = __builtin_amdgcn_exp2f(t[c]);
                    d = d + 1.0f;
#pragma unroll
                    for (int c = 0; c < 4; ++c) d[c] = __builtin_amdgcn_rcpf(d[c]);
                    y[n] = (g * up) * d; }
                uint2 w; int t = 0;
                t = __builtin_amdgcn_cvt_pk_fp8_f32(y[0][0], y[0][1], t, false); t = __builtin_amdgcn_cvt_pk_fp8_f32(y[0][2], y[0][3], t, true); w.x = (unsigned)t;
                t = __builtin_amdgcn_cvt_pk_fp8_f32(y[1][0], y[1][1], t, false); t = __builtin_amdgcn_cvt_pk_fp8_f32(y[1][2], y[1][3], t, true); w.y = (unsigned)t;
                *(uint2*)(hid + (size_t)(u.pm * BM + rt) * 5632 + col0) = w; }
    }
};
struct EpiDown {
    static constexpr bool PERM = true, AFTER_DRAIN = false, LAST_FUSED = false;
    bf16_t* hb;
    __device__ __forceinline__ void operator()(const f32x4 (&acc)[2][2][4][2], const Unit& u, int wr, int wc, int fr, int fq) const {
        unsigned off0 = (unsigned)((u.pm * BM + wr * 64 + fr) * 2048 + u.pn * BM + wc * 32 + 8 * fq);
        u32x4 hv[2][4][2];
#pragma unroll
        for (int ai = 0; ai < 2; ++ai) { unsigned ob = off0 + (unsigned)(ai * HALF * 2048); asm volatile("" : "+v"(ob));
#pragma unroll
            for (int m = 0; m < 4; ++m)
#pragma unroll
                for (int bj = 0; bj < 2; ++bj) hv[ai][m][bj] = __builtin_nontemporal_load((const u32x4*)(hb + (ob + m * 16 * 2048 + bj * HALF))); }
#pragma unroll
        for (int ai = 0; ai < 2; ++ai) { unsigned ob = off0 + (unsigned)(ai * HALF * 2048); asm volatile("" : "+v"(ob));
#pragma unroll
            for (int m = 0; m < 4; ++m)
#pragma unroll
                for (int bj = 0; bj < 2; ++bj) { const u32x4 h = hv[ai][m][bj]; const f32x4 a0 = acc[ai][bj][m][0], a1 = acc[ai][bj][m][1]; u32x4 w;
                    w.x = cvt_pk_bf16(__uint_as_float(h.x << 16) + a0[0], __uint_as_float(h.x & 0xffff0000u) + a0[1]); w.y = cvt_pk_bf16(__uint_as_float(h.y << 16) + a0[2], __uint_as_float(h.y & 0xffff0000u) + a0[3]);
                    w.z = cvt_pk_bf16(__uint_as_float(h.z << 16) + a1[0], __uint_as_float(h.z & 0xffff0000u) + a1[1]); w.w = cvt_pk_bf16(__uint_as_float(h.w << 16) + a1[2], __uint_as_float(h.w & 0xffff0000u) + a1[3]);
                    *(u32x4*)(hb + (ob + m * 16 * 2048 + bj * HALF)) = w; } }
    }
};
struct EpiDownF {
    static constexpr bool PERM = true, AFTER_DRAIN = false, LAST_FUSED = true;
    bf16_t* hb; float* part2; unsigned* pctr; const float* wf; float* out; PG8_LAS float* rtab; int pn_first; bool xcc_local;
    __device__ __forceinline__ void operator()(const f32x4 (&acc)[2][2][4][2], const Unit& u, int wr, int wc, int fr, int fq) const {
        const int row0 = u.pm * BM + wr * 64 + fr;
        unsigned off0 = (unsigned)(row0 * 2048 + u.pn * BM + wc * 32 + 8 * fq);
        u32x4 hv[2][4][2];
#pragma unroll
        for (int ai = 0; ai < 2; ++ai) { unsigned ob = off0 + (unsigned)(ai * HALF * 2048); asm volatile("" : "+v"(ob));
#pragma unroll
            for (int m = 0; m < 4; ++m)
#pragma unroll
                for (int bj = 0; bj < 2; ++bj) hv[ai][m][bj] = __builtin_nontemporal_load((const u32x4*)(hb + (ob + m * 16 * 2048 + bj * HALF))); }
#pragma unroll
        for (int ai = 0; ai < 2; ++ai) { unsigned ob = off0 + (unsigned)(ai * HALF * 2048); asm volatile("" : "+v"(ob));
#pragma unroll
            for (int m = 0; m < 4; ++m) { float ss = 0.f;
#pragma unroll
                for (int bj = 0; bj < 2; ++bj) { const u32x4 h = hv[ai][m][bj]; const f32x4 a0 = acc[ai][bj][m][0], a1 = acc[ai][bj][m][1];
                    const f32x4 h0 = {__uint_as_float(h.x << 16) + a0[0], __uint_as_float(h.x & 0xffff0000u) + a0[1], __uint_as_float(h.y << 16) + a0[2], __uint_as_float(h.y & 0xffff0000u) + a0[3]};
                    const f32x4 h1 = {__uint_as_float(h.z << 16) + a1[0], __uint_as_float(h.z & 0xffff0000u) + a1[1], __uint_as_float(h.w << 16) + a1[2], __uint_as_float(h.w & 0xffff0000u) + a1[3]};
                    const f32x4 q = h0 * h0 + h1 * h1; ss += (q[0] + q[1]) + (q[2] + q[3]);
                    u32x4 w; w.x = cvt_pk_bf16(h0[0], h0[1]); w.y = cvt_pk_bf16(h0[2], h0[3]); w.z = cvt_pk_bf16(h1[0], h1[1]); w.w = cvt_pk_bf16(h1[2], h1[3]);
                    *(u32x4*)(hb + (ob + m * 16 * 2048 + bj * HALF)) = w; }
                ss += __shfl_xor(ss, 16); ss += __shfl_xor(ss, 32);
                if (fq == 0) part2[(size_t)(row0 + ai * HALF + m * 16) * 32 + u.pn * 4 + wc] = ss; } }
    }
    __device__ __forceinline__ void fused(f32x4 (&acc)[2][2][4][2], const Unit& u, int wr, int wc, int fr, int fq, PG8_LAS unsigned char*, int, int) const {
        const int row0 = u.pm * BM + wr * 64 + fr, rt0 = wr * 64 + fr, tid = threadIdx.x;
        { unsigned off0 = (unsigned)(row0 * 2048 + u.pn * BM + wc * 32 + 8 * fq);
          u32x4 hv[2][4][2];
#pragma unroll
          for (int ai = 0; ai < 2; ++ai) { unsigned ob = off0 + (unsigned)(ai * HALF * 2048); asm volatile("" : "+v"(ob));
#pragma unroll
              for (int m = 0; m < 4; ++m)
#pragma unroll
                  for (int bj = 0; bj < 2; ++bj) hv[ai][m][bj] = __builtin_nontemporal_load((const u32x4*)(hb + (ob + m * 16 * 2048 + bj * HALF))); }
#pragma unroll
          for (int ai = 0; ai < 2; ++ai)
#pragma unroll
              for (int m = 0; m < 4; ++m) { float ss = 0.f;
#pragma unroll
                  for (int bj = 0; bj < 2; ++bj) { const u32x4 h = hv[ai][m][bj]; f32x4& a0 = acc[ai][bj][m][0]; f32x4& a1 = acc[ai][bj][m][1];
                      a0[0] += __uint_as_float(h.x << 16); a0[1] += __uint_as_float(h.x & 0xffff0000u); a0[2] += __uint_as_float(h.y << 16); a0[3] += __uint_as_float(h.y & 0xffff0000u);
                      a1[0] += __uint_as_float(h.z << 16); a1[1] += __uint_as_float(h.z & 0xffff0000u); a1[2] += __uint_as_float(h.w << 16); a1[3] += __uint_as_float(h.w & 0xffff0000u);
                      const f32x4 q = a0 * a0 + a1 * a1; ss += (q[0] + q[1]) + (q[2] + q[3]); }
                  ss += __shfl_xor(ss, 16); ss += __shfl_xor(ss, 32);
                  if (fq == 0) part2[(size_t)(row0 + ai * HALF + m * 16) * 32 + u.pn * 4 + wc] = ss; } }
        asm volatile("s_waitcnt vmcnt(0)" ::: "memory");
        __syncthreads();
        if (tid == 0) { if (!xcc_local) __builtin_amdgcn_fence(__ATOMIC_RELEASE, "agent");
            (void)__hip_atomic_fetch_add(pctr + u.pm, 1u, __ATOMIC_RELAXED, __HIP_MEMORY_SCOPE_AGENT);
            while (__hip_atomic_load(pctr + u.pm, __ATOMIC_RELAXED, __HIP_MEMORY_SCOPE_AGENT) < 4u) __builtin_amdgcn_s_sleep(2);
            __builtin_amdgcn_fence(__ATOMIC_ACQUIRE, "agent"); asm volatile("s_waitcnt vmcnt(0)" ::: "memory"); }
        __syncthreads();
        if (tid < 256) { const f32x4* p = (const f32x4*)(part2 + (size_t)(u.pm * BM + tid) * 32); float s = 0.f;
#pragma unroll
            for (int j = 0; j < 8; ++j) { const f32x4 q = p[j]; s += (q[0] + q[1]) + (q[2] + q[3]); }
            rtab[tid] = __builtin_amdgcn_rsqf(s * (1.0f / 2048.0f) + 1e-6f); }
        __syncthreads();
        { const int col0 = u.pn * BM + wc * 32 + 8 * fq; f32x4 wv[2][2];
#pragma unroll
          for (int bj = 0; bj < 2; ++bj) { wv[bj][0] = *(const f32x4*)(wf + col0 + bj * HALF); wv[bj][1] = *(const f32x4*)(wf + col0 + bj * HALF + 4); }
#pragma unroll
          for (int ai = 0; ai < 2; ++ai)
#pragma unroll
              for (int m = 0; m < 4; ++m) { const float r = rtab[rt0 + ai * HALF + m * 16]; float* o = out + (size_t)(row0 + ai * HALF + m * 16) * 2048 + col0;
#pragma unroll
                  for (int bj = 0; bj < 2; ++bj) { *(f32x4*)(o + bj * HALF) = acc[ai][bj][m][0] * r * wv[bj][0]; *(f32x4*)(o + bj * HALF + 4) = acc[ai][bj][m][1] * r * wv[bj][1]; } } }
        { const int col0 = pn_first * BM + wc * 32 + 8 * fq; f32x4 wv[2][2];
#pragma unroll
          for (int bj = 0; bj < 2; ++bj) { wv[bj][0] = *(const f32x4*)(wf + col0 + bj * HALF); wv[bj][1] = *(const f32x4*)(wf + col0 + bj * HALF + 4); }
#pragma unroll
          for (int ai = 0; ai < 2; ++ai) { u32x4 hv[4][2];
#pragma unroll
              for (int m = 0; m < 4; ++m)
#pragma unroll
                  for (int bj = 0; bj < 2; ++bj) hv[m][bj] = *(const u32x4*)(hb + (size_t)(row0 + ai * HALF + m * 16) * 2048 + col0 + bj * HALF);
#pragma unroll
              for (int m = 0; m < 4; ++m) { const float r = rtab[rt0 + ai * HALF + m * 16]; float* o = out + (size_t)(row0 + ai * HALF + m * 16) * 2048 + col0;
#pragma unroll
                  for (int bj = 0; bj < 2; ++bj) { const u32x4 h = hv[m][bj];
                      const f32x4 h0 = {__uint_as_float(h.x << 16), __uint_as_float(h.x & 0xffff0000u), __uint_as_float(h.y << 16), __uint_as_float(h.y & 0xffff0000u)};
                      const f32x4 h1 = {__uint_as_float(h.z << 16), __uint_as_float(h.z & 0xffff0000u), __uint_as_float(h.w << 16), __uint_as_float(h.w & 0xffff0000u)};
                      *(f32x4*)(o + bj * HALF) = h0 * r * wv[bj][0]; *(f32x4*)(o + bj * HALF + 4) = h1 * r * wv[bj][1]; } } } }
    }
};

template <class Epi, class Sched, bool ALIGN_EPI = false, bool SP2 = false, int MODE = 0>
__device__ __forceinline__ void gemm_phase(PG8_LAS unsigned char* lds, const Gemm g, const Sched& S, const Epi& E) {
    const int tid = threadIdx.x, wid = __builtin_amdgcn_readfirstlane(tid >> 6), lane = tid & 63, wr = wid >> 2, wc = wid & 3, fr = lane & 15, fq = lane >> 4;
    const int K = g.K, nt = K / BK;
    unsigned voffA[2], voffB[2];
#pragma unroll
    for (int i = 0; i < 2; ++i) { int R, C; stage_rc(tid * 16 + i * 8192, R, C); const int Rb = Epi::PERM ? ((R & ~31) + perm32(R & 31)) : R;
        voffA[i] = (unsigned)(R * K + C) * 2u; voffB[i] = (unsigned)(Rb * K + C) * 2u; }
    const size_t kstep = (size_t)(BK * 2);
    const size_t hstep = (size_t)HALF * K * 2;
    const size_t tstep = 2 * hstep;
    const unsigned ldsw = (unsigned)wid * 1024u;
    const int aoff = lds_byte(wr * 64 + fr, fq * 8), boff = lds_byte(wc * 32 + fr, fq * 8);
#define PG8_SA(b, h) (((b) * 2 + (h)) * HTB)
#define PG8_SB(b, h) ((4 + (b) * 2 + (h)) * HTB)
#define PG8_STAGE(bufoff, gbase, voff) do { _Pragma("unroll") for (int _i = 0; _i < 2; ++_i) \
        __builtin_amdgcn_global_load_lds((const unsigned*)((const char*)(gbase) + (voff)[_i]), (PG8_LAS unsigned*)(lds + (bufoff) + ldsw + _i * 8192), 16, 0, 0); } while (0)
#define PG8_LDA(dst, b, h) do { _Pragma("unroll") for (int m = 0; m < 4; ++m) _Pragma("unroll") for (int k = 0; k < 2; ++k) dst[m][k] = *(const PG8_LAS bf16x8*)(lds + PG8_SA(b, h) + aoff + m * 2048 + k * 1024); } while (0)
#define PG8_LDB(dst, b, h) do { _Pragma("unroll") for (int n = 0; n < 2; ++n) _Pragma("unroll") for (int k = 0; k < 2; ++k) dst[n][k] = *(const PG8_LAS bf16x8*)(lds + PG8_SB(b, h) + boff + n * 2048 + k * 1024); } while (0)
#define PG8_MMA(ai, bj, At, Bt) do { __builtin_amdgcn_s_setprio(1); _Pragma("unroll") for (int m = 0; m < 4; ++m) _Pragma("unroll") for (int n = 0; n < 2; ++n) { \
        if constexpr (MODE == 1) { const i32x8 b8_ = cat_frag(Bt[n][0], Bt[n][1]), a8_ = cat_frag(At[m][0], At[m][1]); \
            asm volatile("v_mfma_scale_f32_16x16x128_f8f6f4 %0, %1, %2, %0, %3, %4 op_sel_hi:[0,0,0]" : "+v"(acc[ai][bj][m][n]) : "v"(b8_), "v"(a8_), "v"(g.sw), "v"(g.sa)); } \
        else if constexpr (MODE == 2) { _Pragma("unroll") for (int k = 0; k < 2; ++k) acc[ai][bj][m][n] = __builtin_bit_cast(f32x4, __builtin_amdgcn_mfma_i32_16x16x64_i8(__builtin_bit_cast(i32x4, Bt[n][k]), __builtin_bit_cast(i32x4, At[m][k]), __builtin_bit_cast(i32x4, acc[ai][bj][m][n]), 0, 0, 0)); } \
        else { _Pragma("unroll") for (int k = 0; k < 2; ++k) acc[ai][bj][m][n] = __builtin_amdgcn_mfma_f32_16x16x32_bf16(Bt[n][k], At[m][k], acc[ai][bj][m][n], 0, 0, 0); } } \
        __builtin_amdgcn_s_setprio(0); } while (0)
#define PG8_WAIT_V(n) asm volatile("s_waitcnt vmcnt(" #n ")" ::: "memory")
#define PG8_WAIT_L(n) asm volatile("s_waitcnt lgkmcnt(" #n ")" ::: "memory")
#define PG8_BAR __builtin_amdgcn_s_barrier()
#define PG8_SCHED __builtin_amdgcn_sched_barrier(0)
    Unit cur, nxt; int ui = 0;
    if (!S.next(0, cur)) return;
    f32x4 acc[2][2][4][2];
#pragma unroll
    for (int a = 0; a < 2; ++a)
#pragma unroll
        for (int b = 0; b < 2; ++b)
#pragma unroll
            for (int m = 0; m < 4; ++m)
#pragma unroll
                for (int n = 0; n < 2; ++n) acc[a][b][m][n] = (f32x4){0.f, 0.f, 0.f, 0.f};
    bf16x8 At[4][2], B0[2][2], B1[2][2];
    const char* cA = (const char*)g.A + (size_t)cur.pm * tstep; const char* cB = (const char*)g.Bt + (size_t)cur.pn * tstep;
    S.a_ready(cur);
    if constexpr (SP2) {
        PG8_STAGE(PG8_SB(0, 0), cB, voffB); PG8_STAGE(PG8_SB(0, 1), cB + hstep, voffB); PG8_STAGE(PG8_SA(0, 0), cA, voffA); PG8_STAGE(PG8_SA(0, 1), cA + hstep, voffA);
        if (wr == 1) PG8_BAR;
        PG8_WAIT_V(2); PG8_BAR;
        PG8_STAGE(PG8_SB(1, 0), cB + kstep, voffB); PG8_STAGE(PG8_SA(1, 0), cA + kstep, voffA); PG8_STAGE(PG8_SB(1, 1), cB + hstep + kstep, voffB);
        PG8_WAIT_V(6); PG8_BAR;
    } else {
        PG8_STAGE(PG8_SB(0, 0), cB, voffB); PG8_STAGE(PG8_SA(0, 0), cA, voffA); PG8_STAGE(PG8_SB(0, 1), cB + hstep, voffB); PG8_STAGE(PG8_SA(0, 1), cA + hstep, voffA);
        if (wr == 1) PG8_BAR;
        PG8_WAIT_V(4); PG8_BAR;
        PG8_STAGE(PG8_SB(1, 0), cB + kstep, voffB); PG8_STAGE(PG8_SA(1, 0), cA + kstep, voffA); PG8_STAGE(PG8_SB(1, 1), cB + hstep + kstep, voffB);
        PG8_WAIT_V(6); PG8_BAR;
    }
    for (;;) {
        const bool has_next = S.next(ui + 1, nxt);
        const char* nA = has_next ? (const char*)g.A + (size_t)nxt.pm * tstep : cA; const char* nB = has_next ? (const char*)g.Bt + (size_t)nxt.pn * tstep : cB;
        for (int t = 0; t < nt; t += 2) {
            const bool last = (t == nt - 2);
            const char* a1 = cA + (size_t)(t + 1) * kstep;
            const char* a2 = last ? nA : cA + (size_t)(t + 2) * kstep; const char* b2 = last ? nB : cB + (size_t)(t + 2) * kstep;
            const char* a3 = a2 + kstep; const char* b3 = b2 + kstep;
            if (last && has_next) S.a_ready(nxt);
            if constexpr (SP2) {
            PG8_LDB(B0, 0, 0); PG8_LDB(B1, 0, 1); PG8_SCHED; PG8_LDA(At, 0, 0); PG8_STAGE(PG8_SA(1, 1), a1 + hstep, voffA);
            PG8_WAIT_V(8); PG8_WAIT_L(0); PG8_BAR; PG8_MMA(0, 0, At, B0); PG8_MMA(0, 1, At, B1); PG8_BAR; PG8_SCHED;
            PG8_LDA(At, 0, 1); PG8_STAGE(PG8_SB(0, 0), b2, voffB); PG8_STAGE(PG8_SB(0, 1), b2 + hstep, voffB); PG8_STAGE(PG8_SA(0, 0), a2, voffA);
            PG8_WAIT_V(8); PG8_WAIT_L(0); PG8_BAR; PG8_MMA(1, 0, At, B0); PG8_MMA(1, 1, At, B1); PG8_BAR; PG8_SCHED;
            PG8_LDB(B0, 1, 0); PG8_LDB(B1, 1, 1); PG8_SCHED; PG8_LDA(At, 1, 0); PG8_STAGE(PG8_SA(0, 1), a2 + hstep, voffA);
            PG8_WAIT_V(8); PG8_WAIT_L(0); PG8_BAR; PG8_MMA(0, 0, At, B0); PG8_MMA(0, 1, At, B1); PG8_BAR; PG8_SCHED;
            PG8_LDA(At, 1, 1); PG8_STAGE(PG8_SB(1, 0), b3, voffB); PG8_STAGE(PG8_SB(1, 1), b3 + hstep, voffB); PG8_STAGE(PG8_SA(1, 0), a3, voffA);
            PG8_WAIT_V(8); PG8_WAIT_L(0); PG8_BAR; PG8_MMA(1, 0, At, B0); PG8_MMA(1, 1, At, B1); PG8_BAR; PG8_SCHED;
            } else {
            PG8_LDB(B0, 0, 0); PG8_SCHED; PG8_LDA(At, 0, 0); PG8_STAGE(PG8_SA(1, 1), a1 + hstep, voffA);
            PG8_WAIT_L(8); PG8_BAR; PG8_WAIT_L(0); PG8_MMA(0, 0, At, B0); PG8_BAR; PG8_SCHED;
            PG8_LDB(B1, 0, 1); PG8_STAGE(PG8_SB(0, 0), b2, voffB);
            PG8_BAR; PG8_WAIT_L(0); PG8_MMA(0, 1, At, B1); PG8_BAR;
            PG8_LDA(At, 0, 1); PG8_STAGE(PG8_SA(0, 0), a2, voffA);
            PG8_BAR; PG8_WAIT_L(0); PG8_MMA(1, 0, At, B0); PG8_BAR; PG8_SCHED;
            PG8_STAGE(PG8_SB(0, 1), b2 + hstep, voffB);
            PG8_WAIT_V(6); PG8_BAR; PG8_MMA(1, 1, At, B1); PG8_BAR;
            PG8_LDB(B0, 1, 0); PG8_SCHED; PG8_LDA(At, 1, 0); PG8_STAGE(PG8_SA(0, 1), a2 + hstep, voffA);
            PG8_WAIT_L(8); PG8_BAR; PG8_WAIT_L(0); PG8_MMA(0, 0, At, B0); PG8_BAR; PG8_SCHED;
            PG8_LDB(B1, 1, 1); PG8_STAGE(PG8_SB(1, 0), b3, voffB);
            PG8_BAR; PG8_WAIT_L(0); PG8_MMA(0, 1, At, B1); PG8_BAR;
            PG8_LDA(At, 1, 1); PG8_STAGE(PG8_SA(1, 0), a3, voffA);
            PG8_BAR; PG8_WAIT_L(0); PG8_MMA(1, 0, At, B0); PG8_BAR; PG8_SCHED;
            PG8_STAGE(PG8_SB(1, 1), b3 + hstep, voffB);
            PG8_WAIT_V(6); PG8_BAR; PG8_MMA(1, 1, At, B1); PG8_BAR;
            }
        }
        if constexpr (MODE == 1) asm volatile("s_nop 15\n\ts_nop 15" ::: "memory");
        if constexpr (ALIGN_EPI) { if (wr == 0) PG8_BAR; }
        if constexpr (MODE == 2) {
#pragma unroll
            for (int a = 0; a < 2; ++a)
#pragma unroll
                for (int b = 0; b < 2; ++b)
#pragma unroll
                    for (int m = 0; m < 4; ++m)
#pragma unroll
                        for (int n = 0; n < 2; ++n) acc[a][b][m][n] = __builtin_convertvector(__builtin_bit_cast(i32x4, acc[a][b][m][n]), f32x4);
        }
        if constexpr (Epi::LAST_FUSED) { if (has_next) { E(acc, cur, wr, wc, fr, fq); S.done(cur); } }
        else if constexpr (!Epi::AFTER_DRAIN) { E(acc, cur, wr, wc, fr, fq); S.done(cur); }
        if (!has_next) break;
#pragma unroll
        for (int a = 0; a < 2; ++a)
#pragma unroll
            for (int b = 0; b < 2; ++b)
#pragma unroll
                for (int m = 0; m < 4; ++m)
#pragma unroll
                    for (int n = 0; n < 2; ++n) acc[a][b][m][n] = (f32x4){0.f, 0.f, 0.f, 0.f};
        cur = nxt; cA = nA; cB = nB; ++ui;
        if constexpr (ALIGN_EPI) { if (wr == 1) PG8_BAR; }
    }
    PG8_WAIT_V(0);
    if constexpr (!ALIGN_EPI) { if (wr == 0) PG8_BAR; }
    PG8_BAR;
    if constexpr (Epi::AFTER_DRAIN || Epi::LAST_FUSED) { E.fused(acc, cur, wr, wc, fr, fq, lds, wid, lane); S.done(cur); }
#undef PG8_SA
#undef PG8_SB
#undef PG8_STAGE
#undef PG8_LDA
#undef PG8_LDB
#undef PG8_MMA
#undef PG8_WAIT_V
#undef PG8_WAIT_L
#undef PG8_BAR
#undef PG8_SCHED
}
}

#ifndef PG8_SP2
#define PG8_SP2 true
#endif
#ifndef PG8_ALIGN
#define PG8_ALIGN true
#endif
constexpr int RING_OFF = 0, RING_BYTES = 131072;
constexpr int LDS_BYTES = 163840;
constexpr int LDSCTL_OFF = LDS_BYTES - 2048, MISC_OFF = LDSCTL_OFF + 320;
constexpr int RTAB_OFF = LDSCTL_OFF + 1024;
constexpr int NWAVES = 8;
constexpr int CW_BAR = 4096;

#define GAS __attribute__((address_space(1)))
#define LAS __attribute__((address_space(3)))
typedef unsigned v4u __attribute__((ext_vector_type(4)));
typedef float f32x4 __attribute__((ext_vector_type(4)));
typedef GAS unsigned gu32;
#define LDS_WAIT() asm volatile("s_waitcnt lgkmcnt(0)" ::: "memory")
#define VM_WAIT() asm volatile("s_waitcnt vmcnt(0)" ::: "memory")
__device__ __forceinline__ unsigned f2bf_u(float f) { unsigned u = __builtin_bit_cast(unsigned, f); return (u + 0x7fffu + ((u >> 16) & 1u)) >> 16; }
__device__ __forceinline__ unsigned pk2(float lo, float hi) { typedef float f2_ __attribute__((ext_vector_type(2))); typedef __bf16 b2_ __attribute__((ext_vector_type(2))); const f2_ v = {lo, hi}; return __builtin_bit_cast(unsigned, __builtin_convertvector(v, b2_)); }
__device__ __forceinline__ float wave_sum(float v) {
#pragma unroll
    for (int o = 1; o < 64; o <<= 1) v += __shfl_xor(v, o);
    return v;
}
__device__ __forceinline__ float wave_max(float v) {
#pragma unroll
    for (int o = 1; o < 64; o <<= 1) v = fmaxf(v, __shfl_xor(v, o));
    return v;
}
__device__ __forceinline__ unsigned pack4_i8(float a, float b, float c, float d, float inv) {
    const unsigned t0 = __float_as_uint(__builtin_fmaf(a, inv, 12582912.0f)), t1 = __float_as_uint(__builtin_fmaf(b, inv, 12582912.0f)),
                   t2 = __float_as_uint(__builtin_fmaf(c, inv, 12582912.0f)), t3 = __float_as_uint(__builtin_fmaf(d, inv, 12582912.0f));
    const unsigned lo = __builtin_amdgcn_perm(t1, t0, 0x0c0c0400u), hi = __builtin_amdgcn_perm(t3, t2, 0x0c0c0400u);
    return __builtin_amdgcn_perm(hi, lo, 0x05040100u);
}
__device__ __forceinline__ float inv127(float amax) { return 127.0f / fmaxf(amax, 1e-30f); }

#define XB_TMO      128
#define XB_MAP(j)   (32 + (j))
#define XB_MIS      48
#define XB_XCNT(j)  (256  + 64 * (j))
#define XB_XSUB(j)  (1280 + 64 * (j))
#define XB_XGEN(j)  (2304 + 64 * (j))
#define XB_TOP      3328
#define XB_TOPGEN   3392
#define XCD_BAR_WORDS 3456
#define XB_SPIN_CAP (1u << 18)

__device__ __forceinline__ unsigned xb_ld(unsigned* p)              { return __hip_atomic_load(p, __ATOMIC_RELAXED, __HIP_MEMORY_SCOPE_AGENT); }
__device__ __forceinline__ unsigned xb_add(unsigned* p, unsigned v) { return __hip_atomic_fetch_add(p, v, __ATOMIC_RELAXED, __HIP_MEMORY_SCOPE_AGENT); }
__device__ __forceinline__ unsigned xb_xcc_id() { return (unsigned)__builtin_amdgcn_s_getreg((3 << 11) | 20) & 0xFu; }
#define XB_SPIN(cond, bar) do { unsigned _sp = 0; while (cond) { __builtin_amdgcn_s_sleep(1); \
    if ((++_sp & 255u) == 0u) { if (xb_ld(&(bar)[XB_TMO])) break; if (_sp > XB_SPIN_CAP) { atomicAdd(&(bar)[XB_TMO], 1u); break; } } } } while (0)

struct XcdBarrier {
    unsigned* bar; unsigned x;
    volatile LAS unsigned* st;
};

__device__ __forceinline__ XcdBarrier xcd_barrier_post(unsigned* bar, volatile LAS unsigned* st) {
    XcdBarrier b; b.bar = bar; b.x = xb_xcc_id(); b.st = st;
    if (threadIdx.x == 0) {
        const unsigned prev = atomicCAS(&bar[XB_MAP(blockIdx.x & 7u)], 0u, b.x + 1u);
        if (prev != 0u && prev != b.x + 1u) (void)xb_add(&bar[XB_MIS], 1u);
        (void)xb_add(&bar[XB_XCNT(b.x)], 1u); }
    return b;
}
__device__ __forceinline__ void xcd_barrier_complete(unsigned* bar, unsigned x, unsigned& nloc, unsigned& nx) {
    const unsigned G = gridDim.x * gridDim.y * gridDim.z;
    unsigned sum, cnt, mine, sp = 0u;
    for (;;) {
        sum = 0u; cnt = 0u; mine = 0u;
#pragma unroll
        for (unsigned j = 0; j < 16; ++j) { const unsigned c = xb_ld(&bar[XB_XCNT(j)]); sum += c; cnt += (c > 0u) ? 1u : 0u; mine = (j == x) ? c : mine; }
        if (sum == G) break;
        __builtin_amdgcn_s_sleep(1);
        if ((++sp & 255u) == 0u) { if (xb_ld(&bar[XB_TMO])) break; if (sp > XB_SPIN_CAP) { atomicAdd(&bar[XB_TMO], 1u); break; } }
    }
    nloc = mine > 0u ? mine : 1u; nx = cnt > 0u ? cnt : 1u;
}

__device__ __forceinline__ void xcd_barrier(const XcdBarrier& b, bool local = false) {
    asm volatile("s_waitcnt vmcnt(0)" ::: "memory");
    __syncthreads();
    if (threadIdx.x == 0) {
        unsigned* bar = b.bar;
        __builtin_amdgcn_s_waitcnt(0);
        unsigned nloc = b.st[0], nx = b.st[1];
        if (nloc == 0u) { xcd_barrier_complete(bar, b.x, nloc, nx); b.st[0] = nloc; b.st[1] = nx; }
        const unsigned old = xb_add(&bar[XB_XSUB(b.x)], 1u);
        const unsigned gen = old / nloc;
        if (local && old + 1u == (gen + 1u) * nloc) {
            xb_add(&bar[XB_XGEN(b.x)], 1u);
            __builtin_amdgcn_fence(__ATOMIC_ACQUIRE, "agent");
            asm volatile("s_waitcnt vmcnt(0)" ::: "memory");
        } else
        if (old + 1u == (gen + 1u) * nloc) {
            __builtin_amdgcn_fence(__ATOMIC_RELEASE, "agent");
            asm volatile("s_waitcnt vmcnt(0)" ::: "memory");
            const unsigned og = xb_add(&bar[XB_TOP], 1u);
            const unsigned tg = og / nx;
            if (og + 1u == (tg + 1u) * nx) xb_add(&bar[XB_TOPGEN], 1u);
            else XB_SPIN(xb_ld(&bar[XB_TOPGEN]) == tg, bar);
            __builtin_amdgcn_fence(__ATOMIC_ACQUIRE, "agent");
            xb_add(&bar[XB_XGEN(b.x)], 1u);
            asm volatile("s_waitcnt vmcnt(0)" ::: "memory");
        } else {
            XB_SPIN(xb_ld(&bar[XB_XGEN(b.x)]) == gen, bar);
            __builtin_amdgcn_fence(__ATOMIC_ACQUIRE, "agent");
            asm volatile("s_waitcnt vmcnt(0)" ::: "memory");
        }
    }
    __syncthreads();
}

namespace bg {
typedef float f32x4 __attribute__((ext_vector_type(4)));
typedef unsigned u32x4 __attribute__((ext_vector_type(4)));
constexpr int I_O = (DM / 32) * (DM / 64), I_G = 0  , I_D = (DFF / 32) * (DM / 64), NBG = I_O + 2 * I_G + I_D;
struct Ptrs { const float* w_out; const float* w_gate; const float* w_up; const float* w_down; const float* norm2_w; u16* WoT; u16* WguT; u16* WdT; const float* cmax_gu; };
constexpr float WD_SCALE = 256.0f;
struct Dec { const float* W; u16* WT; const float* ksc; int K, N, k0, n0, drow0, f8; };
__device__ __forceinline__ Dec decode(const Ptrs& P, int q) {
    Dec d;
    if (q < I_O) { d.f8 = 0; d.W = P.w_out; d.WT = P.WoT; d.ksc = nullptr; d.K = DM; d.N = DM; d.k0 = 32 * (q / (DM / 64)); d.n0 = 64 * (q % (DM / 64)); d.drow0 = d.n0; return d; }
    q -= I_O;
    if (q < 2 * I_G) { const int up = q >= I_G ? 1 : 0; if (up) q -= I_G; d.f8 = 2; d.W = up ? P.w_up : P.w_gate; d.WT = P.WguT; d.ksc = P.norm2_w; d.K = DM; d.N = DFF;
        d.k0 = 32 * (q / (DFF / 64)); d.n0 = 64 * (q % (DFF / 64)); d.drow0 = 256 * (d.n0 >> 7) + 128 * up + (d.n0 & 127); return d; }
    q -= 2 * I_G;
    d.f8 = 1; d.W = P.w_down; d.WT = P.WdT; d.ksc = nullptr; d.K = DFF; d.N = DM; d.k0 = 32 * (q / (DM / 64)); d.n0 = 64 * (q % (DM / 64)); d.drow0 = d.n0; return d;
}
__device__ __forceinline__ void load(const Ptrs& P, int q, int lane, f32x4 (&v)[8]) {
    const Dec d = decode(P, q); const int kg = lane >> 4, n4 = (lane & 15) * 4;
    const float* src = d.W + (size_t)(d.k0 + 8 * kg) * d.N + d.n0 + n4;
#pragma unroll
    for (int i = 0; i < 8; ++i) v[i] = __builtin_nontemporal_load((const f32x4*)(src + (size_t)i * d.N));
}
__device__ __forceinline__ void store(const Ptrs& P, int q, int lane, f32x4 (&v)[8]) {
    const Dec d = decode(P, q); const int kg = lane >> 4, n4 = (lane & 15) * 4;
    if (d.ksc) { const f32x4 s0 = *(const f32x4*)(d.ksc + d.k0 + 8 * kg), s1 = *(const f32x4*)(d.ksc + d.k0 + 8 * kg + 4);
#pragma unroll
        for (int i = 0; i < 4; ++i) { v[i] = v[i] * s0[i]; v[4 + i] = v[4 + i] * s1[i]; } }
    if (d.f8 == 2) {
        const f32x4 cm = *(const f32x4*)(P.cmax_gu + d.drow0 + n4);
#pragma unroll
        for (int jn = 0; jn < 4; ++jn) { const float inv = inv127(cm[jn]); uint2 o; o.x = pack4_i8(v[0][jn], v[1][jn], v[2][jn], v[3][jn], inv); o.y = pack4_i8(v[4][jn], v[5][jn], v[6][jn], v[7][jn], inv);
            *(uint2*)((unsigned char*)d.WT + (size_t)(d.drow0 + n4 + jn) * d.K + d.k0 + 8 * kg) = o; }
        return; }
    if (d.f8) {
#pragma unroll
        for (int jn = 0; jn < 4; ++jn) { uint2 o; int t = 0;
            t = __builtin_amdgcn_cvt_pk_fp8_f32(v[0][jn] * WD_SCALE, v[1][jn] * WD_SCALE, t, false); t = __builtin_amdgcn_cvt_pk_fp8_f32(v[2][jn] * WD_SCALE, v[3][jn] * WD_SCALE, t, true); o.x = (unsigned)t;
            t = __builtin_amdgcn_cvt_pk_fp8_f32(v[4][jn] * WD_SCALE, v[5][jn] * WD_SCALE, t, false); t = __builtin_amdgcn_cvt_pk_fp8_f32(v[6][jn] * WD_SCALE, v[7][jn] * WD_SCALE, t, true); o.y = (unsigned)t;
            *(uint2*)((unsigned char*)d.WT + (size_t)(d.drow0 + n4 + jn) * d.K + d.k0 + 8 * kg) = o; }
        return; }
#pragma unroll
    for (int jn = 0; jn < 4; ++jn) { u32x4 o; o.x = pk2(v[0][jn], v[1][jn]); o.y = pk2(v[2][jn], v[3][jn]); o.z = pk2(v[4][jn], v[5][jn]); o.w = pk2(v[6][jn], v[7][jn]);
        *(u32x4*)(d.WT + (size_t)(d.drow0 + n4 + jn) * d.K + d.k0 + 8 * kg) = o; }
}
}

namespace hg {
typedef short bf16x8 __attribute__((ext_vector_type(8)));
typedef short s16x4 __attribute__((ext_vector_type(4)));
typedef short v4i16_t __attribute__((ext_vector_type(4)));
typedef float f32x16 __attribute__((ext_vector_type(16)));
typedef float f32x4 __attribute__((ext_vector_type(4)));
typedef float f32x2 __attribute__((ext_vector_type(2)));
typedef unsigned u32x4 __attribute__((ext_vector_type(4)));
typedef unsigned u32x2 __attribute__((ext_vector_type(2)));
#define HG_LAS __attribute__((address_space(3)))
constexpr int SET = 58368, O_QS = 0, O_KS = 16384, O_KD = 32768, O_V = 49152, O_EM = 57344, O_DL = 57856;
constexpr int L_TOT = 2 * SET, L_SLAB = L_TOT + 4096, L_END = L_SLAB + 2 * 16384;
__device__ __forceinline__ unsigned cvtpk(float lo, float hi) { typedef float f2_ __attribute__((ext_vector_type(2))); typedef __bf16 b2_ __attribute__((ext_vector_type(2))); const f2_ v = {lo, hi}; return __builtin_bit_cast(unsigned, __builtin_convertvector(v, b2_)); }
__device__ __forceinline__ float bf_lo(unsigned u) { return __uint_as_float(u << 16); }
__device__ __forceinline__ float bf_hi(unsigned u) { return __uint_as_float(u & 0xffff0000u); }
__device__ __forceinline__ float h_lo(unsigned u) { return (float)__builtin_bit_cast(_Float16, (unsigned short)(u & 0xffffu)); }
__device__ __forceinline__ float h_hi(unsigned u) { return (float)__builtin_bit_cast(_Float16, (unsigned short)(u >> 16)); }
__device__ __forceinline__ s16x4 vtr(const HG_LAS unsigned char* p) { return __builtin_bit_cast(s16x4, __builtin_amdgcn_ds_read_tr16_b64_v4i16((HG_LAS v4i16_t*)p)); }
__device__ __forceinline__ bf16x8 pk8(const f32x16& x, int b) {
    u32x4 w; w.x = cvtpk(x[b], x[b + 1]); w.y = cvtpk(x[b + 2], x[b + 3]); w.z = cvtpk(x[b + 4], x[b + 5]); w.w = cvtpk(x[b + 6], x[b + 7]); return __builtin_bit_cast(bf16x8, w); }
__device__ __forceinline__ bf16x8 cat8(s16x4 lo, s16x4 hi) { return (bf16x8){lo[0], lo[1], lo[2], lo[3], hi[0], hi[1], hi[2], hi[3]}; }
__device__ __forceinline__ bf16x8 perm_frag(const HG_LAS unsigned char* mat, int row, int ch, int hi) {
    const HG_LAS unsigned char* p = mat + row * 256 + 8 * hi;
    const u32x2 lo = *(const HG_LAS u32x2*)(p + ((ch ^ (row & 15)) << 4)), hh = *(const HG_LAS u32x2*)(p + (((ch + 1) ^ (row & 15)) << 4));
    return __builtin_bit_cast(bf16x8, (u32x4){lo.x, lo.y, hh.x, hh.y});
}

__device__ __forceinline__ void hgrn_item(HG_LAS unsigned char* lds, const u16* __restrict__ PROJ, u16* __restrict__ ODIR, int item, int tid, const bg::Ptrs& BP, int& bgj, int gcw, int NCW) {
    const int lane = tid & 63, w = __builtin_amdgcn_readfirstlane(tid >> 6), hi = lane >> 5, c32 = lane & 31;
    const int vh = item & 1, dir = (item >> 1) & 1, h = (item >> 2) & 7, b = item >> 5;
    const bool prod = w < 4; const int pw = w & 3;
    const size_t rowbase = (size_t)b * SEQ;
    const int cq = h * 128 + 2 * lane, cf = 2048 + dir * 1024 + h * 128 + 2 * lane;
    const int pt = pw * 64 + lane, vs = pt >> 2, vc = (pt & 3) * 2, cv = 1024 + h * 128 + vh * 64 + vc * 8;
    const int jb = pw & 1, kh = pw >> 1;
    const int trb = (4 * hi + ((lane & 15) >> 2)) * 64 + ((lane >> 4) & 1) * 32 + (lane & 3) * 8;
    f32x16 R0, R1, R2, R3; bg::f32x4 bgv[4], bgx[8];
#pragma unroll
    for (int r = 0; r < 16; ++r) { R0[r] = 0.f; R1[r] = 0.f; }
#define S0 R0
#define S1 R1
#define oown R2
#define ooth R3
#define FU(x) __float_as_uint(x)
#define UF(x) __uint_as_float(x)
#define HG_TOK(c, i) (dir ? (SEQ - 1 - (64 * (c) + (i))) : (64 * (c) + (i)))
    const unsigned rb8 = (unsigned)(rowbase * 8192);
#define HG_LOAD(c) do { _Pragma("unroll") for (int r = 0; r < 16; ++r) { const unsigned ro = rb8 + (unsigned)HG_TOK(c, 16 * pw + r) * 8192u; R0[r] = *(const float*)(PROJ + (ro + cq)); R1[r] = *(const float*)(PROJ + (ro + cf)); } \
        { const unsigned vo_ = rb8 + (unsigned)HG_TOK(c, vs) * 8192u + cv; bgv[2] = *(const bg::f32x4*)(PROJ + vo_); bgv[3] = *(const bg::f32x4*)(PROJ + (vo_ + 8)); } } while (0)
    if (prod) HG_LOAD(0);
    HG_LAS float* tot = (HG_LAS float*)(lds + L_TOT);
    constexpr int NC = SEQ / 64;
    if (prod) {
        { float a0 = 0.f, a1 = 0.f;
#pragma unroll
          for (int r = 0; r < 16; ++r) { a0 += h_lo(FU(R1[r])); a1 += h_hi(FU(R1[r])); }
          *(HG_LAS f32x2*)(tot + pw * 128 + 2 * lane) = (f32x2){a0, a1}; }
        __syncthreads();
        for (int c = 0; c <= NC + 1; ++c) {
            HG_LAS unsigned char* ps = lds + (c & 1) * SET;
            const int bgq = bgj * NCW + gcw; const bool bgdo = c < NC && bgq < bg::NBG && ((((c + 1) * 8) >> 5) != ((c * 8) >> 5));
            if (c < NC) {
                R2 = R0; R3 = R1; bgv[0] = bgv[2]; bgv[1] = bgv[3];
                if (c + 1 < NC) { int lq = lane; asm volatile("" : "+v"(lq));
                    const int cq = h * 128 + 2 * lq, cf = 2048 + dir * 1024 + h * 128 + 2 * lq, pt = pw * 64 + lq, vs = pt >> 2, cv = 1024 + h * 128 + vh * 64 + (pt & 3) * 16;
                    HG_LOAD(c + 1); }
                if (bgdo) bg::load(BP, bgq, lane, bgx);
                const HG_LAS float* totc = tot + (c & 1) * 512;
                float p0 = 0.f, p1 = 0.f, m0 = 0.f, m1 = 0.f, t0 = 0.f, t1 = 0.f;
#pragma unroll
                for (int ww = 0; ww < 4; ++ww) { const f32x2 x = *(const HG_LAS f32x2*)(totc + ww * 128 + 2 * lane);
                    if (ww < pw) { p0 += x.x; p1 += x.y; } if (ww < 2) { m0 += x.x; m1 += x.y; } t0 += x.x; t1 += x.y; }
                const float El0 = __builtin_amdgcn_exp2f(t0 - m0), El1 = __builtin_amdgcn_exp2f(t1 - m1);
                if (pw == 0) { *(HG_LAS f32x2*)(ps + O_EM + 8 * lane) = (f32x2){__builtin_amdgcn_exp2f(m0), __builtin_amdgcn_exp2f(m1)};
                               *(HG_LAS f32x2*)(ps + O_DL + 8 * lane) = (f32x2){__builtin_amdgcn_exp2f(t0), __builtin_amdgcn_exp2f(t1)}; }
                const float x0 = __builtin_fminf(__builtin_fmaxf(p0 - m0, -56.f), 56.f), x1 = __builtin_fminf(__builtin_fmaxf(p1 - m1, -56.f), 56.f);
                float e0 = __builtin_amdgcn_exp2f(x0), e1 = __builtin_amdgcn_exp2f(x1), g0 = __builtin_amdgcn_exp2f(-x0), g1 = __builtin_amdgcn_exp2f(-x1);
                int lno = lane; asm volatile("" : "+v"(lno));
#pragma unroll
                for (int r = 0; r < 16; ++r) {
                    const int i = 16 * pw + r;
                    const float lf0 = h_lo(FU(R3[r])), lf1 = h_hi(FU(R3[r]));
                    const float f0 = __builtin_amdgcn_exp2f(lf0), f1 = __builtin_amdgcn_exp2f(lf1), fi0 = __builtin_amdgcn_exp2f(-lf0), fi1 = __builtin_amdgcn_exp2f(-lf1);
                    e0 *= f0; e1 *= f1; g0 *= fi0; g1 *= fi1;
                    const float qs0 = bf_lo(FU(R2[r])) * e0, qs1 = bf_hi(FU(R2[r])) * e1, ks0 = (1.0f - f0) * g0, ks1 = (1.0f - f1) * g1;
                    const int sw = i * 256 + ((((lno >> 2) ^ (i & 15))) << 4) + (lno & 3) * 4;
                    *(HG_LAS unsigned*)(ps + O_QS + sw) = cvtpk(qs0, qs1);
                    *(HG_LAS unsigned*)(ps + O_KS + sw) = cvtpk(ks0, ks1);
                    *(HG_LAS unsigned*)(ps + O_KD + (((lno >> 4) * 4 + (i >> 4)) * 1024) + (i & 15) * 64 + (lno & 15) * 4) = cvtpk(ks0 * El0, ks1 * El1);
                }
                { const int pt = pw * 64 + lno, vs = pt >> 2, vc = (pt & 3) * 2;
                  HG_LAS unsigned char* vd = ps + O_V + (((vc >> 2) * 4 + (vs >> 4)) * 1024) + (vs & 15) * 64 + (vc & 3) * 16;
                  *(HG_LAS bg::f32x4*)vd = bgv[0]; *(HG_LAS bg::f32x4*)(vd + 16) = bgv[1]; }
                if (bgdo) { bg::store(BP, bgq, lane, bgx); ++bgj; }
                if (c + 1 < NC) { float a0 = 0.f, a1 = 0.f;
#pragma unroll
                    for (int r = 0; r < 16; ++r) { a0 += h_lo(FU(R1[r])); a1 += h_hi(FU(R1[r])); }
                    *(HG_LAS f32x2*)(tot + ((c + 1) & 1) * 512 + pw * 128 + 2 * lane) = (f32x2){a0, a1}; }
            }
            __syncthreads();
        }
    } else {
        __syncthreads();
        for (int c = 0; c <= NC + 1; ++c) {
            const HG_LAS unsigned char* cs = lds + ((c + 1) & 1) * SET;
            int lnc = lane; asm volatile("" : "+v"(lnc));
            const int hi = lnc >> 5, c32 = lnc & 31, trb = (4 * hi + ((lnc & 15) >> 2)) * 64 + ((lnc >> 4) & 1) * 32 + (lnc & 3) * 8;
            if (c >= 2) {
            const HG_LAS float* slab = (const HG_LAS float*)(lds + L_SLAB) + ((c - 1) & 1) * 4096 + (jb * 2 + (kh ^ 1)) * 1024 + lnc;
            const unsigned oo = (unsigned)(((size_t)dir * M + rowbase) * 1024) + h * 128 + vh * 64 + jb * 32 + c32;
#pragma unroll
            for (int r = 0; r < 16; ++r) { const int i = kh * 32 + (r & 3) + 8 * (r >> 2) + 4 * hi; const float v = oown[r] + slab[r * 64];
                ODIR[oo + (unsigned)HG_TOK(c - 2, i) * 1024u] = (u16)(cvtpk(v, v) & 0xffffu); }
            }
            if (c >= 1 && c <= NC) {
#pragma unroll
            for (int r = 0; r < 16; ++r) { oown[r] = 0.f; ooth[r] = 0.f; }
            const int rown = kh * 32 + c32, roth = (1 - kh) * 32 + c32, c32o = c32, trbo = trb;
#define HG_SB() __builtin_amdgcn_sched_barrier(0)
            bf16x8 qa[2][2][2], sbf[2][2];
            { f32x4 em[2][4];
#pragma unroll
              for (int t2 = 0; t2 < 2; ++t2) {
#pragma unroll
                for (int g = 0; g < 4; ++g) em[t2][g] = *(const HG_LAS f32x4*)(cs + O_EM + ((2 * kh + t2) * 32 + 8 * g + 4 * hi) * 4);
#pragma unroll
                for (int sp = 0; sp < 2; ++sp) { const int ch = (2 * kh + t2) * 4 + 2 * sp; qa[t2][sp][0] = perm_frag(cs + O_QS, rown, ch, hi); qa[t2][sp][1] = perm_frag(cs + O_QS, roth, ch, hi); } }
              HG_SB();
#pragma unroll
              for (int t2 = 0; t2 < 2; ++t2) { f32x16 Sx = t2 ? S1 : S0;
#pragma unroll
                for (int g = 0; g < 4; ++g) { Sx[4 * g] *= em[t2][g][0]; Sx[4 * g + 1] *= em[t2][g][1]; Sx[4 * g + 2] *= em[t2][g][2]; Sx[4 * g + 3] *= em[t2][g][3]; }
                sbf[t2][0] = pk8(Sx, 0); sbf[t2][1] = pk8(Sx, 8); } }
            HG_SB();
            bf16x8 dk[8], dq[8];
            const HG_LAS unsigned char* dksp = cs + O_KS + rown * 256; const HG_LAS unsigned char* dqsp = cs + O_QS + rown * 256;
#pragma unroll
            for (int st = 0; st < 4; ++st) { const int ch = 2 * st + hi; dk[st] = *(const HG_LAS bf16x8*)(dksp + ((ch ^ (rown & 15)) << 4)); dq[st] = *(const HG_LAS bf16x8*)(dqsp + ((ch ^ (rown & 15)) << 4)); }
            HG_SB();
#pragma unroll
            for (int t2 = 0; t2 < 2; ++t2)
#pragma unroll
                for (int sp = 0; sp < 2; ++sp) oown = __builtin_amdgcn_mfma_f32_32x32x16_bf16(qa[t2][sp][0], sbf[t2][sp], oown, 0, 0, 0);
#pragma unroll
            for (int t2 = 0; t2 < 2; ++t2)
#pragma unroll
                for (int sp = 0; sp < 2; ++sp) ooth = __builtin_amdgcn_mfma_f32_32x32x16_bf16(qa[t2][sp][1], sbf[t2][sp], ooth, 0, 0, 0);
            HG_SB();
#pragma unroll
            for (int st = 4; st < 8; ++st) { const int ch = 2 * st + hi; dk[st] = *(const HG_LAS bf16x8*)(dksp + ((ch ^ (rown & 15)) << 4)); dq[st] = *(const HG_LAS bf16x8*)(dqsp + ((ch ^ (rown & 15)) << 4)); }
            HG_SB();
            f32x16 X;
#pragma unroll
            for (int r = 0; r < 16; ++r) X[r] = 0.f;
#pragma unroll
            for (int st = 0; st < 4; ++st) X = __builtin_amdgcn_mfma_f32_32x32x16_bf16(dk[st], dq[st], X, 0, 0, 0);
            HG_SB();
            bf16x8 vf[4], ok[4], oq[4];
#pragma unroll
            for (int ks = 0; ks < 4; ++ks) { const HG_LAS unsigned char* vp = cs + O_V + (jb * 4 + ks) * 1024 + trbo; vf[ks] = cat8(vtr(vp), vtr(vp + 512)); }
            { const int rs = c32o, ri = 32 + c32o; const HG_LAS unsigned char* ksp = cs + O_KS + rs * 256; const HG_LAS unsigned char* qsp = cs + O_QS + ri * 256;
#pragma unroll
              for (int st = 0; st < 4; ++st) { const int ch = 2 * (4 * kh + st) + hi; ok[st] = *(const HG_LAS bf16x8*)(ksp + ((ch ^ (rs & 15)) << 4)); oq[st] = *(const HG_LAS bf16x8*)(qsp + ((ch ^ (ri & 15)) << 4)); } }
            HG_SB();
#pragma unroll
            for (int st = 4; st < 8; ++st) X = __builtin_amdgcn_mfma_f32_32x32x16_bf16(dk[st], dq[st], X, 0, 0, 0);
#pragma unroll
            for (int r = 0; r < 16; ++r) { const int sl = (r & 3) + 8 * (r >> 2) + 4 * hi; X[r] = (sl <= c32) ? X[r] : 0.f; }
            if (kh) { oown = __builtin_amdgcn_mfma_f32_32x32x16_bf16(pk8(X, 0), vf[2], oown, 0, 0, 0); oown = __builtin_amdgcn_mfma_f32_32x32x16_bf16(pk8(X, 8), vf[3], oown, 0, 0, 0); }
            else    { oown = __builtin_amdgcn_mfma_f32_32x32x16_bf16(pk8(X, 0), vf[0], oown, 0, 0, 0); oown = __builtin_amdgcn_mfma_f32_32x32x16_bf16(pk8(X, 8), vf[1], oown, 0, 0, 0); }
            HG_SB();
            f32x4 dl0[4]; bf16x8 kd0[4];
#pragma unroll
            for (int g = 0; g < 4; ++g) dl0[g] = *(const HG_LAS f32x4*)(cs + O_DL + ((2 * kh) * 32 + 8 * g + 4 * hi) * 4);
#pragma unroll
            for (int ks = 0; ks < 4; ++ks) { const HG_LAS unsigned char* kp = cs + O_KD + ((2 * kh) * 4 + ks) * 1024 + trbo; kd0[ks] = cat8(vtr(kp), vtr(kp + 512)); }
            HG_SB();
#pragma unroll
            for (int r = 0; r < 16; ++r) X[r] = 0.f;
#pragma unroll
            for (int st = 0; st < 4; ++st) X = __builtin_amdgcn_mfma_f32_32x32x16_bf16(ok[st], oq[st], X, 0, 0, 0);
            if (kh) { oown = __builtin_amdgcn_mfma_f32_32x32x16_bf16(pk8(X, 0), vf[0], oown, 0, 0, 0); oown = __builtin_amdgcn_mfma_f32_32x32x16_bf16(pk8(X, 8), vf[1], oown, 0, 0, 0); }
            else    { ooth = __builtin_amdgcn_mfma_f32_32x32x16_bf16(pk8(X, 0), vf[0], ooth, 0, 0, 0); ooth = __builtin_amdgcn_mfma_f32_32x32x16_bf16(pk8(X, 8), vf[1], ooth, 0, 0, 0); }
            HG_SB();
            f32x4 dl1[4]; bf16x8 kd1[4];
#pragma unroll
            for (int g = 0; g < 4; ++g) dl1[g] = *(const HG_LAS f32x4*)(cs + O_DL + ((2 * kh + 1) * 32 + 8 * g + 4 * hi) * 4);
#pragma unroll
            for (int ks = 0; ks < 4; ++ks) { const HG_LAS unsigned char* kp = cs + O_KD + ((2 * kh + 1) * 4 + ks) * 1024 + trbo; kd1[ks] = cat8(vtr(kp), vtr(kp + 512)); }
            HG_SB();
#pragma unroll
            for (int g = 0; g < 4; ++g) { S0[4 * g] *= dl0[g][0]; S0[4 * g + 1] *= dl0[g][1]; S0[4 * g + 2] *= dl0[g][2]; S0[4 * g + 3] *= dl0[g][3]; }
#pragma unroll
            for (int ks = 0; ks < 4; ++ks) S0 = __builtin_amdgcn_mfma_f32_32x32x16_bf16(kd0[ks], vf[ks], S0, 0, 0, 0);
#pragma unroll
            for (int g = 0; g < 4; ++g) { S1[4 * g] *= dl1[g][0]; S1[4 * g + 1] *= dl1[g][1]; S1[4 * g + 2] *= dl1[g][2]; S1[4 * g + 3] *= dl1[g][3]; }
#pragma unroll
            for (int ks = 0; ks < 4; ++ks) S1 = __builtin_amdgcn_mfma_f32_32x32x16_bf16(kd1[ks], vf[ks], S1, 0, 0, 0);
#undef HG_SB
            { HG_LAS float* slab = (HG_LAS float*)(lds + L_SLAB) + (c & 1) * 4096 + (jb * 2 + kh) * 1024 + lnc;
#pragma unroll
              for (int r = 0; r < 16; ++r) slab[r * 64] = ooth[r]; }
            }
            __syncthreads();
        }
    }
#undef HG_TOK
#undef HG_LOAD
#undef S0
#undef S1
#undef oown
#undef ooth
#undef FU
#undef UF
}
}

namespace at {
typedef short bf16x8 __attribute__((ext_vector_type(8)));
typedef short s16x4 __attribute__((ext_vector_type(4)));
typedef short v4i16_t __attribute__((ext_vector_type(4)));
typedef float f32x16 __attribute__((ext_vector_type(16)));
typedef float f32x4 __attribute__((ext_vector_type(4)));
typedef unsigned u32x4 __attribute__((ext_vector_type(4)));
#define AT_LAS __attribute__((address_space(3)))
constexpr int L_K = 0, L_V = 16384, L_WS = 65536, L_LUT = 66560, L_END = 68096;
constexpr float THR = 8.0f;
__device__ __forceinline__ unsigned cvtpk(float lo, float hi) { typedef float f2_ __attribute__((ext_vector_type(2))); typedef __bf16 b2_ __attribute__((ext_vector_type(2))); const f2_ v = {lo, hi}; return __builtin_bit_cast(unsigned, __builtin_convertvector(v, b2_)); }
__device__ __forceinline__ s16x4 vtr(const AT_LAS unsigned char* p) { return __builtin_bit_cast(s16x4, __builtin_amdgcn_ds_read_tr16_b64_v4i16((AT_LAS v4i16_t*)p)); }
__device__ __forceinline__ bf16x8 pk8(const f32x16& x, int b) {
    u32x4 w; w.x = cvtpk(x[b], x[b + 1]); w.y = cvtpk(x[b + 2], x[b + 3]); w.z = cvtpk(x[b + 4], x[b + 5]); w.w = cvtpk(x[b + 6], x[b + 7]); return __builtin_bit_cast(bf16x8, w); }
__device__ __forceinline__ bf16x8 cat8(s16x4 lo, s16x4 hi) { return (bf16x8){lo[0], lo[1], lo[2], lo[3], hi[0], hi[1], hi[2], hi[3]}; }
__device__ __forceinline__ float max3f(float a, float b, float c) { float r; asm("v_max3_f32 %0, %1, %2, %3" : "=v"(r) : "v"(a), "v"(b), "v"(c)); return r; }
__device__ __forceinline__ int rel_bucket(int rel) {
    const int n = rel < 0 ? -rel : rel; int bk;
    if (n < 8) bk = n; else if (n < 12) bk = 8; else if (n < 16) bk = 9; else if (n < 23) bk = 10; else if (n < 32) bk = 11;
    else if (n < 46) bk = 12; else if (n < 64) bk = 13; else if (n < 91) bk = 14; else bk = 15;
    return bk + (rel > 0 ? 16 : 0);
}

__device__ __forceinline__ void attn_unit(AT_LAS unsigned char* lds, const u16* __restrict__ PROJ, const float* __restrict__ relb, float* O1, u16* __restrict__ CAT, const float* __restrict__ subw,
                                          float lam, int b, int h, int qb, int mp, int tid) {
    const int lane = tid & 63, w = __builtin_amdgcn_readfirstlane(tid >> 6), hi = lane >> 5, c32 = lane & 31;
    const size_t rowbase = (size_t)b * SEQ;
    const int q0w = qb * 256 + w * 32;
    AT_LAS float* wsf = (AT_LAS float*)(lds + L_WS) + w * 32;
    AT_LAS float* lut = (AT_LAS float*)(lds + L_LUT);
    if (tid < 371) lut[tid] = relb[rel_bucket(tid - 185) * 8 + h] * 1.4426950408889634f;
    const float bias_neg = relb[15 * 8 + h] * 1.4426950408889634f, bias_pos = relb[31 * 8 + h] * 1.4426950408889634f;
    bf16x8 qf[4];
    { const unsigned qo = (unsigned)((rowbase + q0w + c32) * 8192 + 5120 + h * 128 + mp * 64 + 8 * hi);
#pragma unroll
      for (int st = 0; st < 4; ++st) qf[st] = *(const bf16x8*)(PROJ + (qo + 16 * st)); }
    f32x16 o[4];
#pragma unroll
    for (int d = 0; d < 4; ++d)
#pragma unroll
        for (int r = 0; r < 16; ++r) o[d][r] = 0.f;
    float mhat = 0.f, l = 0.f;
    const int krow = 8 * w + (lane >> 3), kch = (lane & 7) ^ ((krow >> 1) & 7);
    const unsigned kgo = (unsigned)((rowbase + krow) * 8192 + 6144 + h * 128 + mp * 64 + 8 * kch);
    const int vrow = ((2 * w) & 3) * 16 + (lane >> 2);
    const unsigned vgo = (unsigned)((rowbase + vrow) * 8192 + 7168 + h * 128 + (w >> 1) * 32 + (lane & 3) * 8);
    const int trb = (4 * hi + ((lane & 15) >> 2)) * 64 + ((lane >> 4) & 1) * 32 + (lane & 3) * 8;
#define AT_STAGE(t_, ks_, vs_) do { const unsigned go_ = (unsigned)(t_) * 64u * 8192u; \
        __builtin_amdgcn_global_load_lds((const unsigned*)(PROJ + (kgo + go_)), (AT_LAS unsigned*)(lds + L_K + (ks_) * 8192 + w * 1024), 16, 0, 0); \
        __builtin_amdgcn_global_load_lds((const unsigned*)(PROJ + (vgo + go_)), (AT_LAS unsigned*)(lds + L_V + (vs_) * 16384 + (2 * w) * 1024), 16, 0, 0); \
        __builtin_amdgcn_global_load_lds((const unsigned*)(PROJ + (vgo + go_ + 16u * 8192u)), (AT_LAS unsigned*)(lds + L_V + (vs_) * 16384 + (2 * w + 1) * 1024), 16, 0, 0); } while (0)
    AT_STAGE(0, 0, 0);
    asm volatile("s_waitcnt vmcnt(0)" ::: "memory");
    __syncthreads();
    constexpr int NT = SEQ / 64;
    const bool late = w >= 4;
    bf16x8 pa0, pa1, pa2, pa3, va_[4], vb_[4]; f32x16 p0, p1;
#define AT_VF(dst, VB, d) do { const AT_LAS unsigned char* vp_ = (VB) + (d) * 4096 + trb; \
        _Pragma("unroll") for (int k_ = 0; k_ < 4; ++k_) dst[k_] = cat8(vtr(vp_ + k_ * 1024), vtr(vp_ + k_ * 1024 + 512)); } while (0)
#define AT_MM(d, vf) do { o[d] = __builtin_amdgcn_mfma_f32_32x32x16_bf16(pa0, vf[0], o[d], 0, 0, 0); o[d] = __builtin_amdgcn_mfma_f32_32x32x16_bf16(pa1, vf[1], o[d], 0, 0, 0); \
        o[d] = __builtin_amdgcn_mfma_f32_32x32x16_bf16(pa2, vf[2], o[d], 0, 0, 0); o[d] = __builtin_amdgcn_mfma_f32_32x32x16_bf16(pa3, vf[3], o[d], 0, 0, 0); } while (0)
#define AT_SB() do {} while (0)
#define AT_VPRE(VB) do { AT_SB(); AT_VF(va_, VB, 0); AT_VF(vb_, VB, 1); AT_SB(); } while (0)
#define AT_PV(VB) do { AT_SB(); AT_MM(0, va_); AT_SB(); AT_VF(va_, VB, 2); AT_SB(); AT_MM(1, vb_); AT_SB(); AT_VF(vb_, VB, 3); AT_SB(); AT_MM(2, va_); AT_SB(); AT_MM(3, vb_); AT_SB(); } while (0)
#define AT_QK(tt) do { const AT_LAS unsigned char* Kb = lds + L_K + ((tt) & 1) * 8192; \
        const int kv0_ = 64 * (tt), far_ = (kv0_ - (q0w + 31) >= 91) ? 1 : ((kv0_ + 63 - q0w <= -91) ? -1 : 0); \
        const float ini = (far_ > 0 ? bias_pos : (far_ < 0 ? bias_neg : 0.f)) - mhat; \
        _Pragma("unroll") for (int r = 0; r < 16; ++r) { p0[r] = ini; p1[r] = ini; } \
        const int r0 = c32, r1 = 32 + c32; bf16x8 ka[4], kb[4]; \
        _Pragma("unroll") for (int st = 0; st < 4; ++st) { const int ch = 2 * st + hi; \
            ka[st] = *(const AT_LAS bf16x8*)(Kb + r0 * 128 + ((ch ^ ((r0 >> 1) & 7)) << 4)); kb[st] = *(const AT_LAS bf16x8*)(Kb + r1 * 128 + ((ch ^ ((r1 >> 1) & 7)) << 4)); } \
        _Pragma("unroll") for (int st = 0; st < 4; ++st) p0 = __builtin_amdgcn_mfma_f32_32x32x16_bf16(ka[st], qf[st], p0, 0, 0, 0);        \
        _Pragma("unroll") for (int st = 0; st < 4; ++st) p1 = __builtin_amdgcn_mfma_f32_32x32x16_bf16(kb[st], qf[st], p1, 0, 0, 0); } while (0)
#define AT_SM(tt) do { const int kv0_ = 64 * (tt); const bool band_ = !(kv0_ - (q0w + 31) >= 91) && !(kv0_ + 63 - q0w <= -91); \
        if (band_) { const AT_LAS float* lp_ = lut + (kv0_ + 4 * hi - (q0w + c32) + 185);        \
            _Pragma("unroll") for (int r = 0; r < 16; ++r) { p0[r] += lp_[(r & 3) + 8 * (r >> 2)]; p1[r] += lp_[(r & 3) + 8 * (r >> 2) + 32]; } } \
        float rm, rm2;                                             \
        rm = max3f(p0[0], p0[1], p1[0]); rm2 = max3f(p0[2], p0[3], p1[1]); rm = max3f(rm, p1[2], p1[3]); \
        _Pragma("unroll") for (int r = 4; r < 16; r += 4) { rm = max3f(rm, p0[r], p0[r + 1]); rm2 = max3f(rm2, p0[r + 2], p0[r + 3]); rm = max3f(rm, p1[r], p1[r + 1]); rm2 = max3f(rm2, p1[r + 2], p1[r + 3]); } \
        rm = __builtin_fmaxf(rm, rm2); \
        { const auto rr = __builtin_amdgcn_permlane32_swap(__float_as_uint(rm), __float_as_uint(rm), false, false); rm = __builtin_fmaxf(__uint_as_float(rr[0]), __uint_as_float(rr[1])); } \
        if ((tt) == 0 || __any(rm > THR)) { \
            const float dl = ((tt) == 0) ? rm : __builtin_fmaxf(rm, 0.f); \
            mhat += dl; \
            _Pragma("unroll") for (int r = 0; r < 16; ++r) { p0[r] -= dl; p1[r] -= dl; } \
            if ((tt) > 0) { const float f = __builtin_amdgcn_exp2f(-dl); l *= f; \
                if (hi == 0) wsf[c32] = f; \
                asm volatile("s_waitcnt lgkmcnt(0)" ::: "memory"); \
                _Pragma("unroll") for (int g = 0; g < 4; ++g) { const f32x4 fv = *(const AT_LAS f32x4*)(wsf + 8 * g + 4 * hi); \
                    _Pragma("unroll") for (int d = 0; d < 4; ++d) { o[d][4 * g] *= fv[0]; o[d][4 * g + 1] *= fv[1]; o[d][4 * g + 2] *= fv[2]; o[d][4 * g + 3] *= fv[3]; } } } } \
        _Pragma("unroll") for (int r = 0; r < 16; ++r) { p0[r] = __builtin_amdgcn_exp2f(p0[r]); p1[r] = __builtin_amdgcn_exp2f(p1[r]); } \
        { typedef float f2_ __attribute__((ext_vector_type(2))); f2_ s2_[8];                   \
          _Pragma("unroll") for (int i_ = 0; i_ < 8; ++i_) s2_[i_] = (f2_){p0[2 * i_], p0[2 * i_ + 1]} + (f2_){p1[2 * i_], p1[2 * i_ + 1]}; \
          s2_[0] += s2_[1]; s2_[2] += s2_[3]; s2_[4] += s2_[5]; s2_[6] += s2_[7]; s2_[0] += s2_[2]; s2_[4] += s2_[6]; s2_[0] += s2_[4]; l += s2_[0].x + s2_[0].y; } \
        pa0 = pk8(p0, 0); pa1 = pk8(p0, 8); pa2 = pk8(p1, 0); pa3 = pk8(p1, 8); } while (0)
#define AT_END() do { vprev = vslot; vslot = (vslot == 2) ? 0 : vslot + 1; \
        asm volatile("s_waitcnt vmcnt(0)" ::: "memory");            \
        __syncthreads(); } while (0)
    int vslot = 0, vprev = 0;
    if (!late) {
        for (int t = 0; t < NT; ++t) {
            if (t + 1 < NT) { AT_STAGE(t + 1, (t + 1) & 1, (vslot == 2) ? 0 : vslot + 1); }
            AT_QK(t); AT_VPRE(lds + L_V + vslot * 16384); AT_SM(t); AT_PV(lds + L_V + vslot * 16384);
            AT_END();
        }
    } else {
        for (int t = 0; t < NT; ++t) {
            if (t + 1 < NT) { AT_STAGE(t + 1, (t + 1) & 1, (vslot == 2) ? 0 : vslot + 1); }
            if (t > 0) { AT_PV(lds + L_V + vprev * 16384); }
            AT_QK(t); AT_SM(t); AT_VPRE(lds + L_V + vslot * 16384);
            AT_END();
        }
        AT_PV(lds + L_V + vprev * 16384);
    }
#undef AT_QK
#undef AT_SM
#undef AT_END
#undef AT_VPRE
#undef AT_PV
#undef AT_VPRE
#undef AT_VF
#undef AT_SB
#undef AT_MM
#undef AT_STAGE
    l += __shfl_xor(l, 32);
    if (hi == 0) wsf[c32] = __builtin_amdgcn_rcpf(l);
    asm volatile("s_waitcnt lgkmcnt(0)" ::: "memory");
    float rl[16];
#pragma unroll
    for (int g = 0; g < 4; ++g) { const f32x4 fv = *(const AT_LAS f32x4*)(wsf + 8 * g + 4 * hi); rl[4 * g] = fv[0]; rl[4 * g + 1] = fv[1]; rl[4 * g + 2] = fv[2]; rl[4 * g + 3] = fv[3]; }
    unsigned oo = (unsigned)((rowbase + q0w + 4 * hi) * 1024 + h * 128 + c32);
    if (mp == 0) {
#pragma unroll
        for (int r = 0; r < 16; ++r) { unsigned ro = oo + (unsigned)(((r & 3) + 8 * (r >> 2)) * 1024); asm volatile("" : "+v"(ro));
#pragma unroll
            for (int d = 0; d < 4; ++d) O1[ro + d * 32] = o[d][r] * rl[r]; }
    } else {
        float sw[4];
#pragma unroll
        for (int d = 0; d < 4; ++d) sw[d] = subw[d * 32 + c32] * 0.8f;
        const unsigned co = (unsigned)((rowbase + q0w + 4 * hi) * 2048 + 1024 + h * 128 + c32);
#pragma unroll
        for (int r = 0; r < 16; ++r) { unsigned ro = oo + (unsigned)(((r & 3) + 8 * (r >> 2)) * 1024), rc = co + (unsigned)(((r & 3) + 8 * (r >> 2)) * 2048); asm volatile("" : "+v"(ro), "+v"(rc));
            float x[4]; float ss = 0.f;
#pragma unroll
            for (int d = 0; d < 4; ++d) { x[d] = O1[ro + d * 32] - lam * (o[d][r] * rl[r]); ss += x[d] * x[d]; }
            ss += __shfl_xor(ss, 1); ss += __shfl_xor(ss, 2); ss += __shfl_xor(ss, 4); ss += __shfl_xor(ss, 8); ss += __shfl_xor(ss, 16);
            const float rr = __builtin_amdgcn_rsqf(ss * (1.0f / 128.0f) + 1e-6f);
#pragma unroll
            for (int d = 0; d < 4; ++d) CAT[rc + d * 32] = (u16)(cvtpk(x[d] * rr * sw[d], 0.f) & 0xffffu); }
    }
}
}

__device__ __forceinline__ void p0_item64(const float* W, int K, int N, const float* ksc, u16* WT, int k0, int n0, int drow0, int lane) {
    const int kg = lane >> 4, n4 = (lane & 15) * 4;
    const float* src = W + (size_t)(k0 + 8 * kg) * N + n0 + n4;
    f32x4 v[2][8];
#pragma unroll
    for (int r = 0; r < 2; ++r)
#pragma unroll
        for (int i = 0; i < 8; ++i) v[r][i] = __builtin_nontemporal_load((const f32x4*)(src + (size_t)(32 * r + i) * N));
    if (ksc) {
#pragma unroll
        for (int r = 0; r < 2; ++r) { const f32x4 s0 = *(const f32x4*)(ksc + k0 + 32 * r + 8 * kg), s1 = *(const f32x4*)(ksc + k0 + 32 * r + 8 * kg + 4);
#pragma unroll
            for (int i = 0; i < 4; ++i) { v[r][i] = v[r][i] * s0[i]; v[r][4 + i] = v[r][4 + i] * s1[i]; } }
    }
#pragma unroll
    for (int jn = 0; jn < 4; ++jn) { u16* dst = WT + (size_t)(drow0 + n4 + jn) * K + k0 + 8 * kg;
#pragma unroll
        for (int r = 0; r < 2; ++r) { v4u o; o.x = pk2(v[r][0][jn], v[r][1][jn]); o.y = pk2(v[r][2][jn], v[r][3][jn]); o.z = pk2(v[r][4][jn], v[r][5][jn]); o.w = pk2(v[r][6][jn], v[r][7][jn]);
            *(v4u*)(dst + 32 * r) = o; } }
}
__device__ __forceinline__ void p0_strip(LAS float* smax, const float* W, int N, const float* ksc, float* cmax, unsigned char* WT, int n0, int drow0, int tid) {
    const int lane = tid & 63, w = tid >> 6, g = lane & 7, kk = lane >> 3, kb = 256 * w + 32 * kk;
    const float* src = W + (size_t)kb * N + n0 + 4 * g;
    f32x4 v[32];
#pragma unroll
    for (int i = 0; i < 32; ++i) v[i] = __builtin_nontemporal_load((const f32x4*)(src + (size_t)i * N));
    if (ksc) {
#pragma unroll
        for (int i4 = 0; i4 < 8; ++i4) { const f32x4 sc = *(const f32x4*)(ksc + kb + 4 * i4);
#pragma unroll
            for (int e = 0; e < 4; ++e) v[4 * i4 + e] = v[4 * i4 + e] * sc[e]; } }
    f32x4 am = {0.f, 0.f, 0.f, 0.f};
#pragma unroll
    for (int i = 0; i < 32; ++i)
#pragma unroll
        for (int jn = 0; jn < 4; ++jn) am[jn] = fmaxf(am[jn], fabsf(v[i][jn]));
#pragma unroll
    for (int jn = 0; jn < 4; ++jn) { float a = am[jn]; a = fmaxf(a, __shfl_xor(a, 8)); a = fmaxf(a, __shfl_xor(a, 16)); a = fmaxf(a, __shfl_xor(a, 32)); am[jn] = a; }
    if (kk == 0) *(LAS f32x4*)(smax + w * 32 + 4 * g) = am;
    __syncthreads();
#pragma unroll
    for (int ww = 0; ww < 8; ++ww) { const f32x4 o = *(const LAS f32x4*)(smax + ww * 32 + 4 * g);
#pragma unroll
        for (int jn = 0; jn < 4; ++jn) am[jn] = fmaxf(am[jn], o[jn]); }
    if (w == 0 && kk == 0) *(f32x4*)(cmax + drow0 + 4 * g) = am;
#pragma unroll
    for (int jn = 0; jn < 4; ++jn) { const float inv = inv127(am[jn]); unsigned char* dst = WT + (size_t)(drow0 + 4 * g + jn) * 2048 + kb;
#pragma unroll
        for (int h = 0; h < 2; ++h) { v4u o;
            o.x = pack4_i8(v[16 * h + 0][jn], v[16 * h + 1][jn], v[16 * h + 2][jn], v[16 * h + 3][jn], inv); o.y = pack4_i8(v[16 * h + 4][jn], v[16 * h + 5][jn], v[16 * h + 6][jn], v[16 * h + 7][jn], inv);
            o.z = pack4_i8(v[16 * h + 8][jn], v[16 * h + 9][jn], v[16 * h + 10][jn], v[16 * h + 11][jn], inv); o.w = pack4_i8(v[16 * h + 12][jn], v[16 * h + 13][jn], v[16 * h + 14][jn], v[16 * h + 15][jn], inv);
            *(v4u*)(dst + 16 * h) = o; } }
}
__device__ __forceinline__ void p0_absmax64(const float* W, int N, const float* ksc, float* cmax, int k0, int n0, int drow0, int lane) {
    const int kg = lane >> 4, n4 = (lane & 15) * 4;
    const float* src = W + (size_t)(k0 + 8 * kg) * N + n0 + n4;
    f32x4 v[2][8];
#pragma unroll
    for (int r = 0; r < 2; ++r)
#pragma unroll
        for (int i = 0; i < 8; ++i) v[r][i] = *(const f32x4*)(src + (size_t)(32 * r + i) * N);
    if (ksc) {
#pragma unroll
        for (int r = 0; r < 2; ++r) { const f32x4 s0 = *(const f32x4*)(ksc + k0 + 32 * r + 8 * kg), s1 = *(const f32x4*)(ksc + k0 + 32 * r + 8 * kg + 4);
#pragma unroll
            for (int i = 0; i < 4; ++i) { v[r][i] = v[r][i] * s0[i]; v[r][4 + i] = v[r][4 + i] * s1[i]; } }
    }
#pragma unroll
    for (int jn = 0; jn < 4; ++jn) { float a = 0.f;
#pragma unroll
        for (int r = 0; r < 2; ++r)
#pragma unroll
            for (int i = 0; i < 8; ++i) a = fmaxf(a, fabsf(v[r][i][jn]));
        a = fmaxf(a, __shfl_xor(a, 16)); a = fmaxf(a, __shfl_xor(a, 32));
        if (kg == 0) atomicMax((unsigned*)(cmax + drow0 + n4 + jn), __float_as_uint(a)); }
}
__device__ __forceinline__ void p0_quant64(const float* W, int K, int N, const float* cmax, unsigned char* WT, int k0, int n0, int drow0, int lane) {
    const int kg = lane >> 4, n4 = (lane & 15) * 4;
    const float* src = W + (size_t)(k0 + 16 * kg) * N + n0 + n4;
    f32x4 v[16];
#pragma unroll
    for (int i = 0; i < 16; ++i) v[i] = __builtin_nontemporal_load((const f32x4*)(src + (size_t)i * N));
    const f32x4 cm = *(const f32x4*)(cmax + drow0 + n4);
#pragma unroll
    for (int jn = 0; jn < 4; ++jn) { const float inv = inv127(cm[jn]); v4u o;
        o.x = pack4_i8(v[0][jn], v[1][jn], v[2][jn], v[3][jn], inv); o.y = pack4_i8(v[4][jn], v[5][jn], v[6][jn], v[7][jn], inv);
        o.z = pack4_i8(v[8][jn], v[9][jn], v[10][jn], v[11][jn], inv); o.w = pack4_i8(v[12][jn], v[13][jn], v[14][jn], v[15][jn], inv);
        *(v4u*)(WT + (size_t)(drow0 + n4 + jn) * K + k0 + 16 * kg) = o; }
}
__device__ __forceinline__ void rms_row_to_bf16(const float* xrow, const float* w, u16* orow, int lane) {
    const f32x4* xr = (const f32x4*)xrow + lane;
    f32x4 v[8]; float s = 0.f;
#pragma unroll
    for (int j = 0; j < 8; ++j) { v[j] = xr[64 * j]; s += (v[j].x * v[j].x + v[j].y * v[j].y) + (v[j].z * v[j].z + v[j].w * v[j].w); }
    const float r = __builtin_amdgcn_rsqf(wave_sum(s) * (1.0f / DM) + EPS);
    const f32x4* wr = (const f32x4*)w + lane;
    uint2* o = (uint2*)orow + lane;
#pragma unroll
    for (int j = 0; j < 8; ++j) { const f32x4 ww = wr[64 * j]; uint2 p; p.x = pk2(v[j].x * r * ww.x, v[j].y * r * ww.y); p.y = pk2(v[j].z * r * ww.z, v[j].w * r * ww.w); o[64 * j] = p; }
}
__device__ __forceinline__ void rms_row_from_bf16(const u16* xrow, const float* w, float* orow, int lane) {
    const v4u* xr = (const v4u*)xrow + lane;
    v4u v[4]; float s = 0.f;
#pragma unroll
    for (int j = 0; j < 4; ++j) { v[j] = __builtin_nontemporal_load(xr + 64 * j);
#pragma unroll
        for (int e = 0; e < 4; ++e) { const float a = __uint_as_float(v[j][e] << 16), b = __uint_as_float(v[j][e] & 0xffff0000u); s += a * a + b * b; } }
    const float r = __builtin_amdgcn_rsqf(wave_sum(s) * (1.0f / DM) + EPS);
#pragma unroll
    for (int j = 0; j < 4; ++j) { const int c = (64 * j + lane) * 8; const f32x4 w0 = *(const f32x4*)(w + c), w1 = *(const f32x4*)(w + c + 4);
        f32x4 o0, o1;
        o0[0] = __uint_as_float(v[j][0] << 16) * r * w0[0]; o0[1] = __uint_as_float(v[j][0] & 0xffff0000u) * r * w0[1]; o0[2] = __uint_as_float(v[j][1] << 16) * r * w0[2]; o0[3] = __uint_as_float(v[j][1] & 0xffff0000u) * r * w0[3];
        o1[0] = __uint_as_float(v[j][2] << 16) * r * w1[0]; o1[1] = __uint_as_float(v[j][2] & 0xffff0000u) * r * w1[1]; o1[2] = __uint_as_float(v[j][3] << 16) * r * w1[2]; o1[3] = __uint_as_float(v[j][3] & 0xffff0000u) * r * w1[3];
        *(f32x4*)(orow + c) = o0; *(f32x4*)(orow + c + 4) = o1; }
}

static_assert(hg::L_END <= LDSCTL_OFF && at::L_END <= LDSCTL_OFF, "phase scratch below the LDS control words");
struct Args { const float* in[17]; float* out; unsigned char* ws; int ph_lo, ph_hi, li, pad; };
enum { PH_PRO = 0, PH_INPROJ = 1, PH_MIX = 2, PH_HGFIN = 3, PH_OUTPROJ = 4, PH_QUANT = 5, PH_GATEUP = 6, PH_DOWN = 7, PH_FINAL = 8, PH_N = 9 };

__global__ void __launch_bounds__(NWAVES * 64, 2) mk_fwd(Args args) {
    extern __shared__ __attribute__((aligned(16))) unsigned char lds_raw[];
    LAS unsigned char* lds = (LAS unsigned char*)lds_raw;
    volatile LAS unsigned* MISC = (volatile LAS unsigned*)(lds + MISC_OFF);
    const int tid = threadIdx.x, lane = tid & 63, wave = __builtin_amdgcn_readfirstlane(tid >> 6);
    const int G = gridDim.x; const int bx = blockIdx.x; const int vcu = (G % 8 == 0) ? (bx % 8) * (G / 8) + bx / 8 : bx;
    unsigned char* ws = args.ws;
    gu32* ctl = (gu32*)(ws + WS_CTL);
    float* rs2 = (float*)(ws + WS_PART); float* sa1 = (float*)(ws + WS_PART + 65536);
    float* cmax_gu = (float*)(ws + WS_CTL + CMAX_GU_OFF); float* cmax_in = (float*)(ws + WS_CTL + CMAX_IN_OFF);
    unsigned char* XN8 = ws + WS_B;
    unsigned char* H1Q = ws + WS_WIN;
    u16* WinT = (u16*)(ws + WS_WIN); u16* WoT = (u16*)(ws + WS_WO); u16* WguT = (u16*)(ws + WS_WGU); u16* WdT = (u16*)(ws + WS_WD);
    u16* XN = (u16*)(ws + WS_XN); u16* BB = (u16*)(ws + WS_B); u16* PROJ = (u16*)(ws + WS_PROJ);
    for (int u = tid; u < (LDS_BYTES - LDSCTL_OFF) / 4; u += NWAVES * 64) ((LAS unsigned*)(lds + LDSCTL_OFF))[u] = 0u;
    __syncthreads();
    XcdBarrier bar = xcd_barrier_post((unsigned*)(ctl + CW_BAR) + args.li * XCD_BAR_WORDS, MISC + 8);
    const int lo = args.ph_lo, hi = args.ph_hi;
#define IN(k) (lo <= (k) && (k) < hi)
#define SEAM(k) do { if (IN(k) && (k) + 1 < hi) xcd_barrier(bar); } while (0)
    bool local_ok = false;
#define SEAM_L(k) do { if (IN(k) && (k) + 1 < hi) xcd_barrier(bar, local_ok); } while (0)
    const int gw = vcu * NWAVES + wave, NGW = G * NWAVES;
    const bool own = (G == 256); const int ow_lw = (vcu & 31) * NWAVES + wave, ow_step = own ? 32 * NWAVES : NGW;
    const int ow_m0 = own ? (vcu >> 5) * SEQ + ow_lw : gw, ow_me = own ? ((vcu >> 5) + 1) * SEQ : M;
    const int ow_p4 = own ? (vcu >> 5) * 2 * SEQ + ow_lw : gw, ow_p4e = own ? ((vcu >> 5) + 1) * 2 * SEQ : M * 2;
    constexpr int PROBE_PH = -1, PROBE_BX = 0;
    unsigned long long pr_t0 = 0, pr_dt = 0, pr_c0 = 0;
#define PROBE_BEGIN(k) do { if (PROBE_PH == (k) && bx == PROBE_BX && tid == 0) pr_t0 = __builtin_amdgcn_s_memrealtime(); if (PROBE_PH == 100 + (k) && bx == PROBE_BX && tid == 0) pr_c0 = __builtin_amdgcn_s_memtime(); } while (0)
#define PROBE_END(k) do { if (PROBE_PH == (k) && bx == PROBE_BX && tid == 0) pr_dt = __builtin_amdgcn_s_memrealtime() - pr_t0; if (PROBE_PH == 100 + (k) && bx == PROBE_BX && tid == 0) pr_dt = (__builtin_amdgcn_s_memtime() - pr_c0) / 24; } while (0)

    PROBE_BEGIN(99);
    PROBE_BEGIN(PH_PRO);
    if (IN(PH_PRO)) {
        constexpr int NS_IN = INC / 32, NS = NS_IN;
        { int par = 0;
          for (int st = vcu; st < NS; st += G, par ^= 1) { LAS float* smax = (LAS float*)(lds + RING_OFF) + par * 256;
              p0_strip(smax, args.in[2], INC, nullptr, cmax_in, (unsigned char*)WinT, 32 * st, 32 * st, tid); } }
        { int r0, cnt, rstep;
          { const int q = NS / G, rem = NS % G, B = (32 * NS + M + G - 1) / G;
            if (B - 32 * (q + 1) >= 0) { r0 = vcu * (B - 32 * q) - 32 * (vcu < rem ? vcu : rem); cnt = B - 32 * (q + (vcu < rem ? 1 : 0)); if (r0 > M) r0 = M; if (r0 + cnt > M || vcu == G - 1) cnt = M - r0; r0 += wave; rstep = NWAVES; cnt = r0 - wave + cnt; }
            else { r0 = gw; rstep = NGW; cnt = M; } }
          f32x4 wv[8];
#pragma unroll
          for (int j = 0; j < 8; ++j) wv[j] = *((const f32x4*)args.in[1] + lane + 64 * j);
          f32x4 cur[8], nxt[8];
          if (r0 < cnt) {
#pragma unroll
              for (int j = 0; j < 8; ++j) nxt[j] = __builtin_nontemporal_load((const f32x4*)(args.in[0] + (size_t)r0 * DM) + lane + 64 * j); }
          for (int m = r0; m < cnt; m += rstep) {
#pragma unroll
              for (int j = 0; j < 8; ++j) cur[j] = nxt[j];
              if (m + rstep < cnt) {
#pragma unroll
                  for (int j = 0; j < 8; ++j) nxt[j] = __builtin_nontemporal_load((const f32x4*)(args.in[0] + (size_t)(m + rstep) * DM) + lane + 64 * j); }
              float s = 0.f;
#pragma unroll
              for (int j = 0; j < 8; ++j) s += (cur[j].x * cur[j].x + cur[j].y * cur[j].y) + (cur[j].z * cur[j].z + cur[j].w * cur[j].w);
              const float r = __builtin_amdgcn_rsqf(wave_sum(s) * (1.0f / DM) + EPS);
              float am = 0.f;
#pragma unroll
              for (int j = 0; j < 8; ++j) { cur[j] = cur[j] * r * wv[j]; am = fmaxf(fmaxf(am, fmaxf(fabsf(cur[j].x), fabsf(cur[j].y))), fmaxf(fabsf(cur[j].z), fabsf(cur[j].w))); }
              am = wave_max(am); const float inv = inv127(am);
              unsigned* o = (unsigned*)(XN8 + (size_t)m * DM) + lane;
#pragma unroll
              for (int j = 0; j < 8; ++j) o[64 * j] = pack4_i8(cur[j].x, cur[j].y, cur[j].z, cur[j].w, inv);
              if (lane == 0) sa1[m] = am * (1.0f / 127.0f); } }
    }
    SEAM(PH_PRO);
    local_ok = (G == 256) && lo == PH_PRO && xb_ld(bar.bar + XB_MIS) == 0u;
    PROBE_END(PH_PRO);
    PROBE_BEGIN(PH_INPROJ);
    if (IN(PH_INPROJ)) {
        pg8::Gemm g{(const u16*)XN8, WinT, M, INC, DM / 2}; pg8::StaticOrder S; S.init(M, INC, G, bx);
        pg8::EpiInProj E{PROJ, args.in[3], sa1, cmax_in};
        pg8::gemm_phase<pg8::EpiInProj, pg8::StaticOrder, PG8_ALIGN, PG8_SP2, 2>(lds + RING_OFF, g, S, E);
    }
    PROBE_BEGIN(53);
    SEAM_L(PH_INPROJ);
    PROBE_END(53);
    PROBE_END(PH_INPROJ);
    const int l16 = lane & 15; const f32x4 wa = *(const f32x4*)(args.in[4] + l16 * 8), wb = *(const f32x4*)(args.in[4] + l16 * 8 + 4);
    auto hgfin_mc = [&](int m, int c) {
            const v4u a = __builtin_nontemporal_load((const v4u*)(BB + (size_t)m * HGW + c)), bb = __builtin_nontemporal_load((const v4u*)(BB + ((size_t)M + m) * HGW + c)), g = __builtin_nontemporal_load((const v4u*)(PROJ + (size_t)m * INC + 4096 + c));
            float o[8]; float ss = 0.f;
#pragma unroll
            for (int e = 0; e < 4; ++e) { o[2 * e] = __uint_as_float(a[e] << 16) + __uint_as_float(bb[e] << 16); o[2 * e + 1] = __uint_as_float(a[e] & 0xffff0000u) + __uint_as_float(bb[e] & 0xffff0000u);
                ss += o[2 * e] * o[2 * e] + o[2 * e + 1] * o[2 * e + 1]; }
            ss += __shfl_xor(ss, 1); ss += __shfl_xor(ss, 2); ss += __shfl_xor(ss, 4); ss += __shfl_xor(ss, 8);
            const float r = __builtin_amdgcn_rsqf(ss * (1.0f / 128.0f) + EPS);
            v4u y;
#pragma unroll
            for (int e = 0; e < 4; ++e) { const float w0 = e < 2 ? wa[2 * e] : wb[2 * e - 4], w1 = e < 2 ? wa[2 * e + 1] : wb[2 * e - 3];
                y[e] = pk2(o[2 * e] * r * w0 * __uint_as_float(g[e] << 16), o[2 * e + 1] * r * w1 * __uint_as_float(g[e] & 0xffff0000u)); }
            *(v4u*)(XN + (size_t)m * DM + c) = y; };
    PROBE_BEGIN(PH_MIX);
    if (IN(PH_MIX)) {
        PROBE_BEGIN(20);
        const bg::Ptrs BP{args.in[11], args.in[13], args.in[14], args.in[15], args.in[12], WoT, WguT, WdT, cmax_gu}; int bgj = 0;
        const int gcw = vcu * 4 + (wave & 3), NCW = G * 4;
        const bool hgf_here = own && IN(PH_HGFIN); unsigned* qctr = (unsigned*)(ws + WS_CTL + 49152 + 512) + (vcu >> 2);
        for (int item = vcu; item < 256; item += G) { hg::hgrn_item(lds + RING_OFF, PROJ, BB, item, tid, BP, bgj, gcw, NCW); __syncthreads(); }
        if (hgf_here) { asm volatile("s_waitcnt vmcnt(0)" ::: "memory"); __syncthreads();
            if (tid == 0) { if (!local_ok) __builtin_amdgcn_fence(__ATOMIC_RELEASE, "agent"); (void)__hip_atomic_fetch_add(qctr, 1u, __ATOMIC_RELAXED, __HIP_MEMORY_SCOPE_AGENT); } }
        { constexpr int NS_G = DFF / 32; int par = 0;
          for (int st = vcu; st < 2 * NS_G; st += G, par ^= 1) { LAS float* smax = (LAS float*)(lds + RING_OFF) + par * 256;
              const int up = st >= NS_G ? 1 : 0, n0 = 32 * (st - up * NS_G);
              p0_strip(smax, up ? args.in[14] : args.in[13], DFF, args.in[12], cmax_gu, (unsigned char*)WguT, n0, 256 * (n0 >> 7) + 128 * up + (n0 & 127), tid); }
          __syncthreads(); }
        if (hgf_here) {
            if (tid == 0) { while (__hip_atomic_load(qctr, __ATOMIC_RELAXED, __HIP_MEMORY_SCOPE_AGENT) < 4u) __builtin_amdgcn_s_sleep(2);
                __builtin_amdgcn_fence(__ATOMIC_ACQUIRE, "agent"); asm volatile("s_waitcnt vmcnt(0)" ::: "memory"); }
            __syncthreads();
            const int hb_ = (vcu >> 5) * SEQ + (vcu & 3) * (SEQ / 4), hc_ = ((vcu >> 2) & 7) * 128 + l16 * 8;
            for (int i = wave * 4 + (lane >> 4); i < SEQ / 4; i += NWAVES * 4) hgfin_mc(hb_ + i, hc_); }
        if (wave < 4) for (; bgj * NCW + gcw < bg::NBG; ++bgj) { bg::f32x4 v[8]; bg::load(BP, bgj * NCW + gcw, lane, v); bg::store(BP, bgj * NCW + gcw, lane, v); }
        PROBE_END(20);
        PROBE_BEGIN(21);
        { const float lam = __expf(wave_sum(args.in[5][lane] * args.in[6][lane])) - __expf(wave_sum(args.in[7][lane] * args.in[8][lane])) + 0.2f;
          for (int pi = vcu; pi < 512; pi += G) { const int p = (G == 256) ? ((vcu >> 5) * 64 + (vcu & 31) * 2 + (pi >> 8)) : pi;
              const int b = p >> 6, h = (p >> 3) & 7, qb = p & 7;
              at::attn_unit(lds + RING_OFF, PROJ, args.in[10], args.out, XN, args.in[9], lam, b, h, qb, 0, tid);
              at::attn_unit(lds + RING_OFF, PROJ, args.in[10], args.out, XN, args.in[9], lam, b, h, qb, 1, tid); } }
        PROBE_END(21);
    }
    PROBE_BEGIN(54);
    if (!(own && IN(PH_HGFIN))) SEAM_L(PH_MIX);
    PROBE_END(54);
    PROBE_END(PH_MIX);
    PROBE_BEGIN(PH_HGFIN);
    if (IN(PH_HGFIN) && !(own && IN(PH_MIX))) {
        for (int p4 = ow_p4, p4e = ow_p4e; p4 < p4e; p4 += ow_step) { const int p = p4 * 4 + (lane >> 4); hgfin_mc(p >> 3, (p & 7) * 128 + l16 * 8); }
    }
    PROBE_BEGIN(57);
    SEAM(PH_HGFIN);
    PROBE_END(57);
    PROBE_END(PH_HGFIN);
    PROBE_BEGIN(PH_OUTPROJ);
    if (IN(PH_OUTPROJ)) {
        pg8::Gemm g{XN, WoT, M, DM, DM}; pg8::StaticOrder S; S.init(M, DM, G, bx);
        pg8::EpiOutProj E{args.in[0], BB};
        pg8::gemm_phase<pg8::EpiOutProj, pg8::StaticOrder, PG8_ALIGN, PG8_SP2>(lds + RING_OFF, g, S, E);
    }
    PROBE_BEGIN(58);
    SEAM_L(PH_OUTPROJ);
    PROBE_END(58);
    PROBE_END(PH_OUTPROJ);
    PROBE_BEGIN(PH_QUANT);
    if (IN(PH_QUANT)) {
        v4u cur[4], nxt[4];
        if (ow_m0 < ow_me) {
#pragma unroll
            for (int j = 0; j < 4; ++j) nxt[j] = *((const v4u*)(BB + (size_t)ow_m0 * DM) + lane + 64 * j); }
        for (int m = ow_m0; m < ow_me; m += ow_step) {
#pragma unroll
            for (int j = 0; j < 4; ++j) cur[j] = nxt[j];
            if (m + ow_step < ow_me) {
#pragma unroll
                for (int j = 0; j < 4; ++j) nxt[j] = *((const v4u*)(BB + (size_t)(m + ow_step) * DM) + lane + 64 * j); }
            float s = 0.f, am = 0.f;
#pragma unroll
            for (int j = 0; j < 4; ++j)
#pragma unroll
                for (int e = 0; e < 4; ++e) { const float a = __uint_as_float(cur[j][e] << 16), b = __uint_as_float(cur[j][e] & 0xffff0000u); s += a * a + b * b; am = fmaxf(am, fmaxf(fabsf(a), fabsf(b))); }
            s = wave_sum(s); am = wave_max(am);
            const float inv = inv127(am);
            uint2* o = (uint2*)(H1Q + (size_t)m * DM) + lane;
#pragma unroll
            for (int j = 0; j < 4; ++j) { uint2 w;
                w.x = pack4_i8(__uint_as_float(cur[j][0] << 16), __uint_as_float(cur[j][0] & 0xffff0000u), __uint_as_float(cur[j][1] << 16), __uint_as_float(cur[j][1] & 0xffff0000u), inv);
                w.y = pack4_i8(__uint_as_float(cur[j][2] << 16), __uint_as_float(cur[j][2] & 0xffff0000u), __uint_as_float(cur[j][3] << 16), __uint_as_float(cur[j][3] & 0xffff0000u), inv);
                o[64 * j] = w; }
            if (lane == 0) rs2[m] = __builtin_amdgcn_rsqf(s * (1.0f / DM) + EPS) * am * (1.0f / 127.0f); }
    }
    SEAM_L(PH_QUANT);
    PROBE_END(PH_QUANT);
    PROBE_BEGIN(PH_GATEUP);
    if (IN(PH_GATEUP)) {
        pg8::Gemm g{(const u16*)H1Q, WguT, M, NGU, DM / 2}; pg8::StaticOrder S; S.init(M, NGU, G, bx);
        pg8::Unit u0; u0.pm = 0; u0.pn = 0; (void)S.next(0, u0);
        LAS float* rtab = (LAS float*)(lds + RTAB_OFF);
        if (tid < 256) rtab[tid] = rs2[u0.pm * 256 + tid];
        __syncthreads();
        pg8::EpiSwiGLU8 E{(unsigned char*)PROJ, (const LAS float*)rtab, u0.pm, rs2, cmax_gu};
        pg8::gemm_phase<pg8::EpiSwiGLU8, pg8::StaticOrder, PG8_ALIGN, PG8_SP2, 2>(lds + RING_OFF, g, S, E);
    }
    PROBE_BEGIN(55);
    SEAM_L(PH_GATEUP);
    PROBE_END(55);
    PROBE_END(PH_GATEUP);
    PROBE_BEGIN(PH_DOWN);
    if (IN(PH_DOWN)) {
        pg8::Gemm g{PROJ, WdT, M, DM, DFF / 2, 0x77777777u  , 0x7d7d7d7du  }; pg8::StaticOrder S; S.init(M, DM, G, bx);
        if (own) {
            pg8::Unit u0; u0.pm = 0; u0.pn = 0; (void)S.next(0, u0);
            pg8::EpiDownF E{BB, (float*)(ws + WS_WGU + 24 * MiB), (unsigned*)(ws + WS_CTL + 49152), args.in[16], args.out, (LAS float*)(lds + RTAB_OFF), u0.pn, local_ok};
            pg8::gemm_phase<pg8::EpiDownF, pg8::StaticOrder, PG8_ALIGN, PG8_SP2, 1>(lds + RING_OFF, g, S, E);
        } else {
        pg8::EpiDown E{BB};
        pg8::gemm_phase<pg8::EpiDown, pg8::StaticOrder, PG8_ALIGN, PG8_SP2, 1>(lds + RING_OFF, g, S, E); }
    }
    PROBE_BEGIN(56);
    if (!(own && IN(PH_DOWN))) SEAM_L(PH_DOWN);
    PROBE_END(56);
    PROBE_END(PH_DOWN);
    PROBE_BEGIN(PH_FINAL);
    if (IN(PH_FINAL) && !(own && IN(PH_DOWN))) {
        for (int m = ow_m0; m < ow_me; m += ow_step) rms_row_from_bf16(BB + (size_t)m * DM, args.in[16], args.out + (size_t)m * DM, lane);
    }
    PROBE_END(PH_FINAL);
    PROBE_END(99);
    if (PROBE_PH >= 0 && bx == PROBE_BX && tid == 0) { const unsigned long long t1 = __builtin_amdgcn_s_memrealtime(); while (__builtin_amdgcn_s_memrealtime() - t1 < 4 * pr_dt) __builtin_amdgcn_s_sleep(8); }
#undef IN
#undef SEAM
}

extern "C" void kernel_launch(void* const* d_in, const int* in_sizes, int n_in, void* d_out, int out_size, void* d_ws, size_t ws_size, hipStream_t stream) {
    static int grid = 0;
    if (grid == 0) {
        if (n_in != 17 || ws_size < WS_NEED || out_size != M * DM) { fprintf(stderr, "kernel_launch: unexpected shapes (n_in %d, ws %zu, out %d)\n", n_in, ws_size, out_size); grid = -1; return; }
        int dev = 0, cus = 0;
        if (hipGetDevice(&dev) != hipSuccess || hipDeviceGetAttribute(&cus, hipDeviceAttributeMultiprocessorCount, dev) != hipSuccess) { grid = -1; return; }
        if (hipFuncSetAttribute((const void*)mk_fwd, hipFuncAttributeMaxDynamicSharedMemorySize, LDS_BYTES) != hipSuccess) { fprintf(stderr, "kernel_launch: hipFuncSetAttribute failed\n"); grid = -1; return; }
        (void)hipGetLastError();
        grid = cus;
    }
    if (grid < 0) return;
    unsigned char* ws = (unsigned char*)d_ws;
    (void)hipMemsetAsync(ws + WS_CTL, 0, CTL_ZERO_BYTES, stream);
    Args a{};
    for (int i = 0; i < 17; ++i) a.in[i] = (const float*)d_in[i];
    a.out = (float*)d_out; a.ws = ws;
    a.ph_lo = PH_PRO; a.ph_hi = PH_N; a.li = 0;
    hipLaunchKernelGGL(mk_fwd, dim3(grid), dim3(NWAVES * 64), LDS_BYTES, stream, a);
}
```
